# Optimizing an MI355X kernel written in HIP

```python
import functools
import jax, jax.numpy as jnp
from jax import lax
import numpy as np

D_MODEL = 1024
BATCH = 4
SEQ = 8192
DEPTH = 1
DEC_BATCH = 128
DEC_SEQ = 8
PAST_LEN = 16384
PAGE_SIZE = 128

MLA_HEADS = 8
QK_NOPE = 64
QK_ROPE = 32
V_HEAD = 64
KV_LORA = 128
Q_LORA = 256
MLA_WIDTH = MLA_HEADS * V_HEAD
ROPE_THETA = 10000.0
Q_BLOCK = 128
GLA_HEADS = 4
GLA_DK = 64
GLA_DV = 128
GLA_WIDTH = GLA_HEADS * GLA_DV
GLA_GATE_RANK = 16
GLA_TAU = 16.0
GLA_CHUNK = 64
P_DIM = 256
NORM_EPS = 1e-6
MIX_WIDTH = MLA_WIDTH + GLA_WIDTH
IN_SIZES = (Q_LORA, KV_LORA + QK_ROPE, MLA_WIDTH, GLA_HEADS * GLA_DK, GLA_HEADS * GLA_DK,
            GLA_WIDTH, GLA_GATE_RANK, GLA_WIDTH)
IN_DIM = Q_LORA + KV_LORA + QK_ROPE + MLA_WIDTH + 2 * GLA_HEADS * GLA_DK + GLA_WIDTH + GLA_GATE_RANK + GLA_WIDTH

kernel_name = 'hymba_mla_gla_decode_step'


def rmsnorm(x, g):
    xf = x.astype(jnp.float32)
    y = xf * lax.rsqrt(jnp.mean(xf * xf, axis=-1, keepdims=True) + NORM_EPS)
    return (y * g.astype(jnp.float32)).astype(x.dtype)


def rope_tables(pos):
    inv = 1.0 / (ROPE_THETA ** (jnp.arange(0, QK_ROPE, 2, dtype=jnp.float32) / QK_ROPE))
    ang = pos[:, None] * inv[None, :]
    return jnp.cos(ang), jnp.sin(ang)


def apply_rope(x, cos, sin):
    x1, x2 = jnp.split(x.astype(jnp.float32), 2, axis=-1)
    return jnp.concatenate([x1 * cos - x2 * sin, x1 * sin + x2 * cos], axis=-1).astype(x.dtype)


def mla_prompt_attention(q_nope, q_rope, c_kv, k_rope, w_uk, w_uv):
    B, S, H, _ = q_nope.shape
    scale = (QK_NOPE + QK_ROPE) ** -0.5
    k_nope = jnp.einsum('bsc,chd->bshd', c_kv, w_uk)
    v = jnp.einsum('bsc,chd->bshd', c_kv, w_uv)
    nb = S // Q_BLOCK
    qn = q_nope.reshape(B, nb, Q_BLOCK, H, QK_NOPE).transpose(1, 0, 2, 3, 4)
    qr = q_rope.reshape(B, nb, Q_BLOCK, H, QK_ROPE).transpose(1, 0, 2, 3, 4)
    kpos = jnp.arange(S)

    def block(args):
        qn_b, qr_b, start = args
        s = (jnp.einsum('bqhd,bkhd->bhqk', qn_b, k_nope)
             + jnp.einsum('bqhr,bkr->bhqk', qr_b, k_rope)).astype(jnp.float32) * scale
        qpos = start + jnp.arange(Q_BLOCK)
        s = jnp.where(kpos[None, :] <= qpos[:, None], s, -jnp.inf)
        p = jax.nn.softmax(s, axis=-1).astype(v.dtype)
        return jnp.einsum('bhqk,bkhd->bqhd', p, v)

    out = lax.map(block, (qn, qr, jnp.arange(nb) * Q_BLOCK))
    return out.transpose(1, 0, 2, 3, 4).reshape(B, S, H, V_HEAD)


def mla_decode_attention(q_nope, q_rope, c_new, kr_new, w_uk, w_uv, ckv_pool, kr_pool, page_table):
    T = q_nope.shape[1]
    scale = (QK_NOPE + QK_ROPE) ** -0.5
    past_len = page_table.shape[1] * ckv_pool.shape[1]
    q_lat = jnp.einsum('bthd,chd->bthc', q_nope, w_uk)
    kpos = jnp.arange(past_len + T)
    qpos = past_len + jnp.arange(T)
    mask = kpos[None, :] <= qpos[:, None]

    def one(args):
        ql, qr, pages, cn, krn = args
        c = jnp.concatenate([ckv_pool[pages].reshape(-1, KV_LORA), cn.astype(ckv_pool.dtype)], axis=0)
        kr = jnp.concatenate([kr_pool[pages].reshape(-1, QK_ROPE), krn.astype(kr_pool.dtype)], axis=0)
        s = (jnp.einsum('thc,lc->htl', ql, c)
             + jnp.einsum('thr,lr->htl', qr, kr)).astype(jnp.float32) * scale
        s = jnp.where(mask[None], s, -jnp.inf)
        p = jax.nn.softmax(s, axis=-1).astype(c.dtype)
        return jnp.einsum('htl,lc->thc', p, c)

    o_lat = lax.map(one, (q_lat, q_rope, page_table, c_new, kr_new))
    return jnp.einsum('bthc,chd->bthd', o_lat, w_uv.astype(o_lat.dtype))


def gla_chunked(q, k, v, log_a, s0, chunk):
    B, T, H, DK = q.shape
    DV = v.shape[-1]
    n = T // chunk
    f32 = jnp.float32
    q = q.astype(f32) * (DK ** -0.5)

    def to_chunks(a):
        return a.astype(f32).reshape(B, n, chunk, H, a.shape[-1]).transpose(1, 0, 3, 2, 4)

    tri = jnp.tril(jnp.ones((chunk, chunk), dtype=bool))

    def step(S, inp):
        qc, kc, vc, gc = inp
        b = jnp.cumsum(gc, axis=-2)
        o_inter = jnp.einsum('bhtk,bhkv->bhtv', qc * jnp.exp(b), S)
        diff = b[:, :, :, None, :] - b[:, :, None, :, :]
        decay = jnp.exp(jnp.where(tri[None, None, :, :, None], diff, -jnp.inf))
        A = jnp.einsum('bhtk,bhsk,bhtsk->bhts', qc, kc, decay)
        o = o_inter + jnp.einsum('bhts,bhsv->bhtv', A, vc)
        b_last = b[:, :, -1:, :]
        S = (jnp.exp(b_last[:, :, 0, :])[..., None] * S
             + jnp.einsum('bhsk,bhsv->bhkv', kc * jnp.exp(b_last - b), vc))
        return S, o

    S, o = lax.scan(step, s0.astype(f32), (to_chunks(q), to_chunks(k), to_chunks(v), to_chunks(log_a)))
    return o.transpose(1, 0, 3, 2, 4).reshape(B, T, H, DV), S


def hybrid_layer(h, p_l, pos, gla_s0, gla_chunk, mla_attend, g_mix_norm, w_in, g_qnorm, w_qup,
                 g_kvnorm, w_uk, w_uv, w_gla_a2, b_gla_a, g_gla_onorm, w_out, w_ple_gate, w_ple_proj):
    B, T, _ = h.shape
    xn = rmsnorm(h, g_mix_norm)
    z = xn @ w_in
    bounds = np.cumsum(IN_SIZES)[:-1].tolist()
    q_c, kv_c, gate_mla, q_g, k_g, v_g, a_g, gate_gla = jnp.split(z, bounds, axis=-1)
    cos, sin = rope_tables(pos)
    q = (rmsnorm(q_c, g_qnorm) @ w_qup).reshape(B, T, MLA_HEADS, QK_NOPE + QK_ROPE)
    q_nope = q[..., :QK_NOPE]
    q_rope = apply_rope(q[..., QK_NOPE:], cos[:, None, :], sin[:, None, :])
    c_kv = rmsnorm(kv_c[..., :KV_LORA], g_kvnorm)
    k_rope = apply_rope(kv_c[..., KV_LORA:], cos, sin)
    o_mla = mla_attend(q_nope, q_rope, c_kv, k_rope, w_uk, w_uv).reshape(B, T, MLA_WIDTH).astype(h.dtype)
    o_mla = o_mla * jax.nn.silu(gate_mla)
    gq = q_g.reshape(B, T, GLA_HEADS, GLA_DK)
    gk = k_g.reshape(B, T, GLA_HEADS, GLA_DK)
    gv = v_g.reshape(B, T, GLA_HEADS, GLA_DV)
    log_a = (jax.nn.log_sigmoid((a_g @ w_gla_a2 + b_gla_a).astype(jnp.float32)) / GLA_TAU
             ).reshape(B, T, GLA_HEADS, GLA_DK)
    o_gla, s_new = gla_chunked(gq, gk, gv, log_a, gla_s0, gla_chunk)
    o_gla = rmsnorm(o_gla.astype(h.dtype), g_gla_onorm).reshape(B, T, GLA_WIDTH) * jax.nn.silu(gate_gla)
    h = h + jnp.concatenate([o_mla, o_gla], axis=-1) @ w_out
    h = h + jax.nn.sigmoid(h @ w_ple_gate) * (p_l @ w_ple_proj)
    return h, c_kv, k_rope, s_new.astype(h.dtype)


def setup_inputs(seed: int = 0) -> dict:
    key = jax.random.key(seed)
    ks = jax.random.split(key, 32)
    n_pages = PAST_LEN // PAGE_SIZE
    n_pool = (DEC_BATCH * n_pages * 5) // 4
    f32 = jnp.float32

    def nrm(k, shape, scale):
        return jax.random.normal(k, shape, f32) * scale

    def gain(k, shape):
        return 1.0 + 0.05 * jax.random.normal(k, shape, f32)

    page_table = jax.random.permutation(ks[7], n_pool)[:DEC_BATCH * n_pages].reshape(DEC_BATCH, n_pages).astype(jnp.int32)
    return {
        'x_prompt': nrm(ks[0], (BATCH, SEQ, D_MODEL), 1.0),
        'x_sample': nrm(ks[1], (DEC_BATCH, DEC_SEQ, D_MODEL), 1.0),
        'p_prompt': nrm(ks[2], (DEPTH, BATCH, SEQ, P_DIM), 1.0),
        'p_sample': nrm(ks[3], (DEPTH, DEC_BATCH, DEC_SEQ, P_DIM), 1.0),
        'cache_ckv': nrm(ks[4], (DEPTH, n_pool, PAGE_SIZE, KV_LORA), 1.0),
        'cache_krope': nrm(ks[5], (DEPTH, n_pool, PAGE_SIZE, QK_ROPE), 1.0),
        'state_gla': nrm(ks[6], (DEPTH, DEC_BATCH, GLA_HEADS, GLA_DK, GLA_DV), 1.0),
        'page_table': page_table,
        'g_mix_norm': gain(ks[8], (DEPTH, D_MODEL)),
        'w_in': nrm(ks[9], (DEPTH, D_MODEL, IN_DIM), D_MODEL ** -0.5),
        'g_qnorm': gain(ks[10], (DEPTH, Q_LORA)),
        'w_qup': nrm(ks[11], (DEPTH, Q_LORA, MLA_HEADS * (QK_NOPE + QK_ROPE)), Q_LORA ** -0.5),
        'g_kvnorm': gain(ks[12], (DEPTH, KV_LORA)),
        'w_uk': nrm(ks[13], (DEPTH, KV_LORA, MLA_HEADS, QK_NOPE), KV_LORA ** -0.5),
        'w_uv': nrm(ks[14], (DEPTH, KV_LORA, MLA_HEADS, V_HEAD), KV_LORA ** -0.5),
        'w_gla_a2': nrm(ks[15], (DEPTH, GLA_GATE_RANK, GLA_HEADS * GLA_DK), GLA_GATE_RANK ** -0.5),
        'b_gla_a': nrm(ks[16], (DEPTH, GLA_HEADS * GLA_DK), 0.5),
        'g_gla_onorm': gain(ks[17], (DEPTH, GLA_DV)),
        'w_out': nrm(ks[18], (DEPTH, MIX_WIDTH, D_MODEL), MIX_WIDTH ** -0.5),
        'w_ple_gate': nrm(ks[19], (DEPTH, D_MODEL, D_MODEL), D_MODEL ** -0.5),
        'w_ple_proj': nrm(ks[20], (DEPTH, P_DIM, D_MODEL), P_DIM ** -0.5),
        'g_final': gain(ks[21], (D_MODEL,)),
    }


def reference(x_prompt, x_sample, p_prompt, p_sample, cache_ckv, cache_krope, state_gla, page_table,
              g_mix_norm, w_in, g_qnorm, w_qup, g_kvnorm, w_uk, w_uv, w_gla_a2, b_gla_a, g_gla_onorm,
              w_out, w_ple_gate, w_ple_proj, g_final):
    B, S, _ = x_prompt.shape
    T = x_sample.shape[1]
    past_len = page_table.shape[1] * cache_ckv.shape[2]
    pos_p = jnp.arange(S, dtype=jnp.float32)
    pos_s = past_len + jnp.arange(T, dtype=jnp.float32)
    s0_prompt = jnp.zeros((B, GLA_HEADS, GLA_DK, GLA_DV), jnp.float32)
    h_p, h_s = x_prompt, x_sample
    ckv_p, kr_p, st_p, ckv_s, kr_s, st_s = [], [], [], [], [], []
    for i in range(DEPTH):
        w = (g_mix_norm[i], w_in[i], g_qnorm[i], w_qup[i], g_kvnorm[i], w_uk[i], w_uv[i],
             w_gla_a2[i], b_gla_a[i], g_gla_onorm[i], w_out[i], w_ple_gate[i], w_ple_proj[i])
        h_p, c1, r1, s1 = hybrid_layer(h_p, p_prompt[i], pos_p, s0_prompt, min(GLA_CHUNK, S),
                                       mla_prompt_attention, *w)
        decode_attend = functools.partial(mla_decode_attention, ckv_pool=cache_ckv[i],
                                          kr_pool=cache_krope[i], page_table=page_table)
        h_s, c2, r2, s2 = hybrid_layer(h_s, p_sample[i], pos_s, state_gla[i], T, decode_attend, *w)
        ckv_p.append(c1); kr_p.append(r1); st_p.append(s1)
        ckv_s.append(c2); kr_s.append(r2); st_s.append(s2)
    y_prompt = rmsnorm(h_p, g_final)
    y_sample = rmsnorm(h_s, g_final)
    return (y_prompt, y_sample, jnp.stack(ckv_p), jnp.stack(kr_p), jnp.stack(st_p),
            jnp.stack(ckv_s), jnp.stack(kr_s), jnp.stack(st_s))
```

```cpp
#include <hip/hip_runtime.h>
#include <cstdio>
#include <cstdint>

namespace pg8 {
#define PG8_LAS __attribute__((address_space(3)))
typedef unsigned short bf16_t;
typedef short bf16x8 __attribute__((ext_vector_type(8)));
typedef float f32x4 __attribute__((ext_vector_type(4)));
typedef float f32x2 __attribute__((ext_vector_type(2)));
typedef unsigned u32x4 __attribute__((ext_vector_type(4)));
typedef unsigned u32x2 __attribute__((ext_vector_type(2)));
constexpr int BM = 256, BK = 64, HALF = 128, HTB = HALF * BK * 2, STAGE_BYTES = 8 * HTB, NXCD = 8, WGM = 8;

__host__ __device__ __forceinline__ int lds_byte(int r, int c) { const int st = (r >> 4) * 2 + (c >> 5), rr = r & 15, cc = c & 31, ob = rr * 64 + cc * 2; return st * 1024 + (ob ^ (((ob >> 9) & 1) << 5)); }
__host__ __device__ __forceinline__ void stage_rc(int b, int& R, int& C) { const int st = b / 1024, sb = b % 1024, swz = sb ^ (((sb >> 9) & 1) << 5); R = (st >> 1) * 16 + swz / 64; C = (st & 1) * 32 + (swz % 64) / 2; }
__host__ __device__ __forceinline__ int perm32(int rho) { const int n = rho >> 4, i = rho & 15; return 8 * (i >> 2) + 4 * n + (i & 3); }

struct Unit { int pm, pn; };
struct Gemm { const bf16_t* A; const bf16_t* Bt; int M, N, K, lda, ldb; };

struct StaticOrder {
    int nM, nN, nwg, G, c, base, lim;
    __host__ __device__ void init(int M, int N, int G_, int c_) { nM = M / BM; nN = N / BM; nwg = nM * nN; G = G_; c = c_; base = 0; lim = nwg; }
    __host__ __device__ bool next(int i, Unit& u) const {
        const long L = (long)base + (long)i * G + c; if (L >= lim) return false;
        int wgid = (int)L; { const int q = nwg / NXCD, r = nwg % NXCD, xcd = wgid % NXCD, off = wgid / NXCD; wgid = (xcd < r ? xcd * (q + 1) : r * (q + 1) + (xcd - r) * q) + off; }
        const int nig = WGM * nN, gid = wgid / nig, fm = gid * WGM, gsz = (nM - fm) < WGM ? (nM - fm) : WGM;
        u.pm = fm + ((wgid % nig) % gsz); u.pn = (wgid % nig) / gsz; return true;
    }
    __device__ __forceinline__ void a_ready(const Unit&) const {}
    __device__ __forceinline__ void done(const Unit&) const {}
};

__device__ __forceinline__ unsigned cvt_pk_bf16(float lo, float hi) { unsigned r; asm volatile("v_cvt_pk_bf16_f32 %0, %1, %2" : "=v"(r) : "v"(lo), "v"(hi)); return r; }

template <class Epi, class Sched, bool ALIGN_EPI = false>
__device__ __forceinline__ void gemm_phase(PG8_LAS unsigned char* lds, const Gemm g, const Sched& S, const Epi& E, const int wid) {
    int lane_; asm volatile("v_mbcnt_lo_u32_b32 %0, -1, 0\n\tv_mbcnt_hi_u32_b32 %0, -1, %0" : "=v"(lane_));
    const int lane = lane_, tid = wid * 64 + lane, wr = wid >> 2, wc = wid & 3, fr = lane & 15, fq = lane >> 4;
    const int K = g.K, nt = K / BK;
    unsigned voffA[2], voffB[2];
#pragma unroll
    for (int i = 0; i < 2; ++i) { int R, C; stage_rc(tid * 16 + i * 8192, R, C); const int Rb = Epi::PERM ? ((R & ~31) + perm32(R & 31)) : R;
        voffA[i] = (unsigned)(R * g.lda + C) * 2u; voffB[i] = (unsigned)(Rb * g.ldb + C) * 2u; }
    const size_t kstep = (size_t)(BK * 2);
    const size_t hstepA = (size_t)HALF * g.lda * 2, hstepB = (size_t)HALF * g.ldb * 2;
    const size_t tstepA = 2 * hstepA, tstepB = 2 * hstepB;
    const unsigned ldsw = (unsigned)wid * 1024u;
    const int aoff = lds_byte(wr * 64 + fr, fq * 8), boff = lds_byte(wc * 32 + fr, fq * 8);
#define PG8_SA(b, h) (((b) * 2 + (h)) * HTB)
#define PG8_SB(b, h) ((4 + (b) * 2 + (h)) * HTB)
#define PG8_STAGE(bufoff, gbase, voff) do { _Pragma("unroll") for (int _i = 0; _i < 2; ++_i) \
        __builtin_amdgcn_global_load_lds((const unsigned*)((const char*)(gbase) + (voff)[_i]), (PG8_LAS unsigned*)(lds + (bufoff) + ldsw + _i * 8192), 16, 0, 0); } while (0)
#define PG8_LDA(dst, b, h) do { _Pragma("unroll") for (int m = 0; m < 4; ++m) _Pragma("unroll") for (int k = 0; k < 2; ++k) dst[m][k] = *(const PG8_LAS bf16x8*)(lds + PG8_SA(b, h) + aoff + m * 2048 + k * 1024); } while (0)
#define PG8_LDB(dst, b, h) do { _Pragma("unroll") for (int n = 0; n < 2; ++n) _Pragma("unroll") for (int k = 0; k < 2; ++k) dst[n][k] = *(const PG8_LAS bf16x8*)(lds + PG8_SB(b, h) + boff + n * 2048 + k * 1024); } while (0)
#define PG8_MMA(ai, bj, At, Bt) do { __builtin_amdgcn_s_setprio(1); _Pragma("unroll") for (int m = 0; m < 4; ++m) _Pragma("unroll") for (int n = 0; n < 2; ++n) _Pragma("unroll") for (int k = 0; k < 2; ++k) \
        acc[ai][bj][m][n] = __builtin_amdgcn_mfma_f32_16x16x32_bf16(Bt[n][k], At[m][k], acc[ai][bj][m][n], 0, 0, 0); __builtin_amdgcn_s_setprio(0); } while (0)
#define PG8_WAIT_V(n) asm volatile("s_waitcnt vmcnt(" #n ")" ::: "memory")
#define PG8_WAIT_L(n) asm volatile("s_waitcnt lgkmcnt(" #n ")" ::: "memory")
#define PG8_BAR __builtin_amdgcn_s_barrier()
#define PG8_SCHED __builtin_amdgcn_sched_barrier(0)
    Unit cur, nxt; int ui = 0;
    if (!S.next(0, cur)) return;
    f32x4 acc[2][2][4][2];
#pragma unroll
    for (int a = 0; a < 2; ++a)
#pragma unroll
        for (int b = 0; b < 2; ++b)
#pragma unroll
            for (int m = 0; m < 4; ++m)
#pragma unroll
                for (int n = 0; n < 2; ++n) acc[a][b][m][n] = (f32x4){0.f, 0.f, 0.f, 0.f};
    bf16x8 At[4][2], B0[2][2], B1[2][2];
    const char* cA = (const char*)g.A + (size_t)cur.pm * tstepA; const char* cB = (const char*)g.Bt + (size_t)cur.pn * tstepB;
    S.a_ready(cur);
    PG8_STAGE(PG8_SB(0, 0), cB, voffB); PG8_STAGE(PG8_SB(0, 1), cB + hstepB, voffB); PG8_STAGE(PG8_SA(0, 0), cA, voffA); PG8_STAGE(PG8_SA(0, 1), cA + hstepA, voffA);
    if (wr == 1) PG8_BAR;
    PG8_WAIT_V(2); PG8_BAR;
    PG8_STAGE(PG8_SB(1, 0), cB + kstep, voffB); PG8_STAGE(PG8_SA(1, 0), cA + kstep, voffA); PG8_STAGE(PG8_SB(1, 1), cB + hstepB + kstep, voffB);
    PG8_WAIT_V(6); PG8_BAR;
    for (;;) {
        const bool has_next = S.next(ui + 1, nxt);
        const char* nA = has_next ? (const char*)g.A + (size_t)nxt.pm * tstepA : cA; const char* nB = has_next ? (const char*)g.Bt + (size_t)nxt.pn * tstepB : cB;
        for (int t = 0; t < nt; t += 2) {
            const bool last = (t == nt - 2);
            const char* a1 = cA + (size_t)(t + 1) * kstep;
            const char* a2 = last ? nA : cA + (size_t)(t + 2) * kstep; const char* b2 = last ? nB : cB + (size_t)(t + 2) * kstep;
            const char* a3 = a2 + kstep; const char* b3 = b2 + kstep;
            if (last && has_next) S.a_ready(nxt);
            PG8_LDB(B0, 0, 0); PG8_LDB(B1, 0, 1); PG8_SCHED; PG8_LDA(At, 0, 0); PG8_STAGE(PG8_SA(1, 1), a1 + hstepA, voffA);
            PG8_WAIT_V(8); PG8_WAIT_L(0); PG8_BAR; PG8_MMA(0, 0, At, B0); PG8_MMA(0, 1, At, B1); PG8_BAR; PG8_SCHED;
            PG8_LDA(At, 0, 1); PG8_STAGE(PG8_SB(0, 0), b2, voffB); PG8_STAGE(PG8_SB(0, 1), b2 + hstepB, voffB); PG8_STAGE(PG8_SA(0, 0), a2, voffA);
            PG8_WAIT_V(8); PG8_WAIT_L(0); PG8_BAR; PG8_MMA(1, 0, At, B0); PG8_MMA(1, 1, At, B1); PG8_BAR; PG8_SCHED;
            PG8_LDB(B0, 1, 0); PG8_LDB(B1, 1, 1); PG8_SCHED; PG8_LDA(At, 1, 0); PG8_STAGE(PG8_SA(0, 1), a2 + hstepA, voffA);
            PG8_WAIT_V(8); PG8_WAIT_L(0); PG8_BAR; PG8_MMA(0, 0, At, B0); PG8_MMA(0, 1, At, B1); PG8_BAR; PG8_SCHED;
            PG8_LDA(At, 1, 1); PG8_STAGE(PG8_SB(1, 0), b3, voffB); PG8_STAGE(PG8_SB(1, 1), b3 + hstepB, voffB); PG8_STAGE(PG8_SA(1, 0), a3, voffA);
            PG8_WAIT_V(8); PG8_WAIT_L(0); PG8_BAR; PG8_MMA(1, 0, At, B0); PG8_MMA(1, 1, At, B1); PG8_BAR; PG8_SCHED;
        }
        if constexpr (ALIGN_EPI) { if (wr == 0) PG8_BAR; }
        E(acc, cur, wr, wc, fr, fq); S.done(cur);
        if (!has_next) break;
#pragma unroll
        for (int a = 0; a < 2; ++a)
#pragma unroll
            for (int b = 0; b < 2; ++b)
#pragma unroll
                for (int m = 0; m < 4; ++m)
#pragma unroll
                    for (int n = 0; n < 2; ++n) acc[a][b][m][n] = (f32x4){0.f, 0.f, 0.f, 0.f};
        cur = nxt; cA = nA; cB = nB; ++ui;
        if constexpr (ALIGN_EPI) { if (wr == 1) PG8_BAR; }
    }
    PG8_WAIT_V(0);
    if constexpr (!ALIGN_EPI) { if (wr == 0) PG8_BAR; }
    PG8_BAR;
#undef PG8_SA
#undef PG8_SB
#undef PG8_STAGE
#undef PG8_LDA
#undef PG8_LDB
#undef PG8_MMA
#undef PG8_WAIT_V
#undef PG8_WAIT_L
#undef PG8_BAR
#undef PG8_SCHED
}
}

constexpr int NWAVES = 8, NTHREADS = 512;
constexpr int DM = 1024, SEQ = 8192, NB = 4, MP = NB * SEQ  , DECB = 128, DECT = 8, MS = DECB * DECT  , MT = MP + MS  ;
constexpr int NPAGES = 128, PAGE = 128, PAST = NPAGES * PAGE;
constexpr int HM = 8, QN = 64, QR = 32, VH = 64, KVL = 128, QL = 256;
constexpr int HG = 4, GDK = 64, GDV = 128, GRANK = 16;
constexpr int PD = 256, INDIM = 2480;
constexpr int ZP = 2560;
constexpr int ZC_KV = 256, ZC_KR = 384, ZC_AG = 416, ZC_GM = 512, ZC_QG = 1024, ZC_KG = 1280, ZC_VG = 1536, ZC_GG = 2048;
constexpr float EPS = 1e-6f;
constexpr float QSCALE = 0.10206207261596577f * 1.4426950408889634f;
constexpr int NPOS = SEQ + DECT;
constexpr int NCH = SEQ / 64;
constexpr int NGU = NB * HG * NCH;
constexpr int DSPLIT = 2, DPART = DSPLIT * 4;

constexpr size_t O_Y = 0;
constexpr size_t O_CKVP = (size_t)MT * DM;
constexpr size_t O_KRP = O_CKVP + (size_t)MP * KVL;
constexpr size_t O_GSP = O_KRP + (size_t)MP * QR;
constexpr size_t O_CKVS = O_GSP + (size_t)NB * HG * GDK * GDV;
constexpr size_t O_KRS = O_CKVS + (size_t)MS * KVL;
constexpr size_t O_GSS = O_KRS + (size_t)MS * QR;
constexpr size_t O_END = O_GSS + (size_t)DECB * HG * GDK * GDV;

constexpr size_t MiB = 1u << 20;
constexpr size_t WS_CTL = 0, CTL_ZERO_BYTES = 2 * MiB;
constexpr int CW_BAR = 4096;
constexpr int CW_PCNT = 16384, CW_SCNT = CW_PCNT + 64 * 128;
constexpr int CW_ATQ = 32768;
constexpr int CW_TMO = 64;
constexpr size_t WS_SSQ_Q = 256 * 1024, WS_SSQ_KV = WS_SSQ_Q + (size_t)MT * 4, WS_SSQ_Y = WS_SSQ_KV + (size_t)MT * 4;
static_assert(WS_SSQ_Y + (size_t)MT * 4 <= CTL_ZERO_BYTES, "ctl map");
constexpr size_t WS_WIN = 2 * MiB;
constexpr size_t WS_WQP = WS_WIN + (size_t)ZP * DM * 2;
constexpr size_t WS_WQS = WS_WQP + 768 * 256 * 2;
constexpr size_t WS_WKV = WS_WQS + 1280 * 256 * 2;
constexpr size_t WS_WPP = WS_WKV + 1024 * 256 * 2;
constexpr size_t WS_WOUT = WS_WPP + 1024 * 256 * 2;
constexpr size_t WS_WPG = WS_WOUT + (size_t)DM * DM * 2;
constexpr size_t WS_ROPE = WS_WPG + (size_t)DM * DM * 2;
constexpr size_t WS_W2T = WS_ROPE + (size_t)NPOS * 32 * 4;
constexpr size_t WS_RSX = WS_W2T + 256 * 16 * 2;
constexpr size_t WS_XN = 16 * MiB;
constexpr size_t WS_PB = WS_XN + (size_t)MT * DM * 2;
constexpr size_t WS_Z = WS_PB + (size_t)MT * PD * 2;
constexpr size_t WS_QP = WS_Z + (size_t)MT * ZP * 2;
constexpr size_t WS_QS = WS_QP + (size_t)MP * 768 * 2;
constexpr size_t WS_KN = WS_QS + (size_t)MS * 1280 * 2;
constexpr size_t WS_VV = WS_KN + (size_t)MP * 512 * 2;
constexpr size_t WS_KR = WS_VV + (size_t)MP * 512 * 2;
constexpr size_t WS_PP = WS_KR + (size_t)MT * 32 * 2;
constexpr size_t WS_QT = WS_PP + (size_t)MT * DM * 2;
constexpr size_t WS_KT = WS_QT + (size_t)MP * 256 * 2;
constexpr size_t WS_U = WS_KT + (size_t)MP * 256 * 2;
constexpr size_t WS_DEC = WS_U + (size_t)NGU * GDK * GDV * 4;
constexpr size_t WS_SPREV = WS_DEC + (size_t)NGU * GDK * 4;
constexpr size_t WS_PART = WS_SPREV + (size_t)NGU * GDK * GDV * 2;
constexpr size_t WS_ML = WS_PART + (size_t)DECB * DPART * 64 * 128 * 4;
constexpr size_t WS_MIX = WS_ML + (size_t)DECB * DPART * 64 * 2 * 4;
constexpr size_t WS_H1B = WS_MIX + (size_t)MT * DM * 2;
constexpr size_t WS_END = WS_H1B + (size_t)MT * DM * 2;
static_assert(WS_RSX + (size_t)MT * 4 <= WS_XN, "weights map");

constexpr int RING_BYTES = 131072;
constexpr int LDSCTL_OFF = RING_BYTES, MISC_OFF = LDSCTL_OFF + 320;
constexpr int LDS_BYTES = 147456;

#define FRESH_LANE_ID(l) asm volatile("v_mbcnt_lo_u32_b32 %0, -1, 0\n\tv_mbcnt_hi_u32_b32 %0, -1, %0" : "=v"(l))
#define GAS __attribute__((address_space(1)))
#define LAS __attribute__((address_space(3)))
typedef unsigned short bf16;
typedef unsigned v4u __attribute__((ext_vector_type(4)));
typedef unsigned v2u __attribute__((ext_vector_type(2)));
typedef float f32x4 __attribute__((ext_vector_type(4)));
typedef float f32x2 __attribute__((ext_vector_type(2)));
typedef float f32x16 __attribute__((ext_vector_type(16)));
typedef short bf16x8 __attribute__((ext_vector_type(8)));
typedef short s16x4 __attribute__((ext_vector_type(4)));
typedef GAS unsigned gu32;
#define LDS_WAIT() asm volatile("s_waitcnt lgkmcnt(0)" ::: "memory")
#define VM_WAIT() asm volatile("s_waitcnt vmcnt(0)" ::: "memory")
__device__ __forceinline__ unsigned f2bf(float f) { unsigned u = __builtin_bit_cast(unsigned, f); return (u + 0x7fffu + ((u >> 16) & 1u)) >> 16; }
typedef float f32x2_cv __attribute__((ext_vector_type(2))); typedef __bf16 bf16x2_cv __attribute__((ext_vector_type(2)));
__device__ __forceinline__ unsigned pk2(float lo, float hi) { f32x2_cv v = {lo, hi}; bf16x2_cv b = __builtin_convertvector(v, bf16x2_cv); return __builtin_bit_cast(unsigned, b); }
__device__ __forceinline__ float bf2f(unsigned short b) { return __builtin_bit_cast(float, (unsigned)b << 16); }
__device__ __forceinline__ float bflo(unsigned w) { return __builtin_bit_cast(float, w << 16); }
__device__ __forceinline__ float bfhi(unsigned w) { return __builtin_bit_cast(float, w & 0xffff0000u); }
__device__ __forceinline__ float wave_sum(float v) {
#pragma unroll
    for (int o = 1; o < 64; o <<= 1) v += __shfl_xor(v, o);
    return v;
}
__device__ __forceinline__ float fast_exp2(float x) { return __builtin_amdgcn_exp2f(x); }
__device__ __forceinline__ float siluf(float x) { return x * __builtin_amdgcn_rcpf(1.f + __expf(-x)); }
__device__ __forceinline__ float sigmoidf_(float x) { return __builtin_amdgcn_rcpf(1.f + __expf(-x)); }
__device__ __forceinline__ float rsq(float x) { return __builtin_amdgcn_rsqf(x); }
__device__ __forceinline__ float xor32(float v, bool upper) {
    auto rr = __builtin_amdgcn_permlane32_swap(__float_as_uint(v), __float_as_uint(v), false, false);
    return __uint_as_float(upper ? rr[0] : rr[1]);
}
__device__ __forceinline__ int crow(int r, int hi) { return (r & 3) + 8 * (r >> 2) + 4 * hi; }
#define XB_TMO      128
#define XB_XCNT(j)  (256  + 64 * (j))
#define XB_XSUB(j)  (1280 + 64 * (j))
#define XB_XGEN(j)  (2304 + 64 * (j))
#define XB_TOP      3328
#define XB_TOPGEN   3392
#define XCD_BAR_WORDS 3456
#define XB_SPIN_CAP (1u << 18)

__device__ __forceinline__ unsigned xb_ld(unsigned* p)              { return __hip_atomic_load(p, __ATOMIC_RELAXED, __HIP_MEMORY_SCOPE_AGENT); }
__device__ __forceinline__ unsigned xb_add(unsigned* p, unsigned v) { return __hip_atomic_fetch_add(p, v, __ATOMIC_RELAXED, __HIP_MEMORY_SCOPE_AGENT); }
__device__ __forceinline__ unsigned xb_xcc_id() { return (unsigned)__builtin_amdgcn_s_getreg((3 << 11) | 20) & 0xFu; }
#define XB_SPIN(cond, bar) do { unsigned _sp = 0; while (cond) { __builtin_amdgcn_s_sleep(1); \
    if ((++_sp & 255u) == 0u) { if (xb_ld(&(bar)[XB_TMO])) break; if (_sp > XB_SPIN_CAP) { atomicAdd(&(bar)[XB_TMO], 1u); break; } } } } while (0)

struct XcdBarrier {
    int w;
    unsigned* bar; unsigned x;
    volatile LAS unsigned* st;
};

__device__ __forceinline__ XcdBarrier xcd_barrier_post(unsigned* bar, volatile LAS unsigned* st) {
    XcdBarrier b; b.w = (int)__builtin_amdgcn_readfirstlane(threadIdx.x >> 6); b.bar = bar; b.x = xb_xcc_id(); b.st = st;
    if (threadIdx.x == 0) (void)xb_add(&bar[XB_XCNT(b.x)], 1u);
    return b;
}
__device__ __forceinline__ void xcd_barrier_complete(unsigned* bar, unsigned x, unsigned& nloc, unsigned& nx) {
    const unsigned G = gridDim.x * gridDim.y * gridDim.z;
    unsigned sum, cnt, mine, sp = 0u;
    for (;;) {
        sum = 0u; cnt = 0u; mine = 0u;
#pragma unroll
        for (unsigned j = 0; j < 16; ++j) { const unsigned c = xb_ld(&bar[XB_XCNT(j)]); sum += c; cnt += (c > 0u) ? 1u : 0u; mine = (j == x) ? c : mine; }
        if (sum == G) break;
        __builtin_amdgcn_s_sleep(1);
        if ((++sp & 255u) == 0u) { if (xb_ld(&bar[XB_TMO])) break; if (sp > XB_SPIN_CAP) { atomicAdd(&bar[XB_TMO], 1u); break; } }
    }
    nloc = mine > 0u ? mine : 1u; nx = cnt > 0u ? cnt : 1u;
}

__device__ __forceinline__ void xcd_barrier(const XcdBarrier& b) {
    asm volatile("s_waitcnt vmcnt(0)" ::: "memory");
    __syncthreads();
    unsigned xb_lane; asm volatile("v_mbcnt_lo_u32_b32 %0, -1, 0\n\tv_mbcnt_hi_u32_b32 %0, -1, %0" : "=v"(xb_lane));
    if (b.w == 0 && xb_lane == 0u) {
        unsigned* bar = b.bar;
        __builtin_amdgcn_s_waitcnt(0);
        unsigned nloc = b.st[0], nx = b.st[1];
        if (nloc == 0u) { xcd_barrier_complete(bar, b.x, nloc, nx); b.st[0] = nloc; b.st[1] = nx; }
        const unsigned old = xb_add(&bar[XB_XSUB(b.x)], 1u);
        const unsigned gen = old / nloc;
        if (old + 1u == (gen + 1u) * nloc) {
            __builtin_amdgcn_fence(__ATOMIC_RELEASE, "agent");
            asm volatile("s_waitcnt vmcnt(0)" ::: "memory");
            const unsigned og = xb_add(&bar[XB_TOP], 1u);
            const unsigned tg = og / nx;
            if (og + 1u == (tg + 1u) * nx) xb_add(&bar[XB_TOPGEN], 1u);
            else XB_SPIN(xb_ld(&bar[XB_TOPGEN]) == tg, bar);
            __builtin_amdgcn_fence(__ATOMIC_ACQUIRE, "agent");
            xb_add(&bar[XB_XGEN(b.x)], 1u);
            asm volatile("s_waitcnt vmcnt(0)" ::: "memory");
        } else {
            XB_SPIN(xb_ld(&bar[XB_XGEN(b.x)]) == gen, bar);
            __builtin_amdgcn_fence(__ATOMIC_ACQUIRE, "agent");
            asm volatile("s_waitcnt vmcnt(0)" ::: "memory");
        }
    }
    __syncthreads();
}

struct Args { const float* in[22]; float* out; unsigned char* ws; };
struct Frame {
    LAS unsigned char* lds; gu32* ctl;
    int tid, lane, wave, vcu, G;
    const float *x_p, *x_s, *p_p, *p_s, *cache_ckv, *cache_kr, *state_gla; const int* page_table;
    const float *g_mix, *w_in, *g_q, *w_qup, *g_kv, *w_uk, *w_uv, *w_a2, *b_a, *g_on, *w_out, *w_pg, *w_pp, *g_fin;
    float* out; unsigned char* ws;
    bf16 *WIN, *WQP, *WQS, *WKV, *WPP, *WOUT, *WPG, *W2T; float* ROPE;
    bf16 *XN, *PB, *Z, *QP, *QS, *KN, *VV, *KR, *PP, *QT, *KT, *SPREV, *MIX, *H1B;
    float *U, *DEC, *PART, *ML, *SSQ_Q, *SSQ_KV, *SSQ_Y, *RSX;
};
typedef __attribute__((address_space(4))) const unsigned long long* kargp_t;
__device__ __forceinline__ void make_frame(Frame& F, LAS unsigned char* lds, int wave_s) {
    kargp_t ka = (kargp_t)__builtin_amdgcn_kernarg_segment_ptr(); asm volatile("" : "+s"(ka));
    int lane_; FRESH_LANE_ID(lane_);
    F.lds = lds; F.lane = lane_; F.wave = wave_s; F.tid = wave_s * 64 + lane_;
    F.G = gridDim.x; { const int bx = blockIdx.x; F.vcu = (F.G % 8 == 0) ? (bx % 8) * (F.G / 8) + bx / 8 : bx; }
#define KIN(i) ((const float*)(GAS const float*)ka[i])
    F.x_p = KIN(0); F.x_s = KIN(1); F.p_p = KIN(2); F.p_s = KIN(3); F.cache_ckv = KIN(4); F.cache_kr = KIN(5); F.state_gla = KIN(6);
    F.page_table = (const int*)(GAS const int*)ka[7]; F.g_mix = KIN(8); F.w_in = KIN(9); F.g_q = KIN(10); F.w_qup = KIN(11); F.g_kv = KIN(12);
    F.w_uk = KIN(13); F.w_uv = KIN(14); F.w_a2 = KIN(15); F.b_a = KIN(16); F.g_on = KIN(17); F.w_out = KIN(18); F.w_pg = KIN(19);
    F.w_pp = KIN(20); F.g_fin = KIN(21);
    F.out = (float*)(GAS float*)ka[22]; unsigned char* ws = (unsigned char*)(GAS unsigned char*)ka[23]; F.ws = ws;
#undef KIN
    F.ctl = (gu32*)(ws + WS_CTL);
    F.WIN = (bf16*)(ws + WS_WIN); F.WQP = (bf16*)(ws + WS_WQP); F.WQS = (bf16*)(ws + WS_WQS); F.WKV = (bf16*)(ws + WS_WKV); F.WPP = (bf16*)(ws + WS_WPP);
    F.WOUT = (bf16*)(ws + WS_WOUT); F.WPG = (bf16*)(ws + WS_WPG); F.ROPE = (float*)(ws + WS_ROPE); F.W2T = (bf16*)(ws + WS_W2T);
    F.XN = (bf16*)(ws + WS_XN); F.PB = (bf16*)(ws + WS_PB); F.Z = (bf16*)(ws + WS_Z); F.QP = (bf16*)(ws + WS_QP); F.QS = (bf16*)(ws + WS_QS);
    F.KN = (bf16*)(ws + WS_KN); F.VV = (bf16*)(ws + WS_VV); F.KR = (bf16*)(ws + WS_KR); F.PP = (bf16*)(ws + WS_PP); F.QT = (bf16*)(ws + WS_QT); F.KT = (bf16*)(ws + WS_KT);
    F.SPREV = (bf16*)(ws + WS_SPREV); F.MIX = (bf16*)(ws + WS_MIX); F.H1B = (bf16*)(ws + WS_H1B);
    F.U = (float*)(ws + WS_U); F.DEC = (float*)(ws + WS_DEC); F.PART = (float*)(ws + WS_PART); F.ML = (float*)(ws + WS_ML);
    F.SSQ_Q = (float*)(ws + WS_SSQ_Q); F.SSQ_KV = (float*)(ws + WS_SSQ_KV); F.SSQ_Y = (float*)(ws + WS_SSQ_Y); F.RSX = (float*)(ws + WS_RSX);
}
__device__ __forceinline__ const float* xrow_ptr(const Frame& F, int row) { return row < MP ? F.x_p + (size_t)row * DM : F.x_s + (size_t)(row - MP) * DM; }

template <class Fn> __device__ __forceinline__ void tr_item(const Fn& f, int K, bf16* WT, LAS float* scr, int kb, int nb, int lane) {
    const int k0 = 64 * kb, n0 = 32 * nb;
#pragma unroll 8
    for (int i = 0; i < 32; ++i) { const int kk = 2 * i + (lane >> 5); scr[kk * 33 + (lane & 31)] = f(k0 + kk, n0 + (lane & 31)); }
    LDS_WAIT(); asm volatile("" ::: "memory");
    const int c = lane & 7;
#pragma unroll
    for (int j = 0; j < 4; ++j) { const int n = (lane >> 3) + 8 * j; const LAS float* s = scr + (8 * c) * 33 + n;
        v4u o; o.x = pk2(s[0 * 33], s[1 * 33]); o.y = pk2(s[2 * 33], s[3 * 33]); o.z = pk2(s[4 * 33], s[5 * 33]); o.w = pk2(s[6 * 33], s[7 * 33]);
        *(GAS v4u*)(WT + (size_t)(n0 + n) * K + k0 + 8 * c) = o; }
    LDS_WAIT(); asm volatile("" ::: "memory");
}
__device__ __forceinline__ int win_src_col(int n) {
    if (n < 416) return n;
    if (n < 432) return 1952 + (n - 416);
    if (n < 512) return -1;
    if (n < 1024) return 416 + (n - 512);
    if (n < 1280) return 928 + (n - 1024);
    if (n < 1536) return 1184 + (n - 1280);
    if (n < 2048) return 1440 + (n - 1536);
    return 1968 + (n - 2048);
}
__device__ __forceinline__ int qup_src_col(int n) {
    return n < 512 ? (n >> 6) * 96 + (n & 63) : ((n - 512) >> 5) * 96 + 64 + ((n - 512) & 31);
}
__device__ __forceinline__ void sincos_d(double a, float& s, float& c) {
    const double q = __builtin_rint(a * 0.63661977236758134308);
    const double r = __builtin_fma(-q, 1.57079632679489655800, a) - q * 6.12323399573676603587e-17;
    const double r2 = r * r;
    double sp = -7.6471637318198164759e-13; sp = sp * r2 + 1.6059043836821614599e-10; sp = sp * r2 - 2.5052108385441718775e-8; sp = sp * r2 + 2.7557319223985890653e-6;
    sp = sp * r2 - 1.9841269841269841270e-4; sp = sp * r2 + 8.3333333333333333333e-3; sp = sp * r2 - 1.6666666666666666667e-1; const double sn = r + r * r2 * sp;
    double cp = 4.7794773323873852974e-14; cp = cp * r2 - 1.1470745597729724714e-11; cp = cp * r2 + 2.0876756987868098979e-9; cp = cp * r2 - 2.7557319223985890653e-7;
    cp = cp * r2 + 2.4801587301587301587e-5; cp = cp * r2 - 1.3888888888888888889e-3; cp = cp * r2 + 4.1666666666666666667e-2; cp = cp * r2 - 0.5; const double cs = 1.0 + r2 * cp;
    const int qi = (int)((long long)q & 3);
    const double so = (qi == 0) ? sn : (qi == 1) ? cs : (qi == 2) ? -sn : -cs;
    const double co = (qi == 0) ? cs : (qi == 1) ? -sn : (qi == 2) ? -cs : sn;
    s = (float)so; c = (float)co;
}
__device__ __forceinline__ void p0_prologue(Frame& F) {
    LAS float* scr = (LAS float*)(F.lds + F.wave * 16384);
    const int gw = F.vcu * NWAVES + F.wave, NGW = F.G * NWAVES, lane = F.lane;
    constexpr int I_WIN = 16 * 80, I_WQP = 4 * 24, I_WKV = 4 * 32, I_WPP = 4 * 32, I_WOUT = 16 * 32, I_WPG = 16 * 32;
    constexpr int NITEMS = I_WIN + I_WQP + I_WKV + I_WPP + I_WOUT + I_WPG;
    for (int it = gw; it < NITEMS; it += NGW) {
        int r = it;
        if (r < I_WIN) { const float* w = F.w_in; const float* g = F.g_mix;
            tr_item([&](int k, int n) -> float { const int s = win_src_col(n); return s >= 0 ? g[k] * w[(size_t)k * INDIM + s] : 0.f; }, DM, F.WIN, scr, r / 80, r % 80, lane); continue; } r -= I_WIN;
        if (r < I_WQP) { const float* w = F.w_qup; const float* g = F.g_q;
            tr_item([&](int k, int n) -> float { return g[k] * w[(size_t)k * 768 + qup_src_col(n)] * QSCALE; }, QL, F.WQP, scr, r / 24, r % 24, lane); continue; } r -= I_WQP;
        if (r < I_WKV) { const float* uk = F.w_uk; const float* uv = F.w_uv; const float* g = F.g_kv;
            tr_item([&](int k, int n) -> float { if (k >= KVL) return 0.f; return g[k] * (n < 512 ? uk[(size_t)k * 512 + n] : uv[(size_t)k * 512 + (n - 512)]); }, 256, F.WKV, scr, r / 32, r % 32, lane); continue; } r -= I_WKV;
        if (r < I_WPP) { const float* w = F.w_pp;
            tr_item([&](int k, int n) -> float { return w[(size_t)k * DM + n]; }, PD, F.WPP, scr, r / 32, r % 32, lane); continue; } r -= I_WPP;
        if (r < I_WOUT) { const float* w = F.w_out;
            tr_item([&](int k, int n) -> float { return w[(size_t)k * DM + n]; }, DM, F.WOUT, scr, r / 32, r % 32, lane); continue; } r -= I_WOUT;
        { const float* w = F.w_pg;
            tr_item([&](int k, int n) -> float { return w[(size_t)k * DM + n]; }, DM, F.WPG, scr, r / 32, r % 32, lane); }
    }
    for (int e = (F.vcu * NTHREADS + F.tid); e < NPOS * 16; e += F.G * NTHREADS) {
        const int pi = e >> 4, i = e & 15; const double pos = (double)(pi < SEQ ? pi : PAST + (pi - SEQ));
        double inv = 1.0; for (int j = 0; j < i; ++j) inv *= 0.56234132519034908039;
        float s, c; sincos_d(pos * inv, s, c);
        F.ROPE[(size_t)pi * 32 + i] = c; F.ROPE[(size_t)pi * 32 + 16 + i] = s;
    }
    for (int e = F.vcu * NTHREADS + F.tid; e < 256 * 16; e += F.G * NTHREADS) F.W2T[e] = (bf16)f2bf(F.w_a2[(e & 15) * 256 + (e >> 4)]);
    for (int e = F.vcu * NTHREADS + F.tid; e < 1280 * QL; e += F.G * NTHREADS) {
        const int n = e >> 8, k = e & 255; float s;
        if (n >= 1024) s = F.w_qup[(size_t)k * 768 + qup_src_col(n - 1024 + 512)];
        else { const int h = n >> 7, c = n & 127; const GAS f32x4* wq = (const GAS f32x4*)(F.w_qup + (size_t)k * 768 + h * 96); const GAS f32x4* wu = (const GAS f32x4*)(F.w_uk + (size_t)(c * 8 + h) * 64); s = 0.f;
#pragma unroll
            for (int d = 0; d < 16; ++d) { const f32x4 a = wq[d], b = wu[d]; s += (a.x * b.x + a.y * b.y) + (a.z * b.z + a.w * b.w); } }
        F.WQS[e] = (bf16)f2bf(s * F.g_q[k] * QSCALE);
    }
}
__device__ __forceinline__ void p0_rows(Frame& F) {
    const int gw = F.vcu * NWAVES + F.wave, NGW = F.G * NWAVES, lane = F.lane;
    for (int m0 = 4 * gw; m0 < MT; m0 += 4 * NGW) {
        f32x4 v[4][4], pv[4];
#pragma unroll
        for (int r = 0; r < 4; ++r) { const int m = m0 + r; const GAS f32x4* xr = (const GAS f32x4*)xrow_ptr(F, m) + lane;
#pragma unroll
            for (int j = 0; j < 4; ++j) v[r][j] = xr[64 * j];
            const float* prow = m < MP ? F.p_p + (size_t)m * PD : F.p_s + (size_t)(m - MP) * PD; pv[r] = ((const GAS f32x4*)prow)[lane]; }
#pragma unroll
        for (int r = 0; r < 4; ++r) { const int m = m0 + r; float s = 0.f;
#pragma unroll
            for (int j = 0; j < 4; ++j) s += (v[r][j].x * v[r][j].x + v[r][j].y * v[r][j].y) + (v[r][j].z * v[r][j].z + v[r][j].w * v[r][j].w);
            const float rstd = 1.f / sqrtf(wave_sum(s) * (1.f / DM) + EPS);
            if (lane == 0) F.RSX[m] = rstd;
            GAS unsigned long long* o8 = (GAS unsigned long long*)(F.XN + (size_t)m * DM) + lane;
#pragma unroll
            for (int j = 0; j < 4; ++j) o8[64 * j] = (unsigned long long)pk2(v[r][j].x, v[r][j].y) | ((unsigned long long)pk2(v[r][j].z, v[r][j].w) << 32);
            ((GAS unsigned long long*)(F.PB + (size_t)m * PD))[lane] = (unsigned long long)pk2(pv[r].x, pv[r].y) | ((unsigned long long)pk2(pv[r].z, pv[r].w) << 32); }
    }
}

namespace pg8 {
__device__ __forceinline__ u32x4 pack8(const f32x4 v0, const f32x4 v1) { u32x4 w; w.x = cvt_pk_bf16(v0[0], v0[1]); w.y = cvt_pk_bf16(v0[2], v0[3]); w.z = cvt_pk_bf16(v1[0], v1[1]); w.w = cvt_pk_bf16(v1[2], v1[3]); return w; }
struct EpiZ {
    static constexpr bool PERM = true;
    bf16_t* Z; float* ssq_q; float* ssq_kv; const float* rsx;
    __device__ __forceinline__ void operator()(const f32x4 (&acc)[2][2][4][2], const Unit& u, int wr, int wc, int, int) const {
        int ln_; FRESH_LANE_ID(ln_); const int fr = ln_ & 15, fq = ln_ >> 4;
        const int row0 = u.pm * BM + wr * 64 + fr, col0 = u.pn * BM + wc * 32 + 8 * fq;
#pragma unroll
        for (int ai = 0; ai < 2; ++ai)
#pragma unroll
            for (int m = 0; m < 4; ++m) { bf16_t* rowp = Z + (size_t)(row0 + ai * HALF + m * 16) * ZP + col0; const float rs = rsx[row0 + ai * HALF + m * 16];
#pragma unroll
                for (int bj = 0; bj < 2; ++bj) *(u32x4*)(rowp + bj * HALF) = pack8(acc[ai][bj][m][0] * rs, acc[ai][bj][m][1] * rs); }
        if (u.pn < 2) {
            float* dst = u.pn == 0 ? ssq_q : ssq_kv; const bool both = (u.pn == 0);
#pragma unroll
            for (int ai = 0; ai < 2; ++ai)
#pragma unroll
                for (int m = 0; m < 4; ++m) { float s = 0.f; const float rs = rsx[row0 + ai * HALF + m * 16];
#pragma unroll
                    for (int n = 0; n < 2; ++n) { const f32x4 a = acc[ai][0][m][n], b = acc[ai][1][m][n];
                        s += (a[0] * a[0] + a[1] * a[1]) + (a[2] * a[2] + a[3] * a[3]);
                        if (both) s += (b[0] * b[0] + b[1] * b[1]) + (b[2] * b[2] + b[3] * b[3]); }
                    s += __shfl_xor(s, 16); s += xor32(s, fq >= 2);
                    if (fq == 0) unsafeAtomicAdd(dst + row0 + ai * HALF + m * 16, s * rs * rs); }
        }
    }
};
struct EpiScale {
    static constexpr bool PERM = true;
    bf16_t* O0; bf16_t* O1; int split_tile; int ldc;
    const float* ssq; float inv_dim; int row_base;
    int rope_tile; const float* rope; int pos_mask, pos_base;
    __device__ __forceinline__ void operator()(const f32x4 (&acc)[2][2][4][2], const Unit& u, int wr, int wc, int, int) const {
        int ln_; FRESH_LANE_ID(ln_); const int fr = ln_ & 15, fq = ln_ >> 4;
        const int row0 = u.pm * BM + wr * 64 + fr;
        bf16_t* base = u.pn < split_tile ? O0 + u.pn * BM : O1 + (u.pn - split_tile) * BM;
        const int col0 = wc * 32 + 8 * fq;
        if (u.pn != rope_tile) {
#pragma unroll
            for (int ai = 0; ai < 2; ++ai)
#pragma unroll
                for (int m = 0; m < 4; ++m) { const int row = row0 + ai * HALF + m * 16;
                    const float rs = ssq ? rsq(ssq[row_base + row] * inv_dim + EPS) : 1.f;
                    bf16_t* rowp = base + (size_t)row * ldc + col0;
#pragma unroll
                    for (int bj = 0; bj < 2; ++bj) *(u32x4*)(rowp + bj * HALF) = pack8(acc[ai][bj][m][0] * rs, acc[ai][bj][m][1] * rs); }
        } else {
#pragma unroll
            for (int ai = 0; ai < 2; ++ai)
#pragma unroll
                for (int m = 0; m < 4; ++m) { const int row = row0 + ai * HALF + m * 16;
                    const float rs = ssq ? rsq(ssq[row_base + row] * inv_dim + EPS) : 1.f;
                    bf16_t* rowp = base + (size_t)row * ldc + col0;
                    const float* tb = rope + (size_t)(pos_base + (row & pos_mask)) * 32 + 8 * (fq & 1);
                    const f32x4 cs0 = *(const f32x4*)tb, cs1 = *(const f32x4*)(tb + 4), sn0 = *(const f32x4*)(tb + 16), sn1 = *(const f32x4*)(tb + 20);
#pragma unroll
                    for (int bj = 0; bj < 2; ++bj) { f32x4 v0 = acc[ai][bj][m][0] * rs, v1 = acc[ai][bj][m][1] * rs; f32x4 o0, o1;
#pragma unroll
                        for (int e = 0; e < 4; ++e) { o0[e] = xor32(v0[e], fq >= 2); o1[e] = xor32(v1[e], fq >= 2); }
                        if (fq < 2) { v0 = v0 * cs0 - o0 * sn0; v1 = v1 * cs1 - o1 * sn1; } else { v0 = o0 * sn0 + v0 * cs0; v1 = o1 * sn1 + v1 * cs1; }
                        *(u32x4*)(rowp + bj * HALF) = pack8(v0, v1); }
                    asm volatile("" ::: "memory"); }
        }
    }
};
}

__device__ __forceinline__ void p2_rows(Frame& F) {
    const int gw = F.vcu * NWAVES + F.wave, NGW = F.G * NWAVES, lane = F.lane, g4 = lane >> 4, l16 = lane & 15;
    const f32x4 gk0 = *(const GAS f32x4*)(F.g_kv + 8 * l16), gk1 = *(const GAS f32x4*)(F.g_kv + 8 * l16 + 4);
    for (int m0 = 4 * gw; m0 < MT; m0 += 4 * NGW) {
        const int m = m0 + g4; const bf16* zr = F.Z + (size_t)m * ZP;
        const v4u zz = *(const GAS v4u*)(zr + ZC_KV + 8 * l16);
        const float x1 = bf2f(zr[ZC_KR + l16]), x2 = bf2f(zr[ZC_KR + 16 + l16]);
        const float rstd = rsq(F.SSQ_KV[m] * (1.f / KVL) + EPS);
        const int pi = m < MP ? (m & (SEQ - 1)) : SEQ + ((m - MP) & (DECT - 1));
        const float c = F.ROPE[(size_t)pi * 32 + l16], s = F.ROPE[(size_t)pi * 32 + 16 + l16];
        float* co = (m < MP ? F.out + O_CKVP + (size_t)m * KVL : F.out + O_CKVS + (size_t)(m - MP) * KVL) + 8 * l16;
        *(GAS f32x4*)co = (f32x4){bflo(zz.x) * rstd * gk0.x, bfhi(zz.x) * rstd * gk0.y, bflo(zz.y) * rstd * gk0.z, bfhi(zz.y) * rstd * gk0.w};
        *(GAS f32x4*)(co + 4) = (f32x4){bflo(zz.z) * rstd * gk1.x, bfhi(zz.z) * rstd * gk1.y, bflo(zz.w) * rstd * gk1.z, bfhi(zz.w) * rstd * gk1.w};
        const float o1 = x1 * c - x2 * s, o2 = x1 * s + x2 * c;
        float* ko = (m < MP ? F.out + O_KRP + (size_t)m * QR : F.out + O_KRS + (size_t)(m - MP) * QR);
        ko[l16] = o1; ko[16 + l16] = o2;
        F.KR[(size_t)m * 32 + l16] = (bf16)f2bf(o1); F.KR[(size_t)m * 32 + 16 + l16] = (bf16)f2bf(o2);
    }
}

__device__ __forceinline__ float logsig16(float x) { return (fminf(x, 0.f) - __logf(1.f + __expf(-fabsf(x)))) * 0.0625f; }
__device__ __forceinline__ void unpack8(const v4u w, float* f) { f[0] = bflo(w.x); f[1] = bfhi(w.x); f[2] = bflo(w.y); f[3] = bfhi(w.y); f[4] = bflo(w.z); f[5] = bfhi(w.z); f[6] = bflo(w.w); f[7] = bfhi(w.w); }

constexpr int TRI_CB = 4160, TRI_BYTES = 4 * TRI_CB;
__device__ __forceinline__ s16x4 tr_read(LAS const unsigned char* p) { typedef short v4i16_t __attribute__((ext_vector_type(4))); return __builtin_bit_cast(s16x4, __builtin_amdgcn_ds_read_tr16_b64_v4i16((LAS v4i16_t*)p)); }
__device__ __forceinline__ bf16x8 tri_frag(LAS const unsigned char* img, int cb, int ks, int lane) {
    const int hh = lane >> 5, g1 = (lane >> 4) & 1, i = lane & 15;
    LAS const unsigned char* p = img + cb * TRI_CB + (16 * ks + 4 * hh + (i >> 2)) * 64 + g1 * 32 + (i & 3) * 8;
    const s16x4 lo = tr_read(p), hi = tr_read(p + 512);
    return (bf16x8){lo[0], lo[1], lo[2], lo[3], hi[0], hi[1], hi[2], hi[3]};
}
__device__ __forceinline__ void tri_store(LAS unsigned char* img, int row, int c8, v4u v) { *(LAS v4u*)(img + (c8 >> 2) * TRI_CB + row * 64 + (c8 & 3) * 16) = v; }

struct GlLd { bf16x8 af; v4u q, k, v[2]; };
__device__ __forceinline__ void gla_local_load(Frame& F, const int unit, const int lane, GlLd& L) {
    const int c = unit & (NCH - 1), bh = unit >> 7, h = bh & 3, b = bh >> 2, tid = F.wave * 64 + lane;
    const size_t row0 = (size_t)b * SEQ + c * 64; const int t = tid >> 3, kg = tid & 7; const bf16* zr = F.Z + (row0 + t) * ZP;
    { const int w = F.wave, r32 = lane & 31, hh = lane >> 5; L.af = *(const GAS bf16x8*)(F.Z + (row0 + 32 * (w & 1) + r32) * ZP + ZC_AG + 8 * hh); }
    L.q = *(const GAS v4u*)(zr + ZC_QG + h * 64 + kg * 8); L.k = *(const GAS v4u*)(zr + ZC_KG + h * 64 + kg * 8);
#pragma unroll
    for (int i = 0; i < 2; ++i) { const int p = tid + 512 * i, tt = p >> 4, dch = p & 15; L.v[i] = *(const GAS v4u*)(F.Z + (row0 + tt) * ZP + ZC_VG + h * 128 + dch * 8); }
}
__device__ __forceinline__ void gla_local_compute(Frame& F, const int unit, const int lane, const GlLd& L) {
    const int c = unit & (NCH - 1), bh = unit >> 7, h = bh & 3, b = bh >> 2;
    const int row0 = b * SEQ + c * 64, tid = F.wave * 64 + lane;
    LAS float* LA = (LAS float*)F.lds;
    LAS float* SEG = (LAS float*)(F.lds + 16640);
    LAS unsigned char* KHI = F.lds + 20480;
    LAS unsigned char* VI = F.lds + 20480 + 2 * TRI_CB;
    if (F.wave < 4) { const int tb = F.wave & 1, kb = F.wave >> 1, r32 = lane & 31, hh = lane >> 5; const int col = h * 64 + 32 * kb + r32;
        const bf16x8 bfr = *(const GAS bf16x8*)(F.W2T + col * 16 + 8 * hh); const float bias = F.b_a[col];
        f32x16 x = {}; x = __builtin_amdgcn_mfma_f32_32x32x16_bf16(L.af, bfr, x, 0, 0, 0);
#pragma unroll
        for (int i = 0; i < 16; ++i) LA[(32 * tb + crow(i, hh)) * 65 + 32 * kb + r32] = logsig16(x[i] + bias); }
    __syncthreads();
    { const int k = tid & 63, seg = tid >> 6; float s = 0.f;
#pragma unroll
      for (int i = 0; i < 8; ++i) s += LA[(seg * 8 + i) * 65 + k];
      SEG[seg * 64 + k] = s;
      __syncthreads();
      float run = 0.f;
      for (int s2 = 0; s2 < seg; ++s2) run += SEG[s2 * 64 + k];
#pragma unroll
      for (int i = 0; i < 8; ++i) { run += LA[(seg * 8 + i) * 65 + k]; LA[(seg * 8 + i) * 65 + k] = run; } }
    __syncthreads();
    { const int t = tid >> 3, kg = tid & 7; const size_t row = (size_t)(row0 + t);
      float q[8], kk8[8]; unpack8(L.q, q); unpack8(L.k, kk8);
      float qt[8], kt[8], kh[8];
#pragma unroll
      for (int e = 0; e < 8; ++e) { const int k = kg * 8 + e; const float bv = LA[t * 65 + k], bl = LA[63 * 65 + k];
          qt[e] = q[e] * __expf(bv) * 0.125f; kt[e] = kk8[e] * __expf(-bv); kh[e] = kk8[e] * __expf(bl - bv); }
      v4u o; o.x = pk2(qt[0], qt[1]); o.y = pk2(qt[2], qt[3]); o.z = pk2(qt[4], qt[5]); o.w = pk2(qt[6], qt[7]);
      *(GAS v4u*)(F.QT + row * 256 + h * 64 + kg * 8) = o;
      o.x = pk2(kt[0], kt[1]); o.y = pk2(kt[2], kt[3]); o.z = pk2(kt[4], kt[5]); o.w = pk2(kt[6], kt[7]);
      *(GAS v4u*)(F.KT + row * 256 + h * 64 + kg * 8) = o;
      o.x = pk2(kh[0], kh[1]); o.y = pk2(kh[2], kh[3]); o.z = pk2(kh[4], kh[5]); o.w = pk2(kh[6], kh[7]);
      tri_store(KHI, t, kg, o);
#pragma unroll
      for (int i = 0; i < 2; ++i) { const int p = tid + 512 * i, tt = p >> 4, dch = p & 15; tri_store(VI, tt, dch, L.v[i]); }
      if (tid < 64) F.DEC[(size_t)unit * 64 + tid] = __expf(LA[63 * 65 + tid]); }
    __syncthreads();
    { const int mb = F.wave & 1, nb = F.wave >> 1, r = lane & 31, hh = lane >> 5; f32x16 acc = {};
#pragma unroll
      for (int ks = 0; ks < 4; ++ks) acc = __builtin_amdgcn_mfma_f32_32x32x16_bf16(tri_frag(KHI, mb, ks, lane), tri_frag(VI, nb, ks, lane), acc, 0, 0, 0);
      GAS bf16* up = (GAS bf16*)F.U + (size_t)unit * (GDK * GDV) + 32 * nb + r;
#pragma unroll
      for (int i = 0; i < 16; ++i) up[(size_t)(32 * mb + crow(i, hh)) * GDV] = (bf16)f2bf(acc[i]); }
    __syncthreads();
}
__device__ __forceinline__ void gla_local_phase(Frame& F) {
    int lane; FRESH_LANE_ID(lane);
    GlLd nxt; int u = F.vcu;
    if (u < NGU) gla_local_load(F, u, lane, nxt);
    for (; u < NGU; u += F.G) { const GlLd cur = nxt; if (u + F.G < NGU) gla_local_load(F, u + F.G, lane, nxt); gla_local_compute(F, u, lane, cur); }
}

__device__ __forceinline__ void gla_scan(Frame& F) {
    for (int e = F.vcu * NTHREADS + F.tid; e < NB * HG * GDK * GDV; e += F.G * NTHREADS) {
        const int bh = e >> 13, k = (e >> 7) & 63, dv = e & 127; float S = 0.f;
        const GAS bf16* up = (const GAS bf16*)F.U + (size_t)bh * NCH * (GDK * GDV) + k * GDV + dv; const float* dp = F.DEC + (size_t)bh * NCH * 64 + k; bf16* sp = F.SPREV + (size_t)bh * NCH * (GDK * GDV) + k * GDV + dv;
        for (int c0 = 0; c0 < NCH; c0 += 16) { float u[16], d[16];
#pragma unroll
            for (int i = 0; i < 16; ++i) { u[i] = bf2f(up[(size_t)(c0 + i) * (GDK * GDV)]); d[i] = dp[(size_t)(c0 + i) * 64]; }
#pragma unroll
            for (int i = 0; i < 16; ++i) { sp[(size_t)(c0 + i) * (GDK * GDV)] = (bf16)f2bf(S); S = d[i] * S + u[i]; } }
        F.out[O_GSP + (size_t)e] = S;
    }
}

struct GoLd { v4u sv[2], vv[2]; v2u qp[8]; bf16x8 qn[4]; bf16x8 kf[2][4]; v4u gate[2]; };
__device__ __forceinline__ void gla_out_load(Frame& F, const int unit, const int lane, GoLd& L) {
    const int c = unit & (NCH - 1), bh = unit >> 7, h = bh & 3, b = bh >> 2, w = F.wave, tid = w * 64 + lane, r = lane & 31, hh = lane >> 5, tb = w >> 2;
    const size_t row0 = (size_t)b * SEQ + c * 64;
#pragma unroll
    for (int i = 0; i < 2; ++i) { const int p = tid + 512 * i, row = p >> 4, c8 = p & 15;
        L.sv[i] = *(const GAS v4u*)(F.SPREV + (size_t)unit * (GDK * GDV) + row * GDV + c8 * 8);
        L.vv[i] = *(const GAS v4u*)(F.Z + (row0 + row) * ZP + ZC_VG + h * 128 + c8 * 8); }
    const bf16* qrow = F.QT + (row0 + 32 * tb + r) * 256 + h * 64;
#pragma unroll
    for (int ks = 0; ks < 4; ++ks) { L.qp[2 * ks] = *(const GAS v2u*)(qrow + 16 * ks + 4 * hh); L.qp[2 * ks + 1] = *(const GAS v2u*)(qrow + 16 * ks + 8 + 4 * hh); L.qn[ks] = *(const GAS bf16x8*)(qrow + 16 * ks + 8 * hh); }
#pragma unroll
    for (int sb = 0; sb < 2; ++sb) { const bf16* krow = F.KT + (row0 + 32 * sb + r) * 256 + h * 64;
#pragma unroll
        for (int ks = 0; ks < 4; ++ks) L.kf[sb][ks] = *(const GAS bf16x8*)(krow + 16 * ks + 8 * hh); }
    { const int t = tid >> 3, part = tid & 7; const bf16* gp = F.Z + (row0 + t) * ZP + ZC_GG + h * 128 + part * 16; L.gate[0] = *(const GAS v4u*)gp; L.gate[1] = *(const GAS v4u*)(gp + 8); }
}
__device__ __forceinline__ void gla_out_compute(Frame& F, const int unit, const int lane, const GoLd& L, const float (&gon)[16]) {
    const int c = unit & (NCH - 1), bh = unit >> 7, h = bh & 3, b = bh >> 2;
    const int row0 = b * SEQ + c * 64, tid = F.wave * 64 + lane, r = lane & 31, hh = lane >> 5;
    LAS unsigned char* SI = F.lds;
    LAS unsigned char* VI = F.lds + TRI_BYTES;
    LAS float* OS = (LAS float*)(F.lds + 2 * TRI_BYTES);
#pragma unroll
    for (int i = 0; i < 2; ++i) { const int p = tid + 512 * i, row = p >> 4, c8 = p & 15; tri_store(SI, row, c8, L.sv[i]); tri_store(VI, row, c8, L.vv[i]); }
    __syncthreads();
    const int dvb = F.wave & 3, tb = F.wave >> 2;
    f32x16 o = {};
#pragma unroll
    for (int ks = 0; ks < 4; ++ks) { const bf16x8 sf = tri_frag(SI, dvb, ks, lane);
        const v4u qw = {L.qp[2 * ks].x, L.qp[2 * ks].y, L.qp[2 * ks + 1].x, L.qp[2 * ks + 1].y};
        o = __builtin_amdgcn_mfma_f32_32x32x16_bf16(__builtin_bit_cast(bf16x8, qw), sf, o, 0, 0, 0); }
#pragma unroll
    for (int sb = 0; sb < 2; ++sb) if (sb <= tb) { f32x16 at = {};
#pragma unroll
        for (int ks = 0; ks < 4; ++ks) at = __builtin_amdgcn_mfma_f32_32x32x16_bf16(L.kf[sb][ks], L.qn[ks], at, 0, 0, 0);
        if (sb == tb) {
#pragma unroll
            for (int i = 0; i < 16; ++i) if (crow(i, hh) > r) at[i] = 0.f; }
#pragma unroll
        for (int k2 = 0; k2 < 2; ++k2) { v4u pw; pw.x = pk2(at[8 * k2 + 0], at[8 * k2 + 1]); pw.y = pk2(at[8 * k2 + 2], at[8 * k2 + 3]); pw.z = pk2(at[8 * k2 + 4], at[8 * k2 + 5]); pw.w = pk2(at[8 * k2 + 6], at[8 * k2 + 7]);
            o = __builtin_amdgcn_mfma_f32_32x32x16_bf16(__builtin_bit_cast(bf16x8, pw), tri_frag(VI, dvb, 2 * sb + k2, lane), o, 0, 0, 0); } }
#pragma unroll
    for (int i = 0; i < 16; ++i) OS[(32 * tb + crow(i, hh)) * 132 + 32 * dvb + r] = o[i];
    __syncthreads();
    { const int t = tid >> 3, part = tid & 7; const LAS float* orow = OS + t * 132 + part * 16; float v[16]; float ss = 0.f;
#pragma unroll
      for (int e = 0; e < 16; ++e) { v[e] = orow[e]; ss += v[e] * v[e]; }
      ss += __shfl_xor(ss, 1); ss += __shfl_xor(ss, 2); ss += __shfl_xor(ss, 4);
      const float rstd = rsq(ss * (1.f / GDV) + EPS);
      const size_t row = (size_t)(row0 + t); float g[16]; unpack8(L.gate[0], g); unpack8(L.gate[1], g + 8);
      float res[16];
#pragma unroll
      for (int e = 0; e < 16; ++e) res[e] = v[e] * rstd * gon[e] * siluf(g[e]);
      v4u w0, w1; w0.x = pk2(res[0], res[1]); w0.y = pk2(res[2], res[3]); w0.z = pk2(res[4], res[5]); w0.w = pk2(res[6], res[7]);
      w1.x = pk2(res[8], res[9]); w1.y = pk2(res[10], res[11]); w1.z = pk2(res[12], res[13]); w1.w = pk2(res[14], res[15]);
      bf16* mp = F.MIX + row * DM + 512 + h * 128 + part * 16; *(GAS v4u*)mp = w0; *(GAS v4u*)(mp + 8) = w1; }
    __syncthreads();
}
__device__ __forceinline__ void gla_out_phase(Frame& F) {
    int lane; FRESH_LANE_ID(lane);
    float gon[16];
#pragma unroll
    for (int e = 0; e < 16; ++e) gon[e] = F.g_on[(lane & 7) * 16 + e];
    GoLd nxt; int u = F.vcu;
    if (u < NGU) gla_out_load(F, u, lane, nxt);
    for (; u < NGU; u += F.G) { const GoLd cur = nxt; if (u + F.G < NGU) gla_out_load(F, u + F.G, lane, nxt); gla_out_compute(F, u, lane, cur, gon); }
}

__device__ __forceinline__ void gla_sample_unit(Frame& F, const int unit) {
    int ln_; FRESH_LANE_ID(ln_);
    const int h = unit & 3, b = unit >> 2, tid = F.wave * 64 + ln_; const int row0 = MP + b * DECT;
    LAS float* LA = (LAS float*)F.lds;
    LAS float* QS_ = LA + 512;
    LAS float* KS_ = QS_ + 512;
    LAS float* KH_ = KS_ + 512;
    LAS float* VS_ = KH_ + 512;
    LAS float* AI = VS_ + 1024;
    LAS float* RED = AI + 64;
    { const int t = tid >> 6, k = tid & 63; const bf16* zr = F.Z + (size_t)(row0 + t) * ZP;
      float a[16]; unpack8(*(const GAS v4u*)(zr + ZC_AG), a); unpack8(*(const GAS v4u*)(zr + ZC_AG + 8), a + 8);
      const int col = h * 64 + k; float x = F.b_a[col];
#pragma unroll
      for (int r = 0; r < 16; ++r) x += a[r] * F.w_a2[r * 256 + col];
      LA[t * 64 + k] = logsig16(x); }
    __syncthreads();
    if (tid < 64) { float run = 0.f;
#pragma unroll
        for (int t = 0; t < 8; ++t) { run += LA[t * 64 + tid]; LA[t * 64 + tid] = run; } }
    __syncthreads();
    { const int t = tid >> 6, k = tid & 63; const bf16* zr = F.Z + (size_t)(row0 + t) * ZP;
      const float bv = LA[t * 64 + k], bl = LA[7 * 64 + k], q = bf2f(zr[ZC_QG + h * 64 + k]), kk = bf2f(zr[ZC_KG + h * 64 + k]);
      QS_[t * 64 + k] = q * __expf(bv) * 0.125f; KS_[t * 64 + k] = kk * __expf(-bv); KH_[t * 64 + k] = kk * __expf(bl - bv);
#pragma unroll
      for (int i = 0; i < 2; ++i) { const int p = tid + 512 * i, tt = p >> 7, dv = p & 127; VS_[tt * 128 + dv] = bf2f(F.Z[(size_t)(row0 + tt) * ZP + ZC_VG + h * 128 + dv]); } }
    __syncthreads();
    if (tid < 64) { const int t = tid >> 3, s = tid & 7; float a = 0.f;
        if (s <= t) {
#pragma unroll 8
            for (int k = 0; k < 64; ++k) a += QS_[t * 64 + k] * KS_[s * 64 + k]; }
        AI[t * 8 + s] = a; }
    { const int kq = tid >> 7, dv = tid & 127; const float* s0p = F.state_gla + (((size_t)b * HG + h) * GDK + kq * 16) * GDV + dv; float* snp = F.out + O_GSS + (((size_t)b * HG + h) * GDK + kq * 16) * GDV + dv;
      float s0[16];
#pragma unroll
      for (int kk = 0; kk < 16; ++kk) s0[kk] = s0p[(size_t)kk * GDV];
      float po[8];
#pragma unroll
      for (int t = 0; t < 8; ++t) { float a = 0.f;
#pragma unroll
          for (int kk = 0; kk < 16; ++kk) a += QS_[t * 64 + kq * 16 + kk] * s0[kk];
          po[t] = a; }
#pragma unroll
      for (int t = 0; t < 8; ++t) RED[(kq * 8 + t) * 128 + dv] = po[t];
#pragma unroll
      for (int kk = 0; kk < 16; ++kk) { const int k = kq * 16 + kk; float sn = __expf(LA[7 * 64 + k]) * s0[kk];
#pragma unroll
          for (int t = 0; t < 8; ++t) sn += KH_[t * 64 + k] * VS_[t * 128 + dv];
          snp[(size_t)kk * GDV] = sn; } }
    __syncthreads();
    { const int t = tid >> 6, j = tid & 63; float ov[2]; float ss = 0.f;
#pragma unroll
      for (int i = 0; i < 2; ++i) { const int dv = j + 64 * i; float o = RED[(0 * 8 + t) * 128 + dv] + RED[(1 * 8 + t) * 128 + dv] + RED[(2 * 8 + t) * 128 + dv] + RED[(3 * 8 + t) * 128 + dv];
          for (int s = 0; s <= t; ++s) o += AI[t * 8 + s] * VS_[s * 128 + dv];
          ov[i] = o; ss += o * o; }
      const float rstd = rsq(wave_sum(ss) * (1.f / GDV) + EPS); const size_t row = (size_t)(row0 + t);
#pragma unroll
      for (int i = 0; i < 2; ++i) { const int dv = j + 64 * i; const float g = bf2f(F.Z[row * ZP + ZC_GG + h * 128 + dv]);
          F.MIX[row * DM + 512 + h * 128 + dv] = (bf16)f2bf(ov[i] * rstd * F.g_on[dv] * siluf(g)); } }
    __syncthreads();
}

constexpr int AT_KSLOT = 12288, AT_VSLOT = 8192, AT_V0 = 4 * AT_KSLOT, AT_WSF = AT_V0 + 3 * AT_VSLOT, AT_OST = AT_WSF + NWAVES * 256, AT_END = AT_OST + NWAVES * 4096;
static_assert(AT_END <= RING_BYTES, "attention LDS");
__device__ __forceinline__ float max16(const f32x16& p) {
    float a = fmaxf(fmaxf(p[0], p[1]), fmaxf(p[2], p[3])), b = fmaxf(fmaxf(p[4], p[5]), fmaxf(p[6], p[7]));
    float c = fmaxf(fmaxf(p[8], p[9]), fmaxf(p[10], p[11])), d = fmaxf(fmaxf(p[12], p[13]), fmaxf(p[14], p[15]));
    return fmaxf(fmaxf(a, b), fmaxf(c, d));
}
__device__ __forceinline__ bf16x8 pack_p(const f32x16& p, int base) {
    v4u w; w.x = pk2(p[base + 0], p[base + 1]); w.y = pk2(p[base + 2], p[base + 3]); w.z = pk2(p[base + 4], p[base + 5]); w.w = pk2(p[base + 6], p[base + 7]); return __builtin_bit_cast(bf16x8, w);
}
#ifndef AT_STHR
#define AT_STHR 1024.0f
#endif
#define AT_SBAR() __builtin_amdgcn_sched_barrier(0)
#define AT_PIN(x) asm volatile("" : "+v"(x))
#define AT_MFMA(a, b, c) __builtin_amdgcn_mfma_f32_32x32x16_bf16(a, b, c, 0, 0, 0)
#define AT_WAIT_BAR(N) asm volatile("s_waitcnt vmcnt(" #N ") lgkmcnt(0)\n\ts_barrier" ::: "memory")
__device__ __forceinline__ void at_glds16(const char* sbase, unsigned voff, unsigned lds_base) {
    unsigned sv; asm volatile("s_mov_b32 %0, m0\n\ts_mov_b32 m0, %3\n\ts_nop 0\n\tglobal_load_lds_dwordx4 %1, %2\n\ts_mov_b32 m0, %0" : "=&s"(sv) : "v"(voff), "s"(sbase), "s"(lds_base) : "memory"); }
__device__ __forceinline__ void at_kload2(bf16x8* kf, LAS const unsigned char* kp, int d0) { kf[2 * d0] = *(const LAS bf16x8*)(kp + d0 * 2048); kf[2 * d0 + 1] = *(const LAS bf16x8*)(kp + d0 * 2048 + 512); }
#define AT_MX3(a, b, c) __builtin_fmaxf(__builtin_fmaxf((a), (b)), (c))
__device__ __forceinline__ float at_rowmax(const f32x16& p0, const f32x16& p1) {
    float a = AT_MX3(p0[0], p0[1], p1[0]), b = AT_MX3(p0[2], p0[3], p1[1]); a = AT_MX3(a, p1[2], p1[3]);
#pragma unroll
    for (int r = 4; r < 16; r += 4) { a = AT_MX3(a, p0[r], p0[r + 1]); b = AT_MX3(b, p0[r + 2], p0[r + 3]); a = AT_MX3(a, p1[r], p1[r + 1]); b = AT_MX3(b, p1[r + 2], p1[r + 3]); }
    float m = __builtin_fmaxf(a, b); auto rr = __builtin_amdgcn_permlane32_swap(__float_as_uint(m), __float_as_uint(m), false, false);
    return __builtin_fmaxf(__uint_as_float(rr[0]), __uint_as_float(rr[1])); }
__device__ __forceinline__ void at_cmask(f32x16& p0, f32x16& p1, int jb, int qrel, int hi) {
    const int d_ = qrel - 64 * jb - 4 * hi;
#pragma unroll
    for (int i = 0; i < 16; ++i) { if ((i & 3) + 8 * (i >> 2) > d_) p0[i] = -INFINITY; if ((i & 3) + 8 * (i >> 2) + 32 > d_) p1[i] = -INFINITY; } }
__device__ __forceinline__ void attn_prompt_unit(Frame& F, const int b, const int h, const int qb) {
    int ln_; FRESH_LANE_ID(ln_);
    const int lane = ln_, w = F.wave, r32 = lane & 31, hi = lane >> 5;
    const size_t R0 = (size_t)b * SEQ; const int q0 = qb * 256;
    LAS unsigned char* const lds = F.lds; const unsigned lds0 = (unsigned)(size_t)lds;
    LAS float* wsf = (LAS float*)(lds + AT_WSF) + w * 64;
    const int NT = 4 * (qb + 1);
    const char* const qbase = (const char*)(F.QP + (R0 + q0) * 768);
    const unsigned qoff = (unsigned)((32 * w + r32) * 768 + 8 * hi) * 2u;
    bf16x8 qr[6];
#pragma unroll
    for (int d0 = 0; d0 < 4; ++d0) qr[d0] = *(const GAS bf16x8*)(qbase + (qoff + (unsigned)(h * 64 + 16 * d0) * 2u));
#pragma unroll
    for (int d0 = 4; d0 < 6; ++d0) qr[d0] = *(const GAS bf16x8*)(qbase + (qoff + (unsigned)(512 + h * 32 + 16 * (d0 - 4)) * 2u));
    const char* const kbase = (const char*)(F.KN + R0 * 512 + h * 64);
    const char* const rbase = (const char*)(F.KR + R0 * 32);
    const char* const vbase = (const char*)(F.VV + R0 * 512 + h * 64);
    const unsigned koff = (unsigned)(lane * 512 + w * 8) * 2u, roff = (unsigned)(lane * 32 + (w & 3) * 8) * 2u;
    const unsigned voff = (unsigned)((16 * (w & 3) + (lane >> 2)) * 512 + (w >> 2) * 32 + (lane & 3) * 8) * 2u;
    const unsigned kdst = lds0 + w * 1024, rdst = lds0 + (8 + (w & 3)) * 1024, vdst = lds0 + AT_V0 + w * 1024;
#define AT_DMA_K(t, slot) do { at_glds16(kbase + (size_t)(t) * 65536u, koff, (unsigned)__builtin_amdgcn_readfirstlane(kdst + (slot) * AT_KSLOT)); \
                               at_glds16(rbase + (size_t)(t) * 4096u, roff, (unsigned)__builtin_amdgcn_readfirstlane(rdst + (slot) * AT_KSLOT)); } while (0)
#define AT_DMA_V(t, slot) at_glds16(vbase + (size_t)(t) * 65536u, voff, (unsigned)__builtin_amdgcn_readfirstlane(vdst + (slot) * AT_VSLOT))
    LAS const unsigned char* const vp0 = lds + AT_V0 + ((lane >> 4) & 1) * 32 + (lane & 3) * 8 + (4 * hi + ((lane & 15) >> 2)) * 64;
    LAS const unsigned char* const kp0 = lds + hi * 1024 + r32 * 16;
    AT_DMA_K(0, 0); AT_DMA_V(0, 0); AT_DMA_K(1, 1); AT_DMA_K(2, 2);
    float nm, l_reg = 0.f, slast = 0.f; f32x16 o[2]; o[0] = f32x16{}; o[1] = f32x16{};
    f32x16 negm;
    const int qrel = w * 32 + r32; bool resc = false;
    f32x16 pA0, pA1, pB0, pB1; bf16x8 kf[12]; s16x4 vlo[8], vhi[8]; v4u pw0, pw1, pw2, pw3;
    int vs_prev = 0, vs_cur = 0, vs_next = 1;
#define AT_ROT() do { vs_prev = vs_cur; vs_cur = vs_next; vs_next = (vs_next == 2) ? 0 : vs_next + 1; } while (0)
#define AT_EX(v) __builtin_amdgcn_exp2f(v)
#define AT_RESC() do { if (resc) { _Pragma("unroll") for (int d_ = 0; d_ < 2; ++d_) _Pragma("unroll") for (int r = 0; r < 16; ++r) o[d_][r] *= wsf[crow(r, hi)]; } } while (0)
    AT_WAIT_BAR(5);
    { const f32x16 z = f32x16{};
      at_kload2(kf, kp0, 0); pA0 = AT_MFMA(kf[0], qr[0], z); pA1 = AT_MFMA(kf[1], qr[0], z);
#pragma unroll
      for (int d0 = 1; d0 < 6; ++d0) { at_kload2(kf, kp0, d0); pA0 = AT_MFMA(kf[2 * d0], qr[d0], pA0); pA1 = AT_MFMA(kf[2 * d0 + 1], qr[d0], pA1); } }
    if (NT == 4) at_cmask(pA0, pA1, 0, qrel, hi);
    { const float rm = at_rowmax(pA0, pA1); nm = -rm;
#pragma unroll
      for (int r = 0; r < 16; ++r) { pA0[r] = AT_EX(pA0[r] + nm); pA1[r] = AT_EX(pA1[r] + nm); negm[r] = nm; } }
    AT_PIN(negm);
    AT_WAIT_BAR(0);
    AT_DMA_K(3, 3); AT_DMA_V(1, 1); AT_ROT();
    at_kload2(kf, kp0 + AT_KSLOT, 0); at_kload2(kf, kp0 + AT_KSLOT, 1);
#define AT_PKW(P, i) pk2(P[i], P[i + 1])
#define AT_PAF(k) __builtin_bit_cast(bf16x8, pw##k)
#define AT_VFR(i) (bf16x8){vlo[i][0], vlo[i][1], vlo[i][2], vlo[i][3], vhi[i][0], vhi[i][1], vhi[i][2], vhi[i][3]}
#define AT_VRD(i) do { vlo[i] = tr_read(vp_ + (((i) >> 2) * 4096 + ((i) & 3) * 1024)); vhi[i] = tr_read(vp_ + (((i) >> 2) * 4096 + ((i) & 3) * 1024 + 512)); } while (0)
#define AT_KJ(d0) at_kload2(kf, kp_, d0)
#define AT_KRD(G, d0) do { if (G) { at_kload2(kf, kn_, d0); } } while (0)
#define AT_GAPM(MF, RD) do { MF; RD; AT_SBAR(); } while (0)
#define AT_GAPB(MF, RD, X, i) do { MF; RD; X[i] = AT_EX(X[i]); X[i + 1] = AT_EX(X[i + 1]); X[i + 2] = AT_EX(X[i + 2]); X[i + 3] = AT_EX(X[i + 3]); AT_PIN(X); AT_SBAR(); } while (0)
#define AT_STEP(C0, C1, P0, P1, t, MASK, GK, GV, GL) do { AT_SBAR(); \
    LAS const unsigned char* const vp_ = vp0 + vs_prev * AT_VSLOT; LAS const unsigned char* const kp_ = kp0 + ((t) & 3) * AT_KSLOT; LAS const unsigned char* const kn_ = kp0 + (((t) + 1) & 3) * AT_KSLOT; \
    float sacc = P0[0] + P0[1]; \
    C0 = AT_MFMA(kf[0], qr[0], negm); AT_KJ(2); float smrg = slast + xor32(slast, hi != 0); sacc += P0[2]; sacc += P0[3]; pw0[0] = pk2(P0[0], P0[1]); AT_PIN(pw0); AT_PIN(smrg); AT_PIN(sacc); AT_SBAR(); \
    C1 = AT_MFMA(kf[1], qr[0], negm); (void)0; sacc += P0[4]; sacc += P0[5]; sacc += P0[6]; pw0[1] = pk2(P0[2], P0[3]); AT_PIN(pw0); AT_PIN(sacc); AT_SBAR(); \
    C0 = AT_MFMA(kf[2], qr[1], C0); AT_KJ(3); sacc += P0[7]; sacc += P0[8]; sacc += P0[9]; pw0[2] = pk2(P0[4], P0[5]); AT_PIN(pw0); AT_PIN(sacc); AT_SBAR(); \
    C1 = AT_MFMA(kf[3], qr[1], C1); (void)0; sacc += P0[10]; sacc += P0[11]; sacc += P0[12]; pw0[3] = pk2(P0[6], P0[7]); AT_PIN(pw0); AT_PIN(sacc); AT_SBAR(); \
    C0 = AT_MFMA(kf[4], qr[2], C0); AT_KJ(4); sacc += P0[13]; sacc += P0[14]; sacc += P0[15]; pw1[0] = pk2(P0[8], P0[9]); AT_PIN(pw1); AT_PIN(sacc); AT_SBAR(); \
    C1 = AT_MFMA(kf[5], qr[2], C1); (void)0; sacc += P1[0]; sacc += P1[1]; sacc += P1[2]; pw1[1] = pk2(P0[10], P0[11]); AT_PIN(pw1); AT_PIN(sacc); AT_SBAR(); \
    C0 = AT_MFMA(kf[6], qr[3], C0); AT_KJ(5); sacc += P1[3]; sacc += P1[4]; sacc += P1[5]; pw1[2] = pk2(P0[12], P0[13]); AT_PIN(pw1); AT_PIN(sacc); AT_SBAR(); \
    C1 = AT_MFMA(kf[7], qr[3], C1); (void)0; sacc += P1[6]; sacc += P1[7]; sacc += P1[8]; pw1[3] = pk2(P0[14], P0[15]); AT_PIN(pw1); AT_PIN(sacc); AT_SBAR(); \
    C0 = AT_MFMA(kf[8], qr[4], C0); AT_VRD(0); sacc += P1[9]; sacc += P1[10]; pw2[0] = pk2(P1[0], P1[1]); pw2[1] = pk2(P1[2], P1[3]); AT_PIN(pw2); AT_PIN(sacc); AT_SBAR(); \
    C1 = AT_MFMA(kf[9], qr[4], C1); AT_VRD(4); sacc += P1[11]; sacc += P1[12]; pw2[2] = pk2(P1[4], P1[5]); pw2[3] = pk2(P1[6], P1[7]); AT_PIN(pw2); AT_PIN(sacc); AT_SBAR(); \
    C0 = AT_MFMA(kf[10], qr[5], C0); AT_VRD(1); sacc += P1[13]; sacc += P1[14]; pw3[0] = pk2(P1[8], P1[9]); pw3[1] = pk2(P1[10], P1[11]); AT_PIN(pw3); AT_PIN(sacc); AT_SBAR(); \
    C1 = AT_MFMA(kf[11], qr[5], C1); AT_VRD(5); sacc += P1[15]; pw3[2] = pk2(P1[12], P1[13]); pw3[3] = pk2(P1[14], P1[15]); AT_PIN(pw3); AT_PIN(sacc); AT_SBAR(); \
    l_reg += sacc; \
    if (GK) AT_DMA_K((t) + 3, ((t) + 3) & 3); if (GV) AT_DMA_V((t) + 1, vs_next); \
    if (MASK) at_cmask(C0, C1, (t) - (NT - 4), qrel, hi); \
    resc = false; slast = sacc;                                                                                            \
    if (__builtin_expect(__any(smrg > AT_STHR), 0)) { const float dl = __builtin_fmaxf(__builtin_amdgcn_logf(smrg), 0.f); nm -= dl;     \
        const float f = __builtin_amdgcn_exp2f(-dl); l_reg *= f; slast *= f; if (hi == 0) wsf[r32] = f; resc = true; \
        _Pragma("unroll") for (int r = 0; r < 16; ++r) { C0[r] -= dl; C1[r] -= dl; negm[r] = nm; } } \
    AT_PIN(negm); AT_SBAR(); \
    AT_GAPB(o[0] = AT_MFMA(AT_PAF(0), AT_VFR(0), o[0]), AT_VRD(2), C0, 0); \
    AT_GAPB(o[1] = AT_MFMA(AT_PAF(0), AT_VFR(4), o[1]), AT_VRD(6), C0, 4); \
    AT_GAPB(o[0] = AT_MFMA(AT_PAF(1), AT_VFR(1), o[0]), AT_VRD(3), C0, 8); \
    AT_GAPB(o[1] = AT_MFMA(AT_PAF(1), AT_VFR(5), o[1]), AT_VRD(7), C0, 12); \
    AT_GAPB(o[0] = AT_MFMA(AT_PAF(2), AT_VFR(2), o[0]), AT_KRD(GL, 0), C1, 0); \
    AT_GAPB(o[1] = AT_MFMA(AT_PAF(2), AT_VFR(6), o[1]), AT_KRD(GL, 1), C1, 4); \
    AT_GAPB(o[0] = AT_MFMA(AT_PAF(3), AT_VFR(3), o[0]), (void)0, C1, 8); \
    AT_GAPB(o[1] = AT_MFMA(AT_PAF(3), AT_VFR(7), o[1]), (void)0, C1, 12); \
    } while (0)
    int t = 1;
    for (; t + 5 < NT; t += 2) {
        AT_STEP(pB0, pB1, pA0, pA1, t, false, true, true, true);     AT_WAIT_BAR(3); AT_RESC(); AT_ROT();
        AT_STEP(pA0, pA1, pB0, pB1, t + 1, false, true, true, true); AT_WAIT_BAR(3); AT_RESC(); AT_ROT();
    }
#define AT_ENDW(tt) do { if ((tt) + 3 < NT) { AT_WAIT_BAR(3); } else if ((tt) + 2 < NT) { AT_WAIT_BAR(1); } else { AT_WAIT_BAR(0); } } while (0)
    for (; t + 1 < NT; t += 2) {
        AT_STEP(pB0, pB1, pA0, pA1, t, true, (t + 3 < NT), (t + 1 < NT), (t + 1 < NT));         AT_ENDW(t);     AT_RESC(); AT_ROT();
        AT_STEP(pA0, pA1, pB0, pB1, t + 1, true, (t + 4 < NT), (t + 2 < NT), (t + 2 < NT));     AT_ENDW(t + 1); AT_RESC(); AT_ROT();
    }
    AT_STEP(pB0, pB1, pA0, pA1, NT - 1, true, false, false, false); AT_RESC();
    { float sacc = pB0[0] + pB0[1];
#pragma unroll
      for (int r = 2; r < 16; ++r) sacc += pB0[r];
#pragma unroll
      for (int r = 0; r < 16; ++r) sacc += pB1[r];
      l_reg += sacc;
      pw0 = (v4u){AT_PKW(pB0, 0), AT_PKW(pB0, 2), AT_PKW(pB0, 4), AT_PKW(pB0, 6)}; pw1 = (v4u){AT_PKW(pB0, 8), AT_PKW(pB0, 10), AT_PKW(pB0, 12), AT_PKW(pB0, 14)};
      pw2 = (v4u){AT_PKW(pB1, 0), AT_PKW(pB1, 2), AT_PKW(pB1, 4), AT_PKW(pB1, 6)}; pw3 = (v4u){AT_PKW(pB1, 8), AT_PKW(pB1, 10), AT_PKW(pB1, 12), AT_PKW(pB1, 14)};
      LAS const unsigned char* const vp_ = vp0 + vs_cur * AT_VSLOT; _Pragma("unroll") for (int i = 0; i < 8; ++i) AT_VRD(i);
      o[0] = AT_MFMA(AT_PAF(0), AT_VFR(0), o[0]); o[1] = AT_MFMA(AT_PAF(0), AT_VFR(4), o[1]); o[0] = AT_MFMA(AT_PAF(1), AT_VFR(1), o[0]); o[1] = AT_MFMA(AT_PAF(1), AT_VFR(5), o[1]);
      o[0] = AT_MFMA(AT_PAF(2), AT_VFR(2), o[0]); o[1] = AT_MFMA(AT_PAF(2), AT_VFR(6), o[1]); o[0] = AT_MFMA(AT_PAF(3), AT_VFR(3), o[0]); o[1] = AT_MFMA(AT_PAF(3), AT_VFR(7), o[1]); }
#undef AT_KJ
#undef AT_DMA_K
#undef AT_DMA_V
#undef AT_ROT
#undef AT_EX
#undef AT_RESC
#undef AT_PKW
#undef AT_PAF
#undef AT_VFR
#undef AT_VRD
#undef AT_KRD
#undef AT_ENDW
#undef AT_GAPM
#undef AT_GAPB
#undef AT_STEP
    float l = l_reg; l += xor32(l, hi != 0);
    if (hi == 0) wsf[32 + r32] = l;
    LAS bf16* stg = (LAS bf16*)(lds + AT_OST) + w * 2048;
#pragma unroll
    for (int i = 0; i < 16; ++i) { const int orow = crow(i, hi); const float rl = __builtin_amdgcn_rcpf(wsf[32 + orow]);
        stg[orow * 64 + r32] = (bf16)f2bf(o[0][i] * rl); stg[orow * 64 + 32 + r32] = (bf16)f2bf(o[1][i] * rl); }
#pragma unroll
    for (int i = 0; i < 4; ++i) { const int row = i * 8 + (lane >> 3), c8 = lane & 7; const unsigned lrow = (unsigned)(32 * w + row);
        const char* const gbase = (const char*)(F.Z + (R0 + q0) * ZP + ZC_GM + h * 64); char* const mbase = (char*)(F.MIX + (R0 + q0) * DM + h * 64);
        float ov[8], g[8]; unpack8(*(const LAS v4u*)(stg + row * 64 + c8 * 8), ov); unpack8(*(const GAS v4u*)(gbase + (lrow * (unsigned)ZP + c8 * 8) * 2u), g);
        v4u ovv; ovv.x = pk2(ov[0] * siluf(g[0]), ov[1] * siluf(g[1])); ovv.y = pk2(ov[2] * siluf(g[2]), ov[3] * siluf(g[3])); ovv.z = pk2(ov[4] * siluf(g[4]), ov[5] * siluf(g[5])); ovv.w = pk2(ov[6] * siluf(g[6]), ov[7] * siluf(g[7]));
        *(GAS v4u*)(mbase + (lrow * (unsigned)DM + c8 * 8) * 2u) = ovv; }
    __syncthreads();
}

constexpr int DC_RCH = 2064, DC_RI = 32768, DC_BUF = DC_RI + 4 * DC_RCH + 192, DC_WSF = 2 * DC_BUF, DC_END = DC_WSF + NWAVES * 256;
static_assert(DC_BUF % 256 == 0 && DC_END <= RING_BYTES, "decode LDS");
__device__ __forceinline__ void decode_unit(Frame& F, const int b, const int sp) {
    int ln_; FRESH_LANE_ID(ln_);
    const int lane = ln_, w = F.wave, tid = w * 64 + lane, r32 = lane & 31, hi = lane >> 5, rh = w & 1, kg = w >> 1;
    LAS unsigned char* const lds = F.lds;
    LAS float* wsf = (LAS float*)(lds + DC_WSF) + w * 64;
    const int qi = 32 * rh + r32, tq = qi >> 3, hq = qi & 7;
    const bf16* qrow = F.QS + (size_t)(b * DECT + tq) * 1280;
    bf16x8 qf[10];
#pragma unroll
    for (int d0 = 0; d0 < 8; ++d0) qf[d0] = *(const GAS bf16x8*)(qrow + hq * 128 + 16 * d0 + 8 * hi);
#pragma unroll
    for (int d0 = 8; d0 < 10; ++d0) qf[d0] = *(const GAS bf16x8*)(qrow + 1024 + hq * 32 + 16 * (d0 - 8) + 8 * hi);
    const int* pt = F.page_table + b * NPAGES + sp * (NPAGES / DSPLIT);
    f32x4 cr[8], kr[2];
#define DC_LOAD(j) do { const size_t pg_ = (size_t)pt[j]; const GAS f32x4* c_ = (const GAS f32x4*)(F.cache_ckv + pg_ * (PAGE * KVL)) + tid; const GAS f32x4* k_ = (const GAS f32x4*)(F.cache_kr + pg_ * (PAGE * QR)) + tid; \
        _Pragma("unroll") for (int i_ = 0; i_ < 8; ++i_) cr[i_] = __builtin_nontemporal_load(c_ + 512 * i_); kr[0] = __builtin_nontemporal_load(k_); kr[1] = __builtin_nontemporal_load(k_ + 512); } while (0)
    const int skb = tid >> 5, sc4 = tid & 31, sch = sc4 >> 1;
    const int st_c = 2048 * (skb >> 3) + 512 * (sch >> 2) + 64 * (skb & 7) + 16 * ((sch & 3) ^ ((skb >> 2) & 3)) + 8 * (sc4 & 1);
    const int st_r = DC_RI + ((tid & 7) >> 1) * DC_RCH + (tid >> 3) * 16 + (tid & 1) * 8;
    const int kr_b = 8192 * kg + 2048 * (r32 >> 3) + 64 * (r32 & 7);
    const int kr_e = kr_b + 16 * (hi ^ ((r32 >> 2) & 3)), kr_o = kr_b + 16 * ((2 + hi) ^ ((r32 >> 2) & 3));
    const int kr_r = DC_RI + hi * DC_RCH + (32 * kg + r32) * 16;
    const int vq = (lane & 15) >> 2, vp = lane & 3, vC = 2 * ((lane >> 4) & 1) + (vp >> 1);
    const int vr_b = 8192 * kg + 64 * (4 * hi + vq) + 8 * (vp & 1);
    const int vr_lo = vr_b + 16 * (vC ^ hi), vr_hi = vr_b + 2048 + 16 * (vC ^ (2 + hi));
#define DC_STORE(buf) do { LAS unsigned char* ib_ = lds + (buf) * DC_BUF; \
        _Pragma("unroll") for (int i = 0; i < 8; ++i) { const v2u wv = {pk2(cr[i].x, cr[i].y), pk2(cr[i].z, cr[i].w)}; *(LAS v2u*)(ib_ + st_c + 4096 * i) = wv; } \
        _Pragma("unroll") for (int i = 0; i < 2; ++i) { const v2u wv = {pk2(kr[i].x, kr[i].y), pk2(kr[i].z, kr[i].w)}; *(LAS v2u*)(ib_ + st_r + 1024 * i) = wv; } } while (0)
#define DC_COMPUTE(buf) do { LAS const unsigned char* ib_ = lds + (buf) * DC_BUF; \
        bf16x8 kf[10]; \
        _Pragma("unroll") for (int d0 = 0; d0 < 8; ++d0) kf[d0] = *(const LAS bf16x8*)(ib_ + ((d0 & 1) ? kr_o : kr_e) + 512 * (d0 >> 1)); \
        kf[8] = *(const LAS bf16x8*)(ib_ + kr_r); kf[9] = *(const LAS bf16x8*)(ib_ + kr_r + 2 * DC_RCH); \
        __builtin_amdgcn_sched_barrier(0); \
        f32x16 p = {}; \
        _Pragma("unroll") for (int d0 = 0; d0 < 10; ++d0) p = __builtin_amdgcn_mfma_f32_32x32x16_bf16(kf[d0], qf[d0], p, 0, 0, 0); \
        float rm = max16(p); rm = fmaxf(rm, xor32(rm, hi != 0)); \
        const float mn = fmaxf(m, rm); \
        if (__any(mn > m)) { const float al = fast_exp2(m - mn); l *= al; if (hi == 0) wsf[r32] = al; \
            _Pragma("unroll") for (int i = 0; i < 16; ++i) { const float f = wsf[crow(i, hi)]; o[0][i] *= f; o[1][i] *= f; o[2][i] *= f; o[3][i] *= f; } } \
        m = mn; \
        float ls = 0.f; \
        _Pragma("unroll") for (int i = 0; i < 16; ++i) { p[i] = fast_exp2(p[i] - m); ls += p[i]; } \
        l += ls; \
        const bf16x8 pa0 = pack_p(p, 0), pa1 = pack_p(p, 8); \
        _Pragma("unroll") for (int cb = 0; cb < 4; ++cb) \
            _Pragma("unroll") for (int ks2 = 0; ks2 < 2; ++ks2) { const s16x4 lo = tr_read(ib_ + vr_lo + 4096 * ks2 + 512 * cb), hi4 = tr_read(ib_ + vr_hi + 4096 * ks2 + 512 * cb); \
                o[cb] = __builtin_amdgcn_mfma_f32_32x32x16_bf16(ks2 == 0 ? pa0 : pa1, (bf16x8){lo[0], lo[1], lo[2], lo[3], hi4[0], hi4[1], hi4[2], hi4[3]}, o[cb], 0, 0, 0); } } while (0)
#define DC_LBAR() asm volatile("s_waitcnt lgkmcnt(0)\n\ts_barrier" ::: "memory")
    f32x16 o[4]; o[0] = f32x16{}; o[1] = f32x16{}; o[2] = f32x16{}; o[3] = f32x16{};
    float m = -1e30f, l = 0.f;
    constexpr int NPG = NPAGES / DSPLIT;
    DC_LOAD(0); DC_STORE(0); DC_LOAD(1);
    DC_LBAR();
    for (int j = 0; j < NPG; ++j) {
        const int cur = j & 1;
        if (w >= 4 && j + 1 < NPG) { DC_STORE(cur ^ 1); if (j + 2 < NPG) DC_LOAD(j + 2); }
        DC_COMPUTE(cur);
        if (w < 4 && j + 1 < NPG) { DC_STORE(cur ^ 1); if (j + 2 < NPG) DC_LOAD(j + 2); }
        DC_LBAR();
    }
#undef DC_LOAD
#undef DC_STORE
#undef DC_COMPUTE
#undef DC_LBAR
    l += xor32(l, hi != 0);
    const int part = sp * 4 + kg;
    float* pp = F.PART + ((size_t)(b * DPART + part) * 64 + 32 * rh) * 128 + r32;
#pragma unroll
    for (int cb = 0; cb < 4; ++cb)
#pragma unroll
        for (int i = 0; i < 16; ++i) pp[(size_t)crow(i, hi) * 128 + 32 * cb] = o[cb][i];
    if (hi == 0) { float* ml = F.ML + ((size_t)(b * DPART + part) * 64 + 32 * rh + r32) * 2; ml[0] = m; ml[1] = l; }
}

__device__ __forceinline__ void decode_combine_unit(Frame& F, const int b) {
    int ln_; FRESH_LANE_ID(ln_);
    const int tid = F.wave * 64 + ln_, i = tid >> 3, part = tid & 7, t = i >> 3, h = i & 7;
    LAS float* SC = (LAS float*)F.lds;
    LAS float* OL = SC + 512;
    const bf16* qrow = F.QS + (size_t)(b * DECT + t) * 1280;
    { float s = -INFINITY;
      if (part <= t) { const float* ck = F.out + O_CKVS + (size_t)(b * DECT + part) * KVL; const float* kr = F.out + O_KRS + (size_t)(b * DECT + part) * QR; float a = 0.f;
          for (int c = 0; c < 128; c += 8) { float q8[8]; unpack8(*(const GAS v4u*)(qrow + h * 128 + c), q8);
#pragma unroll
              for (int e = 0; e < 8; ++e) a += q8[e] * ck[c + e]; }
          for (int c = 0; c < 32; c += 8) { float q8[8]; unpack8(*(const GAS v4u*)(qrow + 1024 + h * 32 + c), q8);
#pragma unroll
              for (int e = 0; e < 8; ++e) a += q8[e] * kr[c + e]; }
          s = a; }
      SC[i * 8 + part] = s; }
    __syncthreads();
    float M = -1e30f; float mp[DPART], lp[DPART], sj[8];
#pragma unroll
    for (int p = 0; p < DPART; ++p) { const float* ml = F.ML + ((size_t)(b * DPART + p) * 64 + i) * 2; mp[p] = ml[0]; lp[p] = ml[1]; M = fmaxf(M, mp[p]); }
#pragma unroll
    for (int j = 0; j < 8; ++j) { sj[j] = SC[i * 8 + j]; M = fmaxf(M, sj[j]); }
    float L = 0.f;
#pragma unroll
    for (int p = 0; p < DPART; ++p) { mp[p] = fast_exp2(mp[p] - M); L += mp[p] * lp[p]; }
#pragma unroll
    for (int j = 0; j < 8; ++j) { sj[j] = fast_exp2(sj[j] - M); L += sj[j]; }
    { float acc[16];
#pragma unroll
      for (int e = 0; e < 16; ++e) acc[e] = 0.f;
#pragma unroll
      for (int p = 0; p < DPART; ++p) { const GAS f32x4* src = (const GAS f32x4*)(F.PART + ((size_t)(b * DPART + p) * 64 + i) * 128 + part * 16);
#pragma unroll
          for (int v = 0; v < 4; ++v) { const f32x4 x = src[v]; acc[4 * v] += mp[p] * x.x; acc[4 * v + 1] += mp[p] * x.y; acc[4 * v + 2] += mp[p] * x.z; acc[4 * v + 3] += mp[p] * x.w; } }
#pragma unroll
      for (int j = 0; j < 8; ++j) { const GAS f32x4* src = (const GAS f32x4*)(F.out + O_CKVS + (size_t)(b * DECT + j) * KVL + part * 16);
#pragma unroll
          for (int v = 0; v < 4; ++v) { const f32x4 x = src[v]; acc[4 * v] += sj[j] * x.x; acc[4 * v + 1] += sj[j] * x.y; acc[4 * v + 2] += sj[j] * x.z; acc[4 * v + 3] += sj[j] * x.w; } }
      const float rl = __builtin_amdgcn_rcpf(L);
#pragma unroll
      for (int e = 0; e < 16; ++e) OL[i * 128 + part * 16 + e] = acc[e] * rl; }
    __syncthreads();
    { float od[8];
#pragma unroll
      for (int e = 0; e < 8; ++e) od[e] = 0.f;
      const float* wv = F.w_uv + h * 64 + part * 8;
#pragma unroll 16
      for (int c = 0; c < 128; ++c) { const float x = OL[i * 128 + c]; const f32x4 w0 = *(const GAS f32x4*)(wv + (size_t)c * 512), w1 = *(const GAS f32x4*)(wv + (size_t)c * 512 + 4);
          od[0] += x * w0.x; od[1] += x * w0.y; od[2] += x * w0.z; od[3] += x * w0.w; od[4] += x * w1.x; od[5] += x * w1.y; od[6] += x * w1.z; od[7] += x * w1.w; }
      const size_t row = (size_t)(MP + b * DECT + t); float g[8]; unpack8(*(const GAS v4u*)(F.Z + row * ZP + ZC_GM + h * 64 + part * 8), g);
      v4u o; o.x = pk2(od[0] * siluf(g[0]), od[1] * siluf(g[1])); o.y = pk2(od[2] * siluf(g[2]), od[3] * siluf(g[3])); o.z = pk2(od[4] * siluf(g[4]), od[5] * siluf(g[5])); o.w = pk2(od[6] * siluf(g[6]), od[7] * siluf(g[7]));
      *(GAS v4u*)(F.MIX + row * DM + h * 64 + part * 8) = o; }
    __syncthreads();
}


namespace pg8 {
struct EpiOut {
    static constexpr bool PERM = true;
    const bf16_t* XB; bf16_t* H1B;
    __device__ __forceinline__ void operator()(const f32x4 (&acc)[2][2][4][2], const Unit& u, int wr, int wc, int, int) const {
        int ln_; FRESH_LANE_ID(ln_); const int fr = ln_ & 15, fq = ln_ >> 4;
        const char* xb = (const char*)(XB + (size_t)u.pm * BM * DM + u.pn * BM);
        char* hb = (char*)(H1B + (size_t)u.pm * BM * DM + u.pn * BM);
        const unsigned lo = (unsigned)((wr * 64 + fr) * DM + wc * 32 + 8 * fq);
#pragma unroll
        for (int ai = 0; ai < 2; ++ai) {
            u32x4 xv[4][2];
#pragma unroll
            for (int m = 0; m < 4; ++m)
#pragma unroll
                for (int bj = 0; bj < 2; ++bj) xv[m][bj] = *(const u32x4*)(xb + (lo + (unsigned)((ai * HALF + m * 16) * DM + bj * HALF)) * 2u);
#pragma unroll
            for (int m = 0; m < 4; ++m)
#pragma unroll
                for (int bj = 0; bj < 2; ++bj) { const u32x4 w = xv[m][bj];
                    const f32x4 x0 = {bflo(w.x), bfhi(w.x), bflo(w.y), bfhi(w.y)}, x1 = {bflo(w.z), bfhi(w.z), bflo(w.w), bfhi(w.w)};
                    *(u32x4*)(hb + (lo + (unsigned)((ai * HALF + m * 16) * DM + bj * HALF)) * 2u) = pack8(acc[ai][bj][m][0] + x0, acc[ai][bj][m][1] + x1); }
            asm volatile("" ::: "memory"); }
    }
};
__device__ __forceinline__ void norm_wait(unsigned* cnt, unsigned want, unsigned* tmo) {
    asm volatile("s_waitcnt vmcnt(0)" ::: "memory");
    unsigned ln; FRESH_LANE_ID(ln);
    if (ln == 0) __hip_atomic_fetch_add(cnt, 1u, __ATOMIC_RELAXED, __HIP_MEMORY_SCOPE_AGENT);
    unsigned spins = 0;
    while ((unsigned)__builtin_amdgcn_readfirstlane(__hip_atomic_load(cnt, __ATOMIC_RELAXED, __HIP_MEMORY_SCOPE_AGENT)) < want) {
        __builtin_amdgcn_s_sleep(2);
        if (++spins > (1u << 20)) { if (ln == 0) __hip_atomic_store(tmo, 1u, __ATOMIC_RELAXED, __HIP_MEMORY_SCOPE_AGENT); break; } }
}
struct EpiPle {
    static constexpr bool PERM = true;
    const bf16_t* H1B; const bf16_t* PPb; float* ssq; float* Yout; const float* g_fin; unsigned* ctl;
    __device__ __forceinline__ void operator()(f32x4 (&acc)[2][2][4][2], const Unit& u, int wr, int wc, int, int) const {
        int ln_; FRESH_LANE_ID(ln_); const int fr = ln_ & 15, fq = ln_ >> 4;
        const int col0 = u.pn * BM + wc * 32 + 8 * fq;
#pragma unroll
        for (int ai = 0; ai < 2; ++ai)
#pragma unroll
            for (int m = 0; m < 4; ++m) { const int row = u.pm * BM + ai * HALF + wr * 64 + m * 16 + fr; const size_t off = (size_t)row * DM + col0; float s = 0.f;
#pragma unroll
                for (int bj = 0; bj < 2; ++bj) { const u32x4 hw = *(const u32x4*)(H1B + off + bj * HALF), pw = *(const u32x4*)(PPb + off + bj * HALF);
#pragma unroll
                    for (int n = 0; n < 2; ++n) { const unsigned h0 = n == 0 ? hw.x : hw.z, h1w = n == 0 ? hw.y : hw.w, p0 = n == 0 ? pw.x : pw.z, p1 = n == 0 ? pw.y : pw.w;
                        const f32x4 a = acc[ai][bj][m][n]; f32x4 h2;
                        h2[0] = bflo(h0) + __builtin_amdgcn_rcpf(1.f + __expf(-a[0])) * bflo(p0); h2[1] = bfhi(h0) + __builtin_amdgcn_rcpf(1.f + __expf(-a[1])) * bfhi(p0);
                        h2[2] = bflo(h1w) + __builtin_amdgcn_rcpf(1.f + __expf(-a[2])) * bflo(p1); h2[3] = bfhi(h1w) + __builtin_amdgcn_rcpf(1.f + __expf(-a[3])) * bfhi(p1);
                        acc[ai][bj][m][n] = h2; s += (h2[0] * h2[0] + h2[1] * h2[1]) + (h2[2] * h2[2] + h2[3] * h2[3]); } }
                s += __shfl_xor(s, 16); s += xor32(s, fq >= 2);
                if (fq == 0) unsafeAtomicAdd(ssq + row, s);
                if (m & 1) asm volatile("" ::: "memory"); }
        norm_wait(ctl + CW_PCNT + 64 * u.pm, 32u, ctl + CW_TMO);
        f32x4 gv[2][2];
#pragma unroll
        for (int bj = 0; bj < 2; ++bj)
#pragma unroll
            for (int n = 0; n < 2; ++n) gv[bj][n] = *(const f32x4*)(g_fin + col0 + bj * HALF + n * 4);
#pragma unroll
        for (int ai = 0; ai < 2; ++ai)
#pragma unroll
            for (int m = 0; m < 4; ++m) { const int row = u.pm * BM + ai * HALF + wr * 64 + m * 16 + fr; const size_t off = (size_t)row * DM + col0;
                const float rstd = rsq(__hip_atomic_load(ssq + row, __ATOMIC_RELAXED, __HIP_MEMORY_SCOPE_AGENT) * (1.f / DM) + EPS);
#pragma unroll
                for (int bj = 0; bj < 2; ++bj)
#pragma unroll
                    for (int n = 0; n < 2; ++n) *(f32x4*)(Yout + off + bj * HALF + n * 4) = acc[ai][bj][m][n] * rstd * gv[bj][n]; }
    }
};
}
__device__ __forceinline__ void p6_final(Frame& F) {
    const int gw = F.vcu * NWAVES + F.wave, NGW = F.G * NWAVES, lane = F.lane;
    for (int m = gw; m < MT; m += NGW) {
        GAS f32x4* yr = (GAS f32x4*)(F.out + O_Y + (size_t)m * DM) + lane; const float rstd = rsq(F.SSQ_Y[m] * (1.f / DM) + EPS);
#pragma unroll
        for (int j = 0; j < 4; ++j) { const f32x4 g = ((const GAS f32x4*)F.g_fin)[lane + 64 * j]; yr[64 * j] = yr[64 * j] * rstd * g; }
    }
}

template <int MODE  >
__device__ __forceinline__ void small_gemm_tile(Frame& F, const int tile) {
    const int lane = F.lane, w = F.wave, rb = w & 3, cg = w >> 2, l15 = lane & 15, kq = lane >> 4;
    const int tm = tile >> 4, tn = tile & 15;
    const bf16* A = (MODE == 4 ? F.MIX : F.H1B) + (size_t)(MP + tm * 64 + rb * 16 + l15) * DM + 8 * kq;
    const bf16* B = (MODE == 4 ? F.WOUT : F.WPG) + (size_t)(tn * 64 + cg * 32 + l15) * DM + 8 * kq;
    f32x4 acc0 = {0.f, 0.f, 0.f, 0.f}, acc1 = {0.f, 0.f, 0.f, 0.f};
    for (int k0 = 0; k0 < DM; k0 += 256) {
        bf16x8 a[8], b0[8], b1[8];
#pragma unroll
        for (int s = 0; s < 8; ++s) { a[s] = *(const GAS bf16x8*)(A + k0 + 32 * s); b0[s] = *(const GAS bf16x8*)(B + k0 + 32 * s); b1[s] = *(const GAS bf16x8*)(B + (size_t)16 * DM + k0 + 32 * s); }
#pragma unroll
        for (int s = 0; s < 8; ++s) { acc0 = __builtin_amdgcn_mfma_f32_16x16x32_bf16(a[s], b0[s], acc0, 0, 0, 0); acc1 = __builtin_amdgcn_mfma_f32_16x16x32_bf16(a[s], b1[s], acc1, 0, 0, 0); }
    }
    if (MODE == 4) {
#pragma unroll
        for (int r = 0; r < 4; ++r) { const int rs = tm * 64 + rb * 16 + 4 * kq + r; const size_t row = (size_t)(MP + rs);
#pragma unroll
            for (int c = 0; c < 2; ++c) { const int col = tn * 64 + cg * 32 + 16 * c + l15; const float av = c == 0 ? acc0[r] : acc1[r];
                F.H1B[row * DM + col] = (bf16)f2bf(av + bf2f(F.XN[row * DM + col])); } }
    } else {
        float hv[4][2];
#pragma unroll
        for (int r = 0; r < 4; ++r) { const int rs = tm * 64 + rb * 16 + 4 * kq + r; const size_t row = (size_t)(MP + rs); float ss = 0.f;
#pragma unroll
            for (int c = 0; c < 2; ++c) { const int col = tn * 64 + cg * 32 + 16 * c + l15; const float av = c == 0 ? acc0[r] : acc1[r];
                hv[r][c] = bf2f(F.H1B[row * DM + col]) + __builtin_amdgcn_rcpf(1.f + __expf(-av)) * bf2f(F.PP[row * DM + col]); ss += hv[r][c] * hv[r][c]; }
            ss += __shfl_xor(ss, 1); ss += __shfl_xor(ss, 2); ss += __shfl_xor(ss, 4); ss += __shfl_xor(ss, 8); if (l15 == 0) unsafeAtomicAdd(F.SSQ_Y + row, ss); }
        pg8::norm_wait((unsigned*)F.ctl + CW_SCNT + 64 * tm, 128u, (unsigned*)F.ctl + CW_TMO);
#pragma unroll
        for (int r = 0; r < 4; ++r) { const int rs = tm * 64 + rb * 16 + 4 * kq + r; const size_t row = (size_t)(MP + rs);
            const float rstd = rsq(__hip_atomic_load(F.SSQ_Y + row, __ATOMIC_RELAXED, __HIP_MEMORY_SCOPE_AGENT) * (1.f / DM) + EPS);
#pragma unroll
            for (int c = 0; c < 2; ++c) { const int col = tn * 64 + cg * 32 + 16 * c + l15; F.out[O_Y + row * DM + col] = hv[r][c] * rstd * F.g_fin[col]; } }
    }
}


__global__ void __launch_bounds__(NTHREADS, 2) hymba_fwd(Args args) {
    extern __shared__ __attribute__((aligned(16))) unsigned char lds_raw[];
    LAS unsigned char* const lds = (LAS unsigned char*)lds_raw;
    const int wave_s = __builtin_amdgcn_readfirstlane(threadIdx.x >> 6);
    for (int u = threadIdx.x; u < (LDS_BYTES - LDSCTL_OFF) / 4; u += NTHREADS) ((LAS unsigned*)(lds + LDSCTL_OFF))[u] = 0u;
    __syncthreads();
    XcdBarrier bar = xcd_barrier_post((unsigned*)((gu32*)(args.ws + WS_CTL) + CW_BAR), (volatile LAS unsigned*)(lds + MISC_OFF) + 8);
#define GRID_BAR() xcd_barrier(bar)
#define PHASE_BEGIN { Frame F; make_frame(F, lds, wave_s); const int bx = (int)blockIdx.x; (void)bx;
#define PHASE_END }

    { PHASE_BEGIN p0_rows(F); PHASE_END PHASE_BEGIN p0_prologue(F); PHASE_END }
    GRID_BAR();

    PHASE_BEGIN
        pg8::Gemm g{F.XN, F.WIN, MT, ZP, DM, DM, DM}; pg8::StaticOrder S; S.init(MT, ZP, F.G, bx);
        pg8::EpiZ E{F.Z, F.SSQ_Q, F.SSQ_KV, F.RSX};
        pg8::gemm_phase<pg8::EpiZ, pg8::StaticOrder, true>(F.lds, g, S, E, wave_s);
    PHASE_END
    PHASE_BEGIN const bool tail = (F.G == 256); const int nfree = 216, first = 40;
      pg8::Gemm g{F.PB, F.WPP, MT, 1024, 256, 256, 256}; pg8::StaticOrder S; S.init(MT, 1024, tail ? nfree : F.G, tail ? (bx >= first ? bx - first : (1 << 24)) : bx);
      pg8::EpiScale E{F.PP, F.PP, 99, 1024, nullptr, 0.f, 0, -1, F.ROPE, 0, 0};
      pg8::gemm_phase<pg8::EpiScale, pg8::StaticOrder, true>(F.lds, g, S, E, wave_s); PHASE_END
    GRID_BAR();

    {
    PHASE_BEGIN pg8::Gemm g{F.Z, F.WQP, MP, 768, 256, ZP, 256}; pg8::StaticOrder S; S.init(MP, 768, F.G, bx);
      pg8::EpiScale E{F.QP, F.QP, 99, 768, F.SSQ_Q, 1.f / 256.f, 0, 2, F.ROPE, SEQ - 1, 0};
      pg8::gemm_phase<pg8::EpiScale, pg8::StaticOrder, true>(F.lds, g, S, E, wave_s); PHASE_END
    PHASE_BEGIN pg8::Gemm g{F.Z + (size_t)MP * ZP, F.WQS, MS, 1280, 256, ZP, 256}; pg8::StaticOrder S; S.init(MS, 1280, F.G, (bx + 256 - (384 % 256)) % F.G);
      pg8::EpiScale E{F.QS, F.QS, 99, 1280, F.SSQ_Q, 1.f / 256.f, MP, 4, F.ROPE, DECT - 1, SEQ};
      pg8::gemm_phase<pg8::EpiScale, pg8::StaticOrder, true>(F.lds, g, S, E, wave_s); PHASE_END
    PHASE_BEGIN pg8::Gemm g{F.Z + ZC_KV, F.WKV, MP, 1024, 256, ZP, 256}; pg8::StaticOrder S; S.init(MP, 1024, F.G, (bx + 512 - (404 % 256)) % F.G);
      pg8::EpiScale E{F.KN, F.VV, 2, 512, F.SSQ_KV, 1.f / 128.f, 0, -1, F.ROPE, 0, 0};
      pg8::gemm_phase<pg8::EpiScale, pg8::StaticOrder, true>(F.lds, g, S, E, wave_s); PHASE_END
    }
    PHASE_BEGIN p2_rows(F); PHASE_END
    PHASE_BEGIN gla_local_phase(F); PHASE_END
    PHASE_BEGIN for (int u = F.vcu; u < DECB * HG; u += F.G) gla_sample_unit(F, u); PHASE_END
    GRID_BAR();

    PHASE_BEGIN gla_scan(F); PHASE_END
    GRID_BAR();

    PHASE_BEGIN
        const int xl = bx & 7, rk = bx >> 3, nrk = (F.G - xl + 7) >> 3, rd = nrk < 16 ? nrk : 16;
        if (rk < rd) for (int jb = rk; jb < 16; jb += rd) { const int b = xl * 16 + jb;
            decode_unit(F, b, 0); decode_unit(F, b, 1);
            __syncthreads();
            decode_combine_unit(F, b); }
        volatile LAS int* qs = (volatile LAS int*)(F.lds + LDSCTL_OFF + 128);
        unsigned* const qhead = (unsigned*)F.ctl + CW_ATQ + 64 * xl;
#define Q_PULL(dst) do { if (F.tid == 0) qs[0] = (int)__hip_atomic_fetch_add(qhead, 1u, __ATOMIC_RELAXED, __HIP_MEMORY_SCOPE_AGENT); __syncthreads(); dst = __builtin_amdgcn_readfirstlane(qs[0]); __syncthreads(); } while (0)
        int i; Q_PULL(i);
        while (i < 128) { const int qb = 31 - ((i & 63) >> 1), bh = 4 * xl + 2 * (i >> 6) + (i & 1);
            attn_prompt_unit(F, bh >> 3, bh & 7, qb); Q_PULL(i); }
        { int lane; FRESH_LANE_ID(lane); float gon[16];
#pragma unroll
          for (int e = 0; e < 16; ++e) gon[e] = F.g_on[(lane & 7) * 16 + e];
          GoLd nxt; if (i < 384) gla_out_load(F, xl * 256 + (i - 128), lane, nxt);
          while (i < 384) { int j; Q_PULL(j); const GoLd cur = nxt; if (j < 384) gla_out_load(F, xl * 256 + (j - 128), lane, nxt); gla_out_compute(F, xl * 256 + (i - 128), lane, cur, gon); i = j; } }
#undef Q_PULL
    PHASE_END
    GRID_BAR();

    { PHASE_BEGIN pg8::Gemm g{F.MIX, F.WOUT, MP, DM, DM, DM, DM}; pg8::StaticOrder S; S.init(MP, DM, F.G, bx);
      pg8::EpiOut E{F.XN, F.H1B};
      pg8::gemm_phase<pg8::EpiOut, pg8::StaticOrder, true>(F.lds, g, S, E, wave_s); PHASE_END
    PHASE_BEGIN for (int t = F.vcu; t < 256; t += F.G) small_gemm_tile<4>(F, t); PHASE_END }
    GRID_BAR();

    PHASE_BEGIN pg8::Gemm g{F.H1B, F.WPG, MP, DM, DM, DM, DM}; pg8::StaticOrder S; S.init(MP, DM, F.G, bx);
      pg8::EpiPle E{F.H1B, F.PP, F.SSQ_Y, F.out + O_Y, F.g_fin, (unsigned*)F.ctl};
      pg8::gemm_phase<pg8::EpiPle, pg8::StaticOrder, true>(F.lds, g, S, E, wave_s); PHASE_END
    PHASE_BEGIN for (int t = F.vcu; t < 256; t += F.G) small_gemm_tile<5>(F, t); PHASE_END
}

extern "C" void kernel_launch(void* const* d_in, const int* in_sizes, int n_in, void* d_out, int out_size, void* d_ws, size_t ws_size, hipStream_t stream) {
    static int grid = 0;
    if (grid == 0) {
        if (n_in != 22 || (size_t)out_size != O_END || ws_size < WS_END) { fprintf(stderr, "kernel_launch: unexpected shapes: n_in %d out %d ws %zu (need %zu)\n", n_in, out_size, ws_size, (size_t)WS_END); grid = -1; return; }
        int dev = 0, cus = 0, per_cu = 0;
        if (hipGetDevice(&dev) != hipSuccess || hipDeviceGetAttribute(&cus, hipDeviceAttributeMultiprocessorCount, dev) != hipSuccess) { grid = -1; return; }
        if (hipFuncSetAttribute((const void*)hymba_fwd, hipFuncAttributeMaxDynamicSharedMemorySize, LDS_BYTES) != hipSuccess) { fprintf(stderr, "kernel_launch: hipFuncSetAttribute failed\n"); grid = -1; return; }
        if (hipOccupancyMaxActiveBlocksPerMultiprocessor(&per_cu, (const void*)hymba_fwd, NTHREADS, LDS_BYTES) != hipSuccess || per_cu < 1)
            fprintf(stderr, "kernel_launch: note: occupancy query reports %d workgroups per CU\n", per_cu);
        (void)hipGetLastError();
        grid = cus;
    }
    if (grid < 0) return;
    if (hipMemsetAsync((char*)d_ws + WS_CTL, 0, CTL_ZERO_BYTES, stream) != hipSuccess) { fprintf(stderr, "kernel_launch: memset failed\n"); return; }
    Args a{};
    for (int i = 0; i < 22; ++i) a.in[i] = (const float*)d_in[i];
    a.out = (float*)d_out; a.ws = (unsigned char*)d_ws;
    hipLaunchKernelGGL(hymba_fwd, dim3(grid), dim3(NTHREADS), LDS_BYTES, stream, a);
    const hipError_t le = hipPeekAtLastError();
    if (le != hipSuccess) fprintf(stderr, "kernel_launch: launch failed: %s\n", hipGetErrorName(le));
}
```

```cpp
#include <hip/hip_runtime.h>
#include <cstdio>
#include <cstdint>

namespace pg8 {
#define PG8_LAS __attribute__((address_space(3)))
typedef unsigned short bf16_t;
typedef short bf16x8 __attribute__((ext_vector_type(8)));
typedef float f32x4 __attribute__((ext_vector_type(4)));
typedef float f32x2 __attribute__((ext_vector_type(2)));
typedef unsigned u32x4 __attribute__((ext_vector_type(4)));
typedef unsigned u32x2 __attribute__((ext_vector_type(2)));
constexpr int BM = 256, BK = 64, HALF = 128, HTB = HALF * BK * 2, STAGE_BYTES = 8 * HTB, NXCD = 8, WGM = 8;

__host__ __device__ __forceinline__ int lds_byte(int r, int c) { const int st = (r >> 4) * 2 + (c >> 5), rr = r & 15, cc = c & 31, ob = rr * 64 + cc * 2; return st * 1024 + (ob ^ (((ob >> 9) & 1) << 5)); }
__host__ __device__ __forceinline__ void stage_rc(int b, int& R, int& C) { const int st = b / 1024, sb = b % 1024, swz = sb ^ (((sb >> 9) & 1) << 5); R = (st >> 1) * 16 + swz / 64; C = (st & 1) * 32 + (swz % 64) / 2; }
__host__ __device__ __forceinline__ int perm32(int rho) { const int n = rho >> 4, i = rho & 15; return 8 * (i >> 2) + 4 * n + (i & 3); }

struct Unit { int pm, pn; };
struct Gemm { const bf16_t* A; const bf16_t* Bt; int M, N, K, lda, ldb; };

struct StaticOrder {
    int nM, nN, nwg, G, c, base, lim;
    __host__ __device__ void init(int M, int N, int G_, int c_) { nM = M / BM; nN = N / BM; nwg = nM * nN; G = G_; c = c_; base = 0; lim = nwg; }
    __host__ __device__ bool next(int i, Unit& u) const {
        const long L = (long)base + (long)i * G + c; if (L >= lim) return false;
        int wgid = (int)L; { const int q = nwg / NXCD, r = nwg % NXCD, xcd = wgid % NXCD, off = wgid / NXCD; wgid = (xcd < r ? xcd * (q + 1) : r * (q + 1) + (xcd - r) * q) + off; }
        const int nig = WGM * nN, gid = wgid / nig, fm = gid * WGM, gsz = (nM - fm) < WGM ? (nM - fm) : WGM;
        u.pm = fm + ((wgid % nig) % gsz); u.pn = (wgid % nig) / gsz; return true;
    }
    __device__ __forceinline__ void a_ready(const Unit&) const {}
    __device__ __forceinline__ void done(const Unit&) const {}
};

__device__ __forceinline__ unsigned cvt_pk_bf16(float lo, float hi) { unsigned r; asm volatile("v_cvt_pk_bf16_f32 %0, %1, %2" : "=v"(r) : "v"(lo), "v"(hi)); return r; }

template <class Epi, class Sched, bool ALIGN_EPI = false>
__device__ __forceinline__ void gemm_phase(PG8_LAS unsigned char* lds, const Gemm g, const Sched& S, const Epi& E, const int wid) {
    int lane_; asm volatile("v_mbcnt_lo_u32_b32 %0, -1, 0\n\tv_mbcnt_hi_u32_b32 %0, -1, %0" : "=v"(lane_));
    const int lane = lane_, tid = wid * 64 + lane, wr = wid >> 2, wc = wid & 3, fr = lane & 15, fq = lane >> 4;
    const int K = g.K, nt = K / BK;
    unsigned voffA[2], voffB[2];
#pragma unroll
    for (int i = 0; i < 2; ++i) { int R, C; stage_rc(tid * 16 + i * 8192, R, C); const int Rb = Epi::PERM ? ((R & ~31) + perm32(R & 31)) : R;
        voffA[i] = (unsigned)(R * g.lda + C) * 2u; voffB[i] = (unsigned)(Rb * g.ldb + C) * 2u; }
    const size_t kstep = (size_t)(BK * 2);
    const size_t hstepA = (size_t)HALF * g.lda * 2, hstepB = (size_t)HALF * g.ldb * 2;
    const size_t tstepA = 2 * hstepA, tstepB = 2 * hstepB;
    const unsigned ldsw = (unsigned)wid * 1024u;
    const int aoff = lds_byte(wr * 64 + fr, fq * 8), boff = lds_byte(wc * 32 + fr, fq * 8);
#define PG8_SA(b, h) (((b) * 2 + (h)) * HTB)
#define PG8_SB(b, h) ((4 + (b) * 2 + (h)) * HTB)
#define PG8_STAGE(bufoff, gbase, voff) do { _Pragma("unroll") for (int _i = 0; _i < 2; ++_i) \
        __builtin_amdgcn_global_load_lds((const unsigned*)((const char*)(gbase) + (voff)[_i]), (PG8_LAS unsigned*)(lds + (bufoff) + ldsw + _i * 8192), 16, 0, 0); } while (0)
#define PG8_LDA(dst, b, h) do { _Pragma("unroll") for (int m = 0; m < 4; ++m) _Pragma("unroll") for (int k = 0; k < 2; ++k) dst[m][k] = *(const PG8_LAS bf16x8*)(lds + PG8_SA(b, h) + aoff + m * 2048 + k * 1024); } while (0)
#define PG8_LDB(dst, b, h) do { _Pragma("unroll") for (int n = 0; n < 2; ++n) _Pragma("unroll") for (int k = 0; k < 2; ++k) dst[n][k] = *(const PG8_LAS bf16x8*)(lds + PG8_SB(b, h) + boff + n * 2048 + k * 1024); } while (0)
#define PG8_MMA(ai, bj, At, Bt) do { __builtin_amdgcn_s_setprio(1); _Pragma("unroll") for (int m = 0; m < 4; ++m) _Pragma("unroll") for (int n = 0; n < 2; ++n) _Pragma("unroll") for (int k = 0; k < 2; ++k) \
        acc[ai][bj][m][n] = __builtin_amdgcn_mfma_f32_16x16x32_bf16(Bt[n][k], At[m][k], acc[ai][bj][m][n], 0, 0, 0); __builtin_amdgcn_s_setprio(0); } while (0)
#define PG8_WAIT_V(n) asm volatile("s_waitcnt vmcnt(" #n ")" ::: "memory")
#define PG8_WAIT_L(n) asm volatile("s_waitcnt lgkmcnt(" #n ")" ::: "memory")
#define PG8_BAR __builtin_amdgcn_s_barrier()
#define PG8_SCHED __builtin_amdgcn_sched_barrier(0)
    Unit cur, nxt; int ui = 0;
    if (!S.next(0, cur)) return;
    f32x4 acc[2][2][4][2];
#pragma unroll
    for (int a = 0; a < 2; ++a)
#pragma unroll
        for (int b = 0; b < 2; ++b)
#pragma unroll
            for (int m = 0; m < 4; ++m)
#pragma unroll
                for (int n = 0; n < 2; ++n) acc[a][b][m][n] = (f32x4){0.f, 0.f, 0.f, 0.f};
    bf16x8 At[4][2], B0[2][2], B1[2][2];
    const char* cA = (const char*)g.A + (size_t)cur.pm * tstepA; const char* cB = (const char*)g.Bt + (size_t)cur.pn * tstepB;
    S.a_ready(cur);
    PG8_STAGE(PG8_SB(0, 0), cB, voffB); PG8_STAGE(PG8_SB(0, 1), cB + hstepB, voffB); PG8_STAGE(PG8_SA(0, 0), cA, voffA); PG8_STAGE(PG8_SA(0, 1), cA + hstepA, voffA);
    if (wr == 1) PG8_BAR;
    PG8_WAIT_V(2); PG8_BAR;
    PG8_STAGE(PG8_SB(1, 0), cB + kstep, voffB); PG8_STAGE(PG8_SA(1, 0), cA + kstep, voffA); PG8_STAGE(PG8_SB(1, 1), cB + hstepB + kstep, voffB);
    PG8_WAIT_V(6); PG8_BAR;
    for (;;) {
        const bool has_next = S.next(ui + 1, nxt);
        const char* nA = has_next ? (const char*)g.A + (size_t)nxt.pm * tstepA : cA; const char* nB = has_next ? (const char*)g.Bt + (size_t)nxt.pn * tstepB : cB;
        for (int t = 0; t < nt; t += 2) {
            const bool last = (t == nt - 2);
            const char* a1 = cA + (size_t)(t + 1) * kstep;
            const char* a2 = last ? nA : cA + (size_t)(t + 2) * kstep; const char* b2 = last ? nB : cB + (size_t)(t + 2) * kstep;
            const char* a3 = a2 + kstep; const char* b3 = b2 + kstep;
            if (last && has_next) S.a_ready(nxt);
            PG8_LDB(B0, 0, 0); PG8_LDB(B1, 0, 1); PG8_SCHED; PG8_LDA(At, 0, 0); PG8_STAGE(PG8_SA(1, 1), a1 + hstepA, voffA);
            PG8_WAIT_V(8); PG8_WAIT_L(0); PG8_BAR; PG8_MMA(0, 0, At, B0); PG8_MMA(0, 1, At, B1); PG8_BAR; PG8_SCHED;
            PG8_LDA(At, 0, 1); PG8_STAGE(PG8_SB(0, 0), b2, voffB); PG8_STAGE(PG8_SB(0, 1), b2 + hstepB, voffB); PG8_STAGE(PG8_SA(0, 0), a2, voffA);
            PG8_WAIT_V(8); PG8_WAIT_L(0); PG8_BAR; PG8_MMA(1, 0, At, B0); PG8_MMA(1, 1, At, B1); PG8_BAR; PG8_SCHED;
            PG8_LDB(B0, 1, 0); PG8_LDB(B1, 1, 1); PG8_SCHED; PG8_LDA(At, 1, 0); PG8_STAGE(PG8_SA(0, 1), a2 + hstepA, voffA);
            PG8_WAIT_V(8); PG8_WAIT_L(0); PG8_BAR; PG8_MMA(0, 0, At, B0); PG8_MMA(0, 1, At, B1); PG8_BAR; PG8_SCHED;
            PG8_LDA(At, 1, 1); PG8_STAGE(PG8_SB(1, 0), b3, voffB); PG8_STAGE(PG8_SB(1, 1), b3 + hstepB, voffB); PG8_STAGE(PG8_SA(1, 0), a3, voffA);
            PG8_WAIT_V(8); PG8_WAIT_L(0); PG8_BAR; PG8_MMA(1, 0, At, B0); PG8_MMA(1, 1, At, B1); PG8_BAR; PG8_SCHED;
        }
        if constexpr (ALIGN_EPI) { if (wr == 0) PG8_BAR; }
        E(acc, cur, wr, wc, fr, fq); S.done(cur);
        if (!has_next) break;
#pragma unroll
        for (int a = 0; a < 2; ++a)
#pragma unroll
            for (int b = 0; b < 2; ++b)
#pragma unroll
                for (int m = 0; m < 4; ++m)
#pragma unroll
                    for (int n = 0; n < 2; ++n) acc[a][b][m][n] = (f32x4){0.f, 0.f, 0.f, 0.f};
        cur = nxt; cA = nA; cB = nB; ++ui;
        if constexpr (ALIGN_EPI) { if (wr == 1) PG8_BAR; }
    }
    PG8_WAIT_V(0);
    if constexpr (!ALIGN_EPI) { if (wr == 0) PG8_BAR; }
    PG8_BAR;
#undef PG8_SA
#undef PG8_SB
#undef PG8_STAGE
#undef PG8_LDA
#undef PG8_LDB
#undef PG8_MMA
#undef PG8_WAIT_V
#undef PG8_WAIT_L
#undef PG8_BAR
#undef PG8_SCHED
}
}

constexpr int NWAVES = 8, NTHREADS = 512;
constexpr int DM = 1024, SEQ = 8192, NB = 4, MP = NB * SEQ  , DECB = 128, DECT = 8, MS = DECB * DECT  , MT = MP + MS  ;
constexpr int NPAGES = 128, PAGE = 128, PAST = NPAGES * PAGE;
constexpr int HM = 8, QN = 64, QR = 32, VH = 64, KVL = 128, QL = 256;
constexpr int HG = 4, GDK = 64, GDV = 128, GRANK = 16;
constexpr int PD = 256, INDIM = 2480;
constexpr int ZP = 2560;
constexpr int ZC_KV = 256, ZC_KR = 384, ZC_AG = 416, ZC_GM = 512, ZC_QG = 1024, ZC_KG = 1280, ZC_VG = 1536, ZC_GG = 2048;
constexpr float EPS = 1e-6f;
constexpr float QSCALE = 0.10206207261596577f * 1.4426950408889634f;
constexpr int NPOS = SEQ + DECT;
constexpr int NCH = SEQ / 64;
constexpr int NGU = NB * HG * NCH;
constexpr int DSPLIT = 2, DPART = DSPLIT * 4;

constexpr size_t O_Y = 0;
constexpr size_t O_CKVP = (size_t)MT * DM;
constexpr size_t O_KRP = O_CKVP + (size_t)MP * KVL;
constexpr size_t O_GSP = O_KRP + (size_t)MP * QR;
constexpr size_t O_CKVS = O_GSP + (size_t)NB * HG * GDK * GDV;
constexpr size_t O_KRS = O_CKVS + (size_t)MS * KVL;
constexpr size_t O_GSS = O_KRS + (size_t)MS * QR;
constexpr size_t O_END = O_GSS + (size_t)DECB * HG * GDK * GDV;

constexpr size_t MiB = 1u << 20;
constexpr size_t WS_CTL = 0, CTL_ZERO_BYTES = 2 * MiB;
constexpr int CW_BAR = 4096;
constexpr int CW_PCNT = 16384, CW_SCNT = CW_PCNT + 64 * 128;
constexpr int CW_ATQ = 32768;
constexpr int CW_TMO = 64;
constexpr size_t WS_SSQ_Q = 256 * 1024, WS_SSQ_KV = WS_SSQ_Q + (size_t)MT * 4, WS_SSQ_Y = WS_SSQ_KV + (size_t)MT * 4;
static_assert(WS_SSQ_Y + (size_t)MT * 4 <= CTL_ZERO_BYTES, "ctl map");
constexpr size_t WS_WIN = 2 * MiB;
constexpr size_t WS_WQP = WS_WIN + (size_t)ZP * DM * 2;
constexpr size_t WS_WQS = WS_WQP + 768 * 256 * 2;
constexpr size_t WS_WKV = WS_WQS + 1280 * 256 * 2;
constexpr size_t WS_WPP = WS_WKV + 1024 * 256 * 2;
constexpr size_t WS_WOUT = WS_WPP + 1024 * 256 * 2;
constexpr size_t WS_WPG = WS_WOUT + (size_t)DM * DM * 2;
constexpr size_t WS_ROPE = WS_WPG + (size_t)DM * DM * 2;
constexpr size_t WS_W2T = WS_ROPE + (size_t)NPOS * 32 * 4;
constexpr size_t WS_RSX = WS_W2T + 256 * 16 * 2;
constexpr size_t WS_XN = 16 * MiB;
constexpr size_t WS_PB = WS_XN + (size_t)MT * DM * 2;
constexpr size_t WS_Z = WS_PB + (size_t)MT * PD * 2;
constexpr size_t WS_QP = WS_Z + (size_t)MT * ZP * 2;
constexpr size_t WS_QS = WS_QP + (size_t)MP * 768 * 2;
constexpr size_t WS_KN = WS_QS + (size_t)MS * 1280 * 2;
constexpr size_t WS_VV = WS_KN + (size_t)MP * 512 * 2;
constexpr size_t WS_KR = WS_VV + (size_t)MP * 512 * 2;
constexpr size_t WS_PP = WS_KR + (size_t)MT * 32 * 2;
constexpr size_t WS_QT = WS_PP + (size_t)MT * DM * 2;
constexpr size_t WS_KT = WS_QT + (size_t)MP * 256 * 2;
constexpr size_t WS_U = WS_KT + (size_t)MP * 256 * 2;
constexpr size_t WS_DEC = WS_U + (size_t)NGU * GDK * GDV * 4;
constexpr size_t WS_SPREV = WS_DEC + (size_t)NGU * GDK * 4;
constexpr size_t WS_PART = WS_SPREV + (size_t)NGU * GDK * GDV * 2;
constexpr size_t WS_ML = WS_PART + (size_t)DECB * DPART * 64 * 128 * 4;
constexpr size_t WS_MIX = WS_ML + (size_t)DECB * DPART * 64 * 2 * 4;
constexpr size_t WS_H1B = WS_MIX + (size_t)MT * DM * 2;
constexpr size_t WS_END = WS_H1B + (size_t)MT * DM * 2;
static_assert(WS_RSX + (size_t)MT * 4 <= WS_XN, "weights map");

constexpr int RING_BYTES = 131072;
constexpr int LDSCTL_OFF = RING_BYTES, MISC_OFF = LDSCTL_OFF + 320;
constexpr int LDS_BYTES = 147456;

#define FRESH_LANE_ID(l) asm volatile("v_mbcnt_lo_u32_b32 %0, -1, 0\n\tv_mbcnt_hi_u32_b32 %0, -1, %0" : "=v"(l))
#define GAS __attribute__((address_space(1)))
#define LAS __attribute__((address_space(3)))
typedef unsigned short bf16;
typedef unsigned v4u __attribute__((ext_vector_type(4)));
typedef unsigned v2u __attribute__((ext_vector_type(2)));
typedef float f32x4 __attribute__((ext_vector_type(4)));
typedef float f32x2 __attribute__((ext_vector_type(2)));
typedef float f32x16 __attribute__((ext_vector_type(16)));
typedef short bf16x8 __attribute__((ext_vector_type(8)));
typedef short s16x4 __attribute__((ext_vector_type(4)));
typedef GAS unsigned gu32;
#define LDS_WAIT() asm volatile("s_waitcnt lgkmcnt(0)" ::: "memory")
#define VM_WAIT() asm volatile("s_waitcnt vmcnt(0)" ::: "memory")
__device__ __forceinline__ unsigned f2bf(float f) { unsigned u = __builtin_bit_cast(unsigned, f); return (u + 0x7fffu + ((u >> 16) & 1u)) >> 16; }
typedef float f32x2_cv __attribute__((ext_vector_type(2))); typedef __bf16 bf16x2_cv __attribute__((ext_vector_type(2)));
__device__ __forceinline__ unsigned pk2(float lo, float hi) { f32x2_cv v = {lo, hi}; bf16x2_cv b = __builtin_convertvector(v, bf16x2_cv); return __builtin_bit_cast(unsigned, b); }
__device__ __forceinline__ float bf2f(unsigned short b) { return __builtin_bit_cast(float, (unsigned)b << 16); }
__device__ __forceinline__ float bflo(unsigned w) { return __builtin_bit_cast(float, w << 16); }
__device__ __forceinline__ float bfhi(unsigned w) { return __builtin_bit_cast(float, w & 0xffff0000u); }
__device__ __forceinline__ float wave_sum(float v) {
#pragma unroll
    for (int o = 1; o < 64; o <<= 1) v += __shfl_xor(v, o);
    return v;
}
__device__ __forceinline__ float fast_exp2(float x) { return __builtin_amdgcn_exp2f(x); }
__device__ __forceinline__ float siluf(float x) { return x * __builtin_amdgcn_rcpf(1.f + __expf(-x)); }
__device__ __forceinline__ float sigmoidf_(float x) { return __builtin_amdgcn_rcpf(1.f + __expf(-x)); }
__device__ __forceinline__ float rsq(float x) { return __builtin_amdgcn_rsqf(x); }
__device__ __forceinline__ float xor32(float v, bool upper) {
    auto rr = __builtin_amdgcn_permlane32_swap(__float_as_uint(v), __float_as_uint(v), false, false);
    return __uint_as_float(upper ? rr[0] : rr[1]);
}
__device__ __forceinline__ int crow(int r, int hi) { return (r & 3) + 8 * (r >> 2) + 4 * hi; }
#define XB_TMO      128
#define XB_XCNT(j)  (256  + 64 * (j))
#define XB_XSUB(j)  (1280 + 64 * (j))
#define XB_XGEN(j)  (2304 + 64 * (j))
#define XB_TOP      3328
#define XB_TOPGEN   3392
#define XCD_BAR_WORDS 3456
#define XB_SPIN_CAP (1u << 18)

__device__ __forceinline__ unsigned xb_ld(unsigned* p)              { return __hip_atomic_load(p, __ATOMIC_RELAXED, __HIP_MEMORY_SCOPE_AGENT); }
__device__ __forceinline__ unsigned xb_add(unsigned* p, unsigned v) { return __hip_atomic_fetch_add(p, v, __ATOMIC_RELAXED, __HIP_MEMORY_SCOPE_AGENT); }
__device__ __forceinline__ unsigned xb_xcc_id() { return (unsigned)__builtin_amdgcn_s_getreg((3 << 11) | 20) & 0xFu; }
#define XB_SPIN(cond, bar) do { unsigned _sp = 0; while (cond) { __builtin_amdgcn_s_sleep(1); \
    if ((++_sp & 255u) == 0u) { if (xb_ld(&(bar)[XB_TMO])) break; if (_sp > XB_SPIN_CAP) { atomicAdd(&(bar)[XB_TMO], 1u); break; } } } } while (0)

struct XcdBarrier {
    int w;
    unsigned* bar; unsigned x;
    volatile LAS unsigned* st;
};

__device__ __forceinline__ XcdBarrier xcd_barrier_post(unsigned* bar, volatile LAS unsigned* st) {
    XcdBarrier b; b.w = (int)__builtin_amdgcn_readfirstlane(threadIdx.x >> 6); b.bar = bar; b.x = xb_xcc_id(); b.st = st;
    if (threadIdx.x == 0) (void)xb_add(&bar[XB_XCNT(b.x)], 1u);
    return b;
}
__device__ __forceinline__ void xcd_barrier_complete(unsigned* bar, unsigned x, unsigned& nloc, unsigned& nx) {
    const unsigned G = gridDim.x * gridDim.y * gridDim.z;
    unsigned sum, cnt, mine, sp = 0u;
    for (;;) {
        sum = 0u; cnt = 0u; mine = 0u;
#pragma unroll
        for (unsigned j = 0; j < 16; ++j) { const unsigned c = xb_ld(&bar[XB_XCNT(j)]); sum += c; cnt += (c > 0u) ? 1u : 0u; mine = (j == x) ? c : mine; }
        if (sum == G) break;
        __builtin_amdgcn_s_sleep(1);
        if ((++sp & 255u) == 0u) { if (xb_ld(&bar[XB_TMO])) break; if (sp > XB_SPIN_CAP) { atomicAdd(&bar[XB_TMO], 1u); break; } }
    }
    nloc = mine > 0u ? mine : 1u; nx = cnt > 0u ? cnt : 1u;
}

__device__ __forceinline__ void xcd_barrier(const XcdBarrier& b) {
    asm volatile("s_waitcnt vmcnt(0)" ::: "memory");
    __syncthreads();
    unsigned xb_lane; asm volatile("v_mbcnt_lo_u32_b32 %0, -1, 0\n\tv_mbcnt_hi_u32_b32 %0, -1, %0" : "=v"(xb_lane));
    if (b.w == 0 && xb_lane == 0u) {
        unsigned* bar = b.bar;
        __builtin_amdgcn_s_waitcnt(0);
        unsigned nloc = b.st[0], nx = b.st[1];
        if (nloc == 0u) { xcd_barrier_complete(bar, b.x, nloc, nx); b.st[0] = nloc; b.st[1] = nx; }
        const unsigned old = xb_add(&bar[XB_XSUB(b.x)], 1u);
        const unsigned gen = old / nloc;
        if (old + 1u == (gen + 1u) * nloc) {
            __builtin_amdgcn_fence(__ATOMIC_RELEASE, "agent");
            asm volatile("s_waitcnt vmcnt(0)" ::: "memory");
            const unsigned og = xb_add(&bar[XB_TOP], 1u);
            const unsigned tg = og / nx;
            if (og + 1u == (tg + 1u) * nx) xb_add(&bar[XB_TOPGEN], 1u);
            else XB_SPIN(xb_ld(&bar[XB_TOPGEN]) == tg, bar);
            __builtin_amdgcn_fence(__ATOMIC_ACQUIRE, "agent");
            xb_add(&bar[XB_XGEN(b.x)], 1u);
            asm volatile("s_waitcnt vmcnt(0)" ::: "memory");
        } else {
            XB_SPIN(xb_ld(&bar[XB_XGEN(b.x)]) == gen, bar);
            __builtin_amdgcn_fence(__ATOMIC_ACQUIRE, "agent");
            asm volatile("s_waitcnt vmcnt(0)" ::: "memory");
        }
    }
    __syncthreads();
}

struct Args { const float* in[22]; float* out; unsigned char* ws; };
struct Frame {
    LAS unsigned char* lds; gu32* ctl;
    int tid, lane, wave, vcu, G;
    const float *x_p, *x_s, *p_p, *p_s, *cache_ckv, *cache_kr, *state_gla; const int* page_table;
    const float *g_mix, *w_in, *g_q, *w_qup, *g_kv, *w_uk, *w_uv, *w_a2, *b_a, *g_on, *w_out, *w_pg, *w_pp, *g_fin;
    float* out; unsigned char* ws;
    bf16 *WIN, *WQP, *WQS, *WKV, *WPP, *WOUT, *WPG, *W2T; float* ROPE;
    bf16 *XN, *PB, *Z, *QP, *QS, *KN, *VV, *KR, *PP, *QT, *KT, *SPREV, *MIX, *H1B;
    float *U, *DEC, *PART, *ML, *SSQ_Q, *SSQ_KV, *SSQ_Y, *RSX;
};
typedef __attribute__((address_space(4))) const unsigned long long* kargp_t;
__device__ __forceinline__ void make_frame(Frame& F, LAS unsigned char* lds, int wave_s) {
    kargp_t ka = (kargp_t)__builtin_amdgcn_kernarg_segment_ptr(); asm volatile("" : "+s"(ka));
    int lane_; FRESH_LANE_ID(lane_);
    F.lds = lds; F.lane = lane_; F.wave = wave_s; F.tid = wave_s * 64 + lane_;
    F.G = gridDim.x; { const int bx = blockIdx.x; F.vcu = (F.G % 8 == 0) ? (bx % 8) * (F.G / 8) + bx / 8 : bx; }
#define KIN(i) ((const float*)(GAS const float*)ka[i])
    F.x_p = KIN(0); F.x_s = KIN(1); F.p_p = KIN(2); F.p_s = KIN(3); F.cache_ckv = KIN(4); F.cache_kr = KIN(5); F.state_gla = KIN(6);
    F.page_table = (const int*)(GAS const int*)ka[7]; F.g_mix = KIN(8); F.w_in = KIN(9); F.g_q = KIN(10); F.w_qup = KIN(11); F.g_kv = KIN(12);
    F.w_uk = KIN(13); F.w_uv = KIN(14); F.w_a2 = KIN(15); F.b_a = KIN(16); F.g_on = KIN(17); F.w_out = KIN(18); F.w_pg = KIN(19);
    F.w_pp = KIN(20); F.g_fin = KIN(21);
    F.out = (float*)(GAS float*)ka[22]; unsigned char* ws = (unsigned char*)(GAS unsigned char*)ka[23]; F.ws = ws;
#undef KIN
    F.ctl = (gu32*)(ws + WS_CTL);
    F.WIN = (bf16*)(ws + WS_WIN); F.WQP = (bf16*)(ws + WS_WQP); F.WQS = (bf16*)(ws + WS_WQS); F.WKV = (bf16*)(ws + WS_WKV); F.WPP = (bf16*)(ws + WS_WPP);
    F.WOUT = (bf16*)(ws + WS_WOUT); F.WPG = (bf16*)(ws + WS_WPG); F.ROPE = (float*)(ws + WS_ROPE); F.W2T = (bf16*)(ws + WS_W2T);
    F.XN = (bf16*)(ws + WS_XN); F.PB = (bf16*)(ws + WS_PB); F.Z = (bf16*)(ws + WS_Z); F.QP = (bf16*)(ws + WS_QP); F.QS = (bf16*)(ws + WS_QS);
    F.KN = (bf16*)(ws + WS_KN); F.VV = (bf16*)(ws + WS_VV); F.KR = (bf16*)(ws + WS_KR); F.PP = (bf16*)(ws + WS_PP); F.QT = (bf16*)(ws + WS_QT); F.KT = (bf16*)(ws + WS_KT);
    F.SPREV = (bf16*)(ws + WS_SPREV); F.MIX = (bf16*)(ws + WS_MIX); F.H1B = (bf16*)(ws + WS_H1B);
    F.U = (float*)(ws + WS_U); F.DEC = (float*)(ws + WS_DEC); F.PART = (float*)(ws + WS_PART); F.ML = (float*)(ws + WS_ML);
    F.SSQ_Q = (float*)(ws + WS_SSQ_Q); F.SSQ_KV = (float*)(ws + WS_SSQ_KV); F.SSQ_Y = (float*)(ws + WS_SSQ_Y); F.RSX = (float*)(ws + WS_RSX);
}
__device__ __forceinline__ const float* xrow_ptr(const Frame& F, int row) { return row < MP ? F.x_p + (size_t)row * DM : F.x_s + (size_t)(row - MP) * DM; }

template <class Fn> __device__ __forceinline__ void tr_item(const Fn& f, int K, bf16* WT, LAS float* scr, int kb, int nb, int lane) {
    const int k0 = 64 * kb, n0 = 32 * nb;
#pragma unroll 8
    for (int i = 0; i < 32; ++i) { const int kk = 2 * i + (lane >> 5); scr[kk * 33 + (lane & 31)] = f(k0 + kk, n0 + (lane & 31)); }
    LDS_WAIT(); asm volatile("" ::: "memory");
    const int c = lane & 7;
#pragma unroll
    for (int j = 0; j < 4; ++j) { const int n = (lane >> 3) + 8 * j; const LAS float* s = scr + (8 * c) * 33 + n;
        v4u o; o.x = pk2(s[0 * 33], s[1 * 33]); o.y = pk2(s[2 * 33], s[3 * 33]); o.z = pk2(s[4 * 33], s[5 * 33]); o.w = pk2(s[6 * 33], s[7 * 33]);
        *(GAS v4u*)(WT + (size_t)(n0 + n) * K + k0 + 8 * c) = o; }
    LDS_WAIT(); asm volatile("" ::: "memory");
}
__device__ __forceinline__ int win_src_col(int n) {
    if (n < 416) return n;
    if (n < 432) return 1952 + (n - 416);
    if (n < 512) return -1;
    if (n < 1024) return 416 + (n - 512);
    if (n < 1280) return 928 + (n - 1024);
    if (n < 1536) return 1184 + (n - 1280);
    if (n < 2048) return 1440 + (n - 1536);
    return 1968 + (n - 2048);
}
__device__ __forceinline__ int qup_src_col(int n) {
    return n < 512 ? (n >> 6) * 96 + (n & 63) : ((n - 512) >> 5) * 96 + 64 + ((n - 512) & 31);
}
__device__ __forceinline__ void sincos_d(double a, float& s, float& c) {
    const double q = __builtin_rint(a * 0.63661977236758134308);
    const double r = __builtin_fma(-q, 1.57079632679489655800, a) - q * 6.12323399573676603587e-17;
    const double r2 = r * r;
    double sp = -7.6471637318198164759e-13; sp = sp * r2 + 1.6059043836821614599e-10; sp = sp * r2 - 2.5052108385441718775e-8; sp = sp * r2 + 2.7557319223985890653e-6;
    sp = sp * r2 - 1.9841269841269841270e-4; sp = sp * r2 + 8.3333333333333333333e-3; sp = sp * r2 - 1.6666666666666666667e-1; const double sn = r + r * r2 * sp;
    double cp = 4.7794773323873852974e-14; cp = cp * r2 - 1.1470745597729724714e-11; cp = cp * r2 + 2.0876756987868098979e-9; cp = cp * r2 - 2.7557319223985890653e-7;
    cp = cp * r2 + 2.4801587301587301587e-5; cp = cp * r2 - 1.3888888888888888889e-3; cp = cp * r2 + 4.1666666666666666667e-2; cp = cp * r2 - 0.5; const double cs = 1.0 + r2 * cp;
    const int qi = (int)((long long)q & 3);
    const double so = (qi == 0) ? sn : (qi == 1) ? cs : (qi == 2) ? -sn : -cs;
    const double co = (qi == 0) ? cs : (qi == 1) ? -sn : (qi == 2) ? -cs : sn;
    s = (float)so; c = (float)co;
}
__device__ __forceinline__ void p0_prologue(Frame& F) {
    LAS float* scr = (LAS float*)(F.lds + F.wave * 16384);
    const int gw = F.vcu * NWAVES + F.wave, NGW = F.G * NWAVES, lane = F.lane;
    constexpr int I_WIN = 16 * 80, I_WQP = 4 * 24, I_WKV = 4 * 32, I_WPP = 4 * 32, I_WOUT = 16 * 32, I_WPG = 16 * 32;
    constexpr int NITEMS = I_WIN + I_WQP + I_WKV + I_WPP + I_WOUT + I_WPG;
    for (int it = gw; it < NITEMS; it += NGW) {
        int r = it;
        if (r < I_WIN) { const float* w = F.w_in; const float* g = F.g_mix;
            tr_item([&](int k, int n) -> float { const int s = win_src_col(n); return s >= 0 ? g[k] * w[(size_t)k * INDIM + s] : 0.f; }, DM, F.WIN, scr, r / 80, r % 80, lane); continue; } r -= I_WIN;
        if (r < I_WQP) { const float* w = F.w_qup; const float* g = F.g_q;
            tr_item([&](int k, int n) -> float { return g[k] * w[(size_t)k * 768 + qup_src_col(n)] * QSCALE; }, QL, F.WQP, scr, r / 24, r % 24, lane); continue; } r -= I_WQP;
        if (r < I_WKV) { const float* uk = F.w_uk; const float* uv = F.w_uv; const float* g = F.g_kv;
            tr_item([&](int k, int n) -> float { if (k >= KVL) return 0.f; return g[k] * (n < 512 ? uk[(size_t)k * 512 + n] : uv[(size_t)k * 512 + (n - 512)]); }, 256, F.WKV, scr, r / 32, r % 32, lane); continue; } r -= I_WKV;
        if (r < I_WPP) { const float* w = F.w_pp;
            tr_item([&](int k, int n) -> float { return w[(size_t)k * DM + n]; }, PD, F.WPP, scr, r / 32, r % 32, lane); continue; } r -= I_WPP;
        if (r < I_WOUT) { const float* w = F.w_out;
            tr_item([&](int k, int n) -> float { return w[(size_t)k * DM + n]; }, DM, F.WOUT, scr, r / 32, r % 32, lane); continue; } r -= I_WOUT;
        { const float* w = F.w_pg;
            tr_item([&](int k, int n) -> float { return w[(size_t)k * DM + n]; }, DM, F.WPG, scr, r / 32, r % 32, lane); }
    }
    for (int e = (F.vcu * NTHREADS + F.tid); e < NPOS * 16; e += F.G * NTHREADS) {
        const int pi = e >> 4, i = e & 15; const double pos = (double)(pi < SEQ ? pi : PAST + (pi - SEQ));
        double inv = 1.0; for (int j = 0; j < i; ++j) inv *= 0.56234132519034908039;
        float s, c; sincos_d(pos * inv, s, c);
        F.ROPE[(size_t)pi * 32 + i] = c; F.ROPE[(size_t)pi * 32 + 16 + i] = s;
    }
    for (int e = F.vcu * NTHREADS + F.tid; e < 256 * 16; e += F.G * NTHREADS) F.W2T[e] = (bf16)f2bf(F.w_a2[(e & 15) * 256 + (e >> 4)]);
    for (int e = F.vcu * NTHREADS + F.tid; e < 512 * QL; e += F.G * NTHREADS) {
        const int q = e >> 8, k = e & 255, h = q >> 6, c = 2 * (q & 63);
        const GAS f32x4* wq = (const GAS f32x4*)(F.w_qup + (size_t)k * 768 + h * 96);
        const GAS f32x4* wu0 = (const GAS f32x4*)(F.w_uk + (size_t)(c * 8 + h) * 64); const GAS f32x4* wu1 = (const GAS f32x4*)(F.w_uk + (size_t)((c + 1) * 8 + h) * 64);
        float s0 = 0.f, s1 = 0.f;
#pragma unroll
        for (int d = 0; d < 16; ++d) { const f32x4 a = wq[d], b0 = wu0[d], b1 = wu1[d];
            s0 += (a.x * b0.x + a.y * b0.y) + (a.z * b0.z + a.w * b0.w); s1 += (a.x * b1.x + a.y * b1.y) + (a.z * b1.z + a.w * b1.w); }
        const float gs = F.g_q[k] * QSCALE;
        F.WQS[(size_t)(h * 128 + c) * QL + k] = (bf16)f2bf(s0 * gs); F.WQS[(size_t)(h * 128 + c + 1) * QL + k] = (bf16)f2bf(s1 * gs);
    }
    for (int e = F.vcu * NTHREADS + F.tid; e < 256 * QL; e += F.G * NTHREADS) {
        const int n = 1024 + (e >> 8), k = e & 255;
        F.WQS[(size_t)n * QL + k] = (bf16)f2bf(F.w_qup[(size_t)k * 768 + qup_src_col(n - 1024 + 512)] * F.g_q[k] * QSCALE);
    }
}
__device__ __forceinline__ void p0_rows(Frame& F) {
    const int gw = F.vcu * NWAVES + F.wave, NGW = F.G * NWAVES, lane = F.lane;
    for (int m0 = 4 * gw; m0 < MT; m0 += 4 * NGW) {
        f32x4 v[4][4], pv[4];
#pragma unroll
        for (int r = 0; r < 4; ++r) { const int m = m0 + r; const GAS f32x4* xr = (const GAS f32x4*)xrow_ptr(F, m) + lane;
#pragma unroll
            for (int j = 0; j < 4; ++j) v[r][j] = xr[64 * j];
            const float* prow = m < MP ? F.p_p + (size_t)m * PD : F.p_s + (size_t)(m - MP) * PD; pv[r] = ((const GAS f32x4*)prow)[lane]; }
#pragma unroll
        for (int r = 0; r < 4; ++r) { const int m = m0 + r; float s = 0.f;
#pragma unroll
            for (int j = 0; j < 4; ++j) s += (v[r][j].x * v[r][j].x + v[r][j].y * v[r][j].y) + (v[r][j].z * v[r][j].z + v[r][j].w * v[r][j].w);
            const float rstd = 1.f / sqrtf(wave_sum(s) * (1.f / DM) + EPS);
            if (lane == 0) F.RSX[m] = rstd;
            GAS unsigned long long* o8 = (GAS unsigned long long*)(F.XN + (size_t)m * DM) + lane;
#pragma unroll
            for (int j = 0; j < 4; ++j) o8[64 * j] = (unsigned long long)pk2(v[r][j].x, v[r][j].y) | ((unsigned long long)pk2(v[r][j].z, v[r][j].w) << 32);
            ((GAS unsigned long long*)(F.PB + (size_t)m * PD))[lane] = (unsigned long long)pk2(pv[r].x, pv[r].y) | ((unsigned long long)pk2(pv[r].z, pv[r].w) << 32); }
    }
}

namespace pg8 {
__device__ __forceinline__ u32x4 pack8(const f32x4 v0, const f32x4 v1) { u32x4 w; w.x = cvt_pk_bf16(v0[0], v0[1]); w.y = cvt_pk_bf16(v0[2], v0[3]); w.z = cvt_pk_bf16(v1[0], v1[1]); w.w = cvt_pk_bf16(v1[2], v1[3]); return w; }
struct EpiZ {
    static constexpr bool PERM = true;
    bf16_t* Z; float* ssq_q; float* ssq_kv; const float* rsx;
    __device__ __forceinline__ void operator()(const f32x4 (&acc)[2][2][4][2], const Unit& u, int wr, int wc, int, int) const {
        int ln_; FRESH_LANE_ID(ln_); const int fr = ln_ & 15, fq = ln_ >> 4;
        const int row0 = u.pm * BM + wr * 64 + fr, col0 = u.pn * BM + wc * 32 + 8 * fq;
#pragma unroll
        for (int ai = 0; ai < 2; ++ai)
#pragma unroll
            for (int m = 0; m < 4; ++m) { bf16_t* rowp = Z + (size_t)(row0 + ai * HALF + m * 16) * ZP + col0; const float rs = rsx[row0 + ai * HALF + m * 16];
#pragma unroll
                for (int bj = 0; bj < 2; ++bj) *(u32x4*)(rowp + bj * HALF) = pack8(acc[ai][bj][m][0] * rs, acc[ai][bj][m][1] * rs); }
        if (u.pn < 2) {
            float* dst = u.pn == 0 ? ssq_q : ssq_kv; const bool both = (u.pn == 0);
#pragma unroll
            for (int ai = 0; ai < 2; ++ai)
#pragma unroll
                for (int m = 0; m < 4; ++m) { float s = 0.f; const float rs = rsx[row0 + ai * HALF + m * 16];
#pragma unroll
                    for (int n = 0; n < 2; ++n) { const f32x4 a = acc[ai][0][m][n], b = acc[ai][1][m][n];
                        s += (a[0] * a[0] + a[1] * a[1]) + (a[2] * a[2] + a[3] * a[3]);
                        if (both) s += (b[0] * b[0] + b[1] * b[1]) + (b[2] * b[2] + b[3] * b[3]); }
                    s += __shfl_xor(s, 16); s += xor32(s, fq >= 2);
                    if (fq == 0) unsafeAtomicAdd(dst + row0 + ai * HALF + m * 16, s * rs * rs); }
        }
    }
};
struct EpiScale {
    static constexpr bool PERM = true;
    bf16_t* O0; bf16_t* O1; int split_tile; int ldc;
    const float* ssq; float inv_dim; int row_base;
    int rope_tile; const float* rope; int pos_mask, pos_base;
    __device__ __forceinline__ void operator()(const f32x4 (&acc)[2][2][4][2], const Unit& u, int wr, int wc, int, int) const {
        int ln_; FRESH_LANE_ID(ln_); const int fr = ln_ & 15, fq = ln_ >> 4;
        const int row0 = u.pm * BM + wr * 64 + fr;
        bf16_t* base = u.pn < split_tile ? O0 + u.pn * BM : O1 + (u.pn - split_tile) * BM;
        const int col0 = wc * 32 + 8 * fq;
        if (u.pn != rope_tile) {
#pragma unroll
            for (int ai = 0; ai < 2; ++ai)
#pragma unroll
                for (int m = 0; m < 4; ++m) { const int row = row0 + ai * HALF + m * 16;
                    const float rs = ssq ? rsq(ssq[row_base + row] * inv_dim + EPS) : 1.f;
                    bf16_t* rowp = base + (size_t)row * ldc + col0;
#pragma unroll
                    for (int bj = 0; bj < 2; ++bj) *(u32x4*)(rowp + bj * HALF) = pack8(acc[ai][bj][m][0] * rs, acc[ai][bj][m][1] * rs); }
        } else {
#pragma unroll
            for (int ai = 0; ai < 2; ++ai)
#pragma unroll
                for (int m = 0; m < 4; ++m) { const int row = row0 + ai * HALF + m * 16;
                    const float rs = ssq ? rsq(ssq[row_base + row] * inv_dim + EPS) : 1.f;
                    bf16_t* rowp = base + (size_t)row * ldc + col0;
                    const float* tb = rope + (size_t)(pos_base + (row & pos_mask)) * 32 + 8 * (fq & 1);
                    const f32x4 cs0 = *(const f32x4*)tb, cs1 = *(const f32x4*)(tb + 4), sn0 = *(const f32x4*)(tb + 16), sn1 = *(const f32x4*)(tb + 20);
#pragma unroll
                    for (int bj = 0; bj < 2; ++bj) { f32x4 v0 = acc[ai][bj][m][0] * rs, v1 = acc[ai][bj][m][1] * rs; f32x4 o0, o1;
#pragma unroll
                        for (int e = 0; e < 4; ++e) { o0[e] = xor32(v0[e], fq >= 2); o1[e] = xor32(v1[e], fq >= 2); }
                        if (fq < 2) { v0 = v0 * cs0 - o0 * sn0; v1 = v1 * cs1 - o1 * sn1; } else { v0 = o0 * sn0 + v0 * cs0; v1 = o1 * sn1 + v1 * cs1; }
                        *(u32x4*)(rowp + bj * HALF) = pack8(v0, v1); }
                    asm volatile("" ::: "memory"); }
        }
    }
};
}

__device__ __forceinline__ void p2_rows(Frame& F) {
    const int gw = F.vcu * NWAVES + F.wave, NGW = F.G * NWAVES, lane = F.lane, g4 = lane >> 4, l16 = lane & 15;
    const f32x4 gk0 = *(const GAS f32x4*)(F.g_kv + 8 * l16), gk1 = *(const GAS f32x4*)(F.g_kv + 8 * l16 + 4);
    for (int m0 = 4 * gw; m0 < MT; m0 += 4 * NGW) {
        const int m = m0 + g4; const bf16* zr = F.Z + (size_t)m * ZP;
        const v4u zz = *(const GAS v4u*)(zr + ZC_KV + 8 * l16);
        const float x1 = bf2f(zr[ZC_KR + l16]), x2 = bf2f(zr[ZC_KR + 16 + l16]);
        const float rstd = rsq(F.SSQ_KV[m] * (1.f / KVL) + EPS);
        const int pi = m < MP ? (m & (SEQ - 1)) : SEQ + ((m - MP) & (DECT - 1));
        const float c = F.ROPE[(size_t)pi * 32 + l16], s = F.ROPE[(size_t)pi * 32 + 16 + l16];
        float* co = (m < MP ? F.out + O_CKVP + (size_t)m * KVL : F.out + O_CKVS + (size_t)(m - MP) * KVL) + 8 * l16;
        *(GAS f32x4*)co = (f32x4){bflo(zz.x) * rstd * gk0.x, bfhi(zz.x) * rstd * gk0.y, bflo(zz.y) * rstd * gk0.z, bfhi(zz.y) * rstd * gk0.w};
        *(GAS f32x4*)(co + 4) = (f32x4){bflo(zz.z) * rstd * gk1.x, bfhi(zz.z) * rstd * gk1.y, bflo(zz.w) * rstd * gk1.z, bfhi(zz.w) * rstd * gk1.w};
        const float o1 = x1 * c - x2 * s, o2 = x1 * s + x2 * c;
        float* ko = (m < MP ? F.out + O_KRP + (size_t)m * QR : F.out + O_KRS + (size_t)(m - MP) * QR);
        ko[l16] = o1; ko[16 + l16] = o2;
        F.KR[(size_t)m * 32 + l16] = (bf16)f2bf(o1); F.KR[(size_t)m * 32 + 16 + l16] = (bf16)f2bf(o2);
    }
}

__device__ __forceinline__ float logsig16(float x) { return (fminf(x, 0.f) - __logf(1.f + __expf(-fabsf(x)))) * 0.0625f; }
__device__ __forceinline__ void unpack8(const v4u w, float* f) { f[0] = bflo(w.x); f[1] = bfhi(w.x); f[2] = bflo(w.y); f[3] = bfhi(w.y); f[4] = bflo(w.z); f[5] = bfhi(w.z); f[6] = bflo(w.w); f[7] = bfhi(w.w); }

constexpr int TRI_CB = 4160, TRI_BYTES = 4 * TRI_CB;
__device__ __forceinline__ s16x4 tr_read(LAS const unsigned char* p) { typedef short v4i16_t __attribute__((ext_vector_type(4))); return __builtin_bit_cast(s16x4, __builtin_amdgcn_ds_read_tr16_b64_v4i16((LAS v4i16_t*)p)); }
__device__ __forceinline__ bf16x8 tri_frag(LAS const unsigned char* img, int cb, int ks, int lane) {
    const int hh = lane >> 5, g1 = (lane >> 4) & 1, i = lane & 15;
    LAS const unsigned char* p = img + cb * TRI_CB + (16 * ks + 4 * hh + (i >> 2)) * 64 + g1 * 32 + (i & 3) * 8;
    const s16x4 lo = tr_read(p), hi = tr_read(p + 512);
    return (bf16x8){lo[0], lo[1], lo[2], lo[3], hi[0], hi[1], hi[2], hi[3]};
}
__device__ __forceinline__ void tri_store(LAS unsigned char* img, int row, int c8, v4u v) { *(LAS v4u*)(img + (c8 >> 2) * TRI_CB + row * 64 + (c8 & 3) * 16) = v; }

struct GlLd { bf16x8 af; v4u q, k, v[2]; };
__device__ __forceinline__ void gla_local_load(Frame& F, const int unit, const int lane, GlLd& L) {
    const int c = unit & (NCH - 1), bh = unit >> 7, h = bh & 3, b = bh >> 2, tid = F.wave * 64 + lane;
    const size_t row0 = (size_t)b * SEQ + c * 64; const int t = tid >> 3, kg = tid & 7; const bf16* zr = F.Z + (row0 + t) * ZP;
    { const int w = F.wave, r32 = lane & 31, hh = lane >> 5; L.af = *(const GAS bf16x8*)(F.Z + (row0 + 32 * (w & 1) + r32) * ZP + ZC_AG + 8 * hh); }
    L.q = *(const GAS v4u*)(zr + ZC_QG + h * 64 + kg * 8); L.k = *(const GAS v4u*)(zr + ZC_KG + h * 64 + kg * 8);
#pragma unroll
    for (int i = 0; i < 2; ++i) { const int p = tid + 512 * i, tt = p >> 4, dch = p & 15; L.v[i] = *(const GAS v4u*)(F.Z + (row0 + tt) * ZP + ZC_VG + h * 128 + dch * 8); }
}
__device__ __forceinline__ void gla_local_compute(Frame& F, const int unit, const int lane, const GlLd& L) {
    const int c = unit & (NCH - 1), bh = unit >> 7, h = bh & 3, b = bh >> 2;
    const int row0 = b * SEQ + c * 64, tid = F.wave * 64 + lane;
    LAS float* LA = (LAS float*)F.lds;
    LAS float* SEG = (LAS float*)(F.lds + 16640);
    LAS unsigned char* KHI = F.lds + 20480;
    LAS unsigned char* VI = F.lds + 20480 + 2 * TRI_CB;
    if (F.wave < 4) { const int tb = F.wave & 1, kb = F.wave >> 1, r32 = lane & 31, hh = lane >> 5; const int col = h * 64 + 32 * kb + r32;
        const bf16x8 bfr = *(const GAS bf16x8*)(F.W2T + col * 16 + 8 * hh); const float bias = F.b_a[col];
        f32x16 x = {}; x = __builtin_amdgcn_mfma_f32_32x32x16_bf16(L.af, bfr, x, 0, 0, 0);
#pragma unroll
        for (int i = 0; i < 16; ++i) LA[(32 * tb + crow(i, hh)) * 65 + 32 * kb + r32] = logsig16(x[i] + bias); }
    __syncthreads();
    { const int k = tid & 63, seg = tid >> 6; float s = 0.f;
#pragma unroll
      for (int i = 0; i < 8; ++i) s += LA[(seg * 8 + i) * 65 + k];
      SEG[seg * 64 + k] = s;
      __syncthreads();
      float run = 0.f;
      for (int s2 = 0; s2 < seg; ++s2) run += SEG[s2 * 64 + k];
#pragma unroll
      for (int i = 0; i < 8; ++i) { run += LA[(seg * 8 + i) * 65 + k]; LA[(seg * 8 + i) * 65 + k] = run; } }
    __syncthreads();
    { const int t = tid >> 3, kg = tid & 7; const size_t row = (size_t)(row0 + t);
      float q[8], kk8[8]; unpack8(L.q, q); unpack8(L.k, kk8);
      float qt[8], kt[8], kh[8];
#pragma unroll
      for (int e = 0; e < 8; ++e) { const int k = kg * 8 + e; const float bv = LA[t * 65 + k], bl = LA[63 * 65 + k];
          qt[e] = q[e] * __expf(bv) * 0.125f; kt[e] = kk8[e] * __expf(-bv); kh[e] = kk8[e] * __expf(bl - bv); }
      v4u o; o.x = pk2(qt[0], qt[1]); o.y = pk2(qt[2], qt[3]); o.z = pk2(qt[4], qt[5]); o.w = pk2(qt[6], qt[7]);
      *(GAS v4u*)(F.QT + row * 256 + h * 64 + kg * 8) = o;
      o.x = pk2(kt[0], kt[1]); o.y = pk2(kt[2], kt[3]); o.z = pk2(kt[4], kt[5]); o.w = pk2(kt[6], kt[7]);
      *(GAS v4u*)(F.KT + row * 256 + h * 64 + kg * 8) = o;
      o.x = pk2(kh[0], kh[1]); o.y = pk2(kh[2], kh[3]); o.z = pk2(kh[4], kh[5]); o.w = pk2(kh[6], kh[7]);
      tri_store(KHI, t, kg, o);
#pragma unroll
      for (int i = 0; i < 2; ++i) { const int p = tid + 512 * i, tt = p >> 4, dch = p & 15; tri_store(VI, tt, dch, L.v[i]); }
      if (tid < 64) F.DEC[(size_t)unit * 64 + tid] = __expf(LA[63 * 65 + tid]); }
    __syncthreads();
    { const int mb = F.wave & 1, nb = F.wave >> 1, r = lane & 31, hh = lane >> 5; f32x16 acc = {};
#pragma unroll
      for (int ks = 0; ks < 4; ++ks) acc = __builtin_amdgcn_mfma_f32_32x32x16_bf16(tri_frag(KHI, mb, ks, lane), tri_frag(VI, nb, ks, lane), acc, 0, 0, 0);
      GAS bf16* up = (GAS bf16*)F.U + (size_t)unit * (GDK * GDV) + 32 * nb + r;
#pragma unroll
      for (int i = 0; i < 16; ++i) up[(size_t)(32 * mb + crow(i, hh)) * GDV] = (bf16)f2bf(acc[i]); }
    __syncthreads();
}
__device__ __forceinline__ void gla_local_phase(Frame& F) {
    int lane; FRESH_LANE_ID(lane);
    GlLd nxt; int u = F.vcu;
    if (u < NGU) gla_local_load(F, u, lane, nxt);
    for (; u < NGU; u += F.G) { const GlLd cur = nxt; if (u + F.G < NGU) gla_local_load(F, u + F.G, lane, nxt); gla_local_compute(F, u, lane, cur); }
}

__device__ __forceinline__ void gla_scan(Frame& F) {
    for (int e = F.vcu * NTHREADS + F.tid; e < NB * HG * GDK * GDV; e += F.G * NTHREADS) {
        const int bh = e >> 13, k = (e >> 7) & 63, dv = e & 127; float S = 0.f;
        const GAS bf16* up = (const GAS bf16*)F.U + (size_t)bh * NCH * (GDK * GDV) + k * GDV + dv; const float* dp = F.DEC + (size_t)bh * NCH * 64 + k; bf16* sp = F.SPREV + (size_t)bh * NCH * (GDK * GDV) + k * GDV + dv;
        for (int c0 = 0; c0 < NCH; c0 += 16) { float u[16], d[16];
#pragma unroll
            for (int i = 0; i < 16; ++i) { u[i] = bf2f(up[(size_t)(c0 + i) * (GDK * GDV)]); d[i] = dp[(size_t)(c0 + i) * 64]; }
#pragma unroll
            for (int i = 0; i < 16; ++i) { sp[(size_t)(c0 + i) * (GDK * GDV)] = (bf16)f2bf(S); S = d[i] * S + u[i]; } }
        F.out[O_GSP + (size_t)e] = S;
    }
}

struct GoLd { v4u sv[2], vv[2]; v2u qp[8]; bf16x8 qn[4]; bf16x8 kf[2][4]; v4u gate[2]; };
__device__ __forceinline__ void gla_out_load(Frame& F, const int unit, const int lane, GoLd& L) {
    const int c = unit & (NCH - 1), bh = unit >> 7, h = bh & 3, b = bh >> 2, w = F.wave, tid = w * 64 + lane, r = lane & 31, hh = lane >> 5, tb = w >> 2;
    const size_t row0 = (size_t)b * SEQ + c * 64;
#pragma unroll
    for (int i = 0; i < 2; ++i) { const int p = tid + 512 * i, row = p >> 4, c8 = p & 15;
        L.sv[i] = *(const GAS v4u*)(F.SPREV + (size_t)unit * (GDK * GDV) + row * GDV + c8 * 8);
        L.vv[i] = *(const GAS v4u*)(F.Z + (row0 + row) * ZP + ZC_VG + h * 128 + c8 * 8); }
    const bf16* qrow = F.QT + (row0 + 32 * tb + r) * 256 + h * 64;
#pragma unroll
    for (int ks = 0; ks < 4; ++ks) { L.qp[2 * ks] = *(const GAS v2u*)(qrow + 16 * ks + 4 * hh); L.qp[2 * ks + 1] = *(const GAS v2u*)(qrow + 16 * ks + 8 + 4 * hh); L.qn[ks] = *(const GAS bf16x8*)(qrow + 16 * ks + 8 * hh); }
#pragma unroll
    for (int sb = 0; sb < 2; ++sb) { const bf16* krow = F.KT + (row0 + 32 * sb + r) * 256 + h * 64;
#pragma unroll
        for (int ks = 0; ks < 4; ++ks) L.kf[sb][ks] = *(const GAS bf16x8*)(krow + 16 * ks + 8 * hh); }
    { const int t = tid >> 3, part = tid & 7; const bf16* gp = F.Z + (row0 + t) * ZP + ZC_GG + h * 128 + part * 16; L.gate[0] = *(const GAS v4u*)gp; L.gate[1] = *(const GAS v4u*)(gp + 8); }
}
__device__ __forceinline__ void gla_out_compute(Frame& F, const int unit, const int lane, const GoLd& L, const float (&gon)[16]) {
    const int c = unit & (NCH - 1), bh = unit >> 7, h = bh & 3, b = bh >> 2;
    const int row0 = b * SEQ + c * 64, tid = F.wave * 64 + lane, r = lane & 31, hh = lane >> 5;
    LAS unsigned char* SI = F.lds;
    LAS unsigned char* VI = F.lds + TRI_BYTES;
    LAS float* OS = (LAS float*)(F.lds + 2 * TRI_BYTES);
#pragma unroll
    for (int i = 0; i < 2; ++i) { const int p = tid + 512 * i, row = p >> 4, c8 = p & 15; tri_store(SI, row, c8, L.sv[i]); tri_store(VI, row, c8, L.vv[i]); }
    __syncthreads();
    const int dvb = F.wave & 3, tb = F.wave >> 2;
    f32x16 o = {};
#pragma unroll
    for (int ks = 0; ks < 4; ++ks) { const bf16x8 sf = tri_frag(SI, dvb, ks, lane);
        const v4u qw = {L.qp[2 * ks].x, L.qp[2 * ks].y, L.qp[2 * ks + 1].x, L.qp[2 * ks + 1].y};
        o = __builtin_amdgcn_mfma_f32_32x32x16_bf16(__builtin_bit_cast(bf16x8, qw), sf, o, 0, 0, 0); }
#pragma unroll
    for (int sb = 0; sb < 2; ++sb) if (sb <= tb) { f32x16 at = {};
#pragma unroll
        for (int ks = 0; ks < 4; ++ks) at = __builtin_amdgcn_mfma_f32_32x32x16_bf16(L.kf[sb][ks], L.qn[ks], at, 0, 0, 0);
        if (sb == tb) {
#pragma unroll
            for (int i = 0; i < 16; ++i) if (crow(i, hh) > r) at[i] = 0.f; }
#pragma unroll
        for (int k2 = 0; k2 < 2; ++k2) { v4u pw; pw.x = pk2(at[8 * k2 + 0], at[8 * k2 + 1]); pw.y = pk2(at[8 * k2 + 2], at[8 * k2 + 3]); pw.z = pk2(at[8 * k2 + 4], at[8 * k2 + 5]); pw.w = pk2(at[8 * k2 + 6], at[8 * k2 + 7]);
            o = __builtin_amdgcn_mfma_f32_32x32x16_bf16(__builtin_bit_cast(bf16x8, pw), tri_frag(VI, dvb, 2 * sb + k2, lane), o, 0, 0, 0); } }
#pragma unroll
    for (int i = 0; i < 16; ++i) OS[(32 * tb + crow(i, hh)) * 132 + 32 * dvb + r] = o[i];
    __syncthreads();
    { const int t = tid >> 3, part = tid & 7; const LAS float* orow = OS + t * 132 + part * 16; float v[16]; float ss = 0.f;
#pragma unroll
      for (int e = 0; e < 16; ++e) { v[e] = orow[e]; ss += v[e] * v[e]; }
      ss += __shfl_xor(ss, 1); ss += __shfl_xor(ss, 2); ss += __shfl_xor(ss, 4);
      const float rstd = rsq(ss * (1.f / GDV) + EPS);
      const size_t row = (size_t)(row0 + t); float g[16]; unpack8(L.gate[0], g); unpack8(L.gate[1], g + 8);
      float res[16];
#pragma unroll
      for (int e = 0; e < 16; ++e) res[e] = v[e] * rstd * gon[e] * siluf(g[e]);
      v4u w0, w1; w0.x = pk2(res[0], res[1]); w0.y = pk2(res[2], res[3]); w0.z = pk2(res[4], res[5]); w0.w = pk2(res[6], res[7]);
      w1.x = pk2(res[8], res[9]); w1.y = pk2(res[10], res[11]); w1.z = pk2(res[12], res[13]); w1.w = pk2(res[14], res[15]);
      bf16* mp = F.MIX + row * DM + 512 + h * 128 + part * 16; *(GAS v4u*)mp = w0; *(GAS v4u*)(mp + 8) = w1; }
    __syncthreads();
}
__device__ __forceinline__ void gla_out_phase(Frame& F) {
    int lane; FRESH_LANE_ID(lane);
    float gon[16];
#pragma unroll
    for (int e = 0; e < 16; ++e) gon[e] = F.g_on[(lane & 7) * 16 + e];
    GoLd nxt; int u = F.vcu;
    if (u < NGU) gla_out_load(F, u, lane, nxt);
    for (; u < NGU; u += F.G) { const GoLd cur = nxt; if (u + F.G < NGU) gla_out_load(F, u + F.G, lane, nxt); gla_out_compute(F, u, lane, cur, gon); }
}

__device__ __forceinline__ void gla_sample_unit(Frame& F, const int unit) {
    int ln_; FRESH_LANE_ID(ln_);
    const int h = unit & 3, b = unit >> 2, tid = F.wave * 64 + ln_; const int row0 = MP + b * DECT;
    LAS float* LA = (LAS float*)F.lds;
    LAS float* QS_ = LA + 512;
    LAS float* KS_ = QS_ + 512;
    LAS float* KH_ = KS_ + 512;
    LAS float* VS_ = KH_ + 512;
    LAS float* AI = VS_ + 1024;
    LAS float* RED = AI + 64;
    { const int t = tid >> 6, k = tid & 63; const bf16* zr = F.Z + (size_t)(row0 + t) * ZP;
      float a[16]; unpack8(*(const GAS v4u*)(zr + ZC_AG), a); unpack8(*(const GAS v4u*)(zr + ZC_AG + 8), a + 8);
      const int col = h * 64 + k; float x = F.b_a[col];
#pragma unroll
      for (int r = 0; r < 16; ++r) x += a[r] * F.w_a2[r * 256 + col];
      LA[t * 64 + k] = logsig16(x); }
    __syncthreads();
    if (tid < 64) { float run = 0.f;
#pragma unroll
        for (int t = 0; t < 8; ++t) { run += LA[t * 64 + tid]; LA[t * 64 + tid] = run; } }
    __syncthreads();
    { const int t = tid >> 6, k = tid & 63; const bf16* zr = F.Z + (size_t)(row0 + t) * ZP;
      const float bv = LA[t * 64 + k], bl = LA[7 * 64 + k], q = bf2f(zr[ZC_QG + h * 64 + k]), kk = bf2f(zr[ZC_KG + h * 64 + k]);
      QS_[t * 64 + k] = q * __expf(bv) * 0.125f; KS_[t * 64 + k] = kk * __expf(-bv); KH_[t * 64 + k] = kk * __expf(bl - bv);
#pragma unroll
      for (int i = 0; i < 2; ++i) { const int p = tid + 512 * i, tt = p >> 7, dv = p & 127; VS_[tt * 128 + dv] = bf2f(F.Z[(size_t)(row0 + tt) * ZP + ZC_VG + h * 128 + dv]); } }
    __syncthreads();
    if (tid < 64) { const int t = tid >> 3, s = tid & 7; float a = 0.f;
        if (s <= t) {
#pragma unroll 8
            for (int k = 0; k < 64; ++k) a += QS_[t * 64 + k] * KS_[s * 64 + k]; }
        AI[t * 8 + s] = a; }
    { const int kq = tid >> 7, dv = tid & 127; const float* s0p = F.state_gla + (((size_t)b * HG + h) * GDK + kq * 16) * GDV + dv; float* snp = F.out + O_GSS + (((size_t)b * HG + h) * GDK + kq * 16) * GDV + dv;
      float s0[16];
#pragma unroll
      for (int kk = 0; kk < 16; ++kk) s0[kk] = s0p[(size_t)kk * GDV];
      float po[8];
#pragma unroll
      for (int t = 0; t < 8; ++t) { float a = 0.f;
#pragma unroll
          for (int kk = 0; kk < 16; ++kk) a += QS_[t * 64 + kq * 16 + kk] * s0[kk];
          po[t] = a; }
#pragma unroll
      for (int t = 0; t < 8; ++t) RED[(kq * 8 + t) * 128 + dv] = po[t];
#pragma unroll
      for (int kk = 0; kk < 16; ++kk) { const int k = kq * 16 + kk; float sn = __expf(LA[7 * 64 + k]) * s0[kk];
#pragma unroll
          for (int t = 0; t < 8; ++t) sn += KH_[t * 64 + k] * VS_[t * 128 + dv];
          snp[(size_t)kk * GDV] = sn; } }
    __syncthreads();
    { const int t = tid >> 6, j = tid & 63; float ov[2]; float ss = 0.f;
#pragma unroll
      for (int i = 0; i < 2; ++i) { const int dv = j + 64 * i; float o = RED[(0 * 8 + t) * 128 + dv] + RED[(1 * 8 + t) * 128 + dv] + RED[(2 * 8 + t) * 128 + dv] + RED[(3 * 8 + t) * 128 + dv];
          for (int s = 0; s <= t; ++s) o += AI[t * 8 + s] * VS_[s * 128 + dv];
          ov[i] = o; ss += o * o; }
      const float rstd = rsq(wave_sum(ss) * (1.f / GDV) + EPS); const size_t row = (size_t)(row0 + t);
#pragma unroll
      for (int i = 0; i < 2; ++i) { const int dv = j + 64 * i; const float g = bf2f(F.Z[row * ZP + ZC_GG + h * 128 + dv]);
          F.MIX[row * DM + 512 + h * 128 + dv] = (bf16)f2bf(ov[i] * rstd * F.g_on[dv] * siluf(g)); } }
    __syncthreads();
}

constexpr int AT_KSLOT = 12288, AT_VSLOT = 8192, AT_V0 = 4 * AT_KSLOT, AT_WSF = AT_V0 + 3 * AT_VSLOT, AT_OST = AT_WSF + NWAVES * 256, AT_END = AT_OST + NWAVES * 4096;
static_assert(AT_END <= RING_BYTES, "attention LDS");
__device__ __forceinline__ float max16(const f32x16& p) {
    float a = fmaxf(fmaxf(p[0], p[1]), fmaxf(p[2], p[3])), b = fmaxf(fmaxf(p[4], p[5]), fmaxf(p[6], p[7]));
    float c = fmaxf(fmaxf(p[8], p[9]), fmaxf(p[10], p[11])), d = fmaxf(fmaxf(p[12], p[13]), fmaxf(p[14], p[15]));
    return fmaxf(fmaxf(a, b), fmaxf(c, d));
}
__device__ __forceinline__ bf16x8 pack_p(const f32x16& p, int base) {
    v4u w; w.x = pk2(p[base + 0], p[base + 1]); w.y = pk2(p[base + 2], p[base + 3]); w.z = pk2(p[base + 4], p[base + 5]); w.w = pk2(p[base + 6], p[base + 7]); return __builtin_bit_cast(bf16x8, w);
}
#ifndef AT_STHR
#define AT_STHR 1024.0f
#endif
#define AT_SBAR() __builtin_amdgcn_sched_barrier(0)
#define AT_PIN(x) asm volatile("" : "+v"(x))
#define AT_MFMA(a, b, c) __builtin_amdgcn_mfma_f32_32x32x16_bf16(a, b, c, 0, 0, 0)
#define AT_WAIT_BAR(N) asm volatile("s_waitcnt vmcnt(" #N ") lgkmcnt(0)\n\ts_barrier" ::: "memory")
__device__ __forceinline__ void at_glds16(const char* sbase, unsigned voff, unsigned lds_base) {
    unsigned sv; asm volatile("s_mov_b32 %0, m0\n\ts_mov_b32 m0, %3\n\ts_nop 0\n\tglobal_load_lds_dwordx4 %1, %2\n\ts_mov_b32 m0, %0" : "=&s"(sv) : "v"(voff), "s"(sbase), "s"(lds_base) : "memory"); }
__device__ __forceinline__ void at_kload2(bf16x8* kf, LAS const unsigned char* kp, int d0) { kf[2 * d0] = *(const LAS bf16x8*)(kp + d0 * 2048); kf[2 * d0 + 1] = *(const LAS bf16x8*)(kp + d0 * 2048 + 512); }
#define AT_MX3(a, b, c) __builtin_fmaxf(__builtin_fmaxf((a), (b)), (c))
__device__ __forceinline__ float at_rowmax(const f32x16& p0, const f32x16& p1) {
    float a = AT_MX3(p0[0], p0[1], p1[0]), b = AT_MX3(p0[2], p0[3], p1[1]); a = AT_MX3(a, p1[2], p1[3]);
#pragma unroll
    for (int r = 4; r < 16; r += 4) { a = AT_MX3(a, p0[r], p0[r + 1]); b = AT_MX3(b, p0[r + 2], p0[r + 3]); a = AT_MX3(a, p1[r], p1[r + 1]); b = AT_MX3(b, p1[r + 2], p1[r + 3]); }
    float m = __builtin_fmaxf(a, b); auto rr = __builtin_amdgcn_permlane32_swap(__float_as_uint(m), __float_as_uint(m), false, false);
    return __builtin_fmaxf(__uint_as_float(rr[0]), __uint_as_float(rr[1])); }
__device__ __forceinline__ void at_cmask(f32x16& p0, f32x16& p1, int jb, int qrel, int hi) {
    const int d_ = qrel - 64 * jb - 4 * hi;
#pragma unroll
    for (int i = 0; i < 16; ++i) { if ((i & 3) + 8 * (i >> 2) > d_) p0[i] = -INFINITY; if ((i & 3) + 8 * (i >> 2) + 32 > d_) p1[i] = -INFINITY; } }
__device__ __forceinline__ void attn_prompt_unit(Frame& F, const int b, const int h, const int qb) {
    int ln_; FRESH_LANE_ID(ln_);
    const int lane = ln_, w = F.wave, r32 = lane & 31, hi = lane >> 5;
    const size_t R0 = (size_t)b * SEQ; const int q0 = qb * 256;
    LAS unsigned char* const lds = F.lds; const unsigned lds0 = (unsigned)(size_t)lds;
    LAS float* wsf = (LAS float*)(lds + AT_WSF) + w * 64;
    const int NT = 4 * (qb + 1);
    const char* const qbase = (const char*)(F.QP + (R0 + q0) * 768);
    const unsigned qoff = (unsigned)((32 * w + r32) * 768 + 8 * hi) * 2u;
    bf16x8 qr[6];
#pragma unroll
    for (int d0 = 0; d0 < 4; ++d0) qr[d0] = *(const GAS bf16x8*)(qbase + (qoff + (unsigned)(h * 64 + 16 * d0) * 2u));
#pragma unroll
    for (int d0 = 4; d0 < 6; ++d0) qr[d0] = *(const GAS bf16x8*)(qbase + (qoff + (unsigned)(512 + h * 32 + 16 * (d0 - 4)) * 2u));
    const char* const kbase = (const char*)(F.KN + R0 * 512 + h * 64);
    const char* const rbase = (const char*)(F.KR + R0 * 32);
    const char* const vbase = (const char*)(F.VV + R0 * 512 + h * 64);
    const unsigned koff = (unsigned)(lane * 512 + w * 8) * 2u, roff = (unsigned)(lane * 32 + (w & 3) * 8) * 2u;
    const unsigned voff = (unsigned)((16 * (w & 3) + (lane >> 2)) * 512 + (w >> 2) * 32 + (lane & 3) * 8) * 2u;
    const unsigned kdst = lds0 + w * 1024, rdst = lds0 + (8 + (w & 3)) * 1024, vdst = lds0 + AT_V0 + w * 1024;
#define AT_DMA_K(t, slot) do { at_glds16(kbase + (size_t)(t) * 65536u, koff, (unsigned)__builtin_amdgcn_readfirstlane(kdst + (slot) * AT_KSLOT)); \
                               at_glds16(rbase + (size_t)(t) * 4096u, roff, (unsigned)__builtin_amdgcn_readfirstlane(rdst + (slot) * AT_KSLOT)); } while (0)
#define AT_DMA_V(t, slot) at_glds16(vbase + (size_t)(t) * 65536u, voff, (unsigned)__builtin_amdgcn_readfirstlane(vdst + (slot) * AT_VSLOT))
    LAS const unsigned char* const vp0 = lds + AT_V0 + ((lane >> 4) & 1) * 32 + (lane & 3) * 8 + (4 * hi + ((lane & 15) >> 2)) * 64;
    LAS const unsigned char* const kp0 = lds + hi * 1024 + r32 * 16;
    AT_DMA_K(0, 0); AT_DMA_V(0, 0); AT_DMA_K(1, 1); AT_DMA_K(2, 2);
    float nm, l_reg = 0.f, slast = 0.f; f32x16 o[2]; o[0] = f32x16{}; o[1] = f32x16{};
    f32x16 negm;
    const int qrel = w * 32 + r32; bool resc = false;
    f32x16 pA0, pA1, pB0, pB1; bf16x8 kf[12]; s16x4 vlo[8], vhi[8]; v4u pw0, pw1, pw2, pw3;
    int vs_prev = 0, vs_cur = 0, vs_next = 1;
#define AT_ROT() do { vs_prev = vs_cur; vs_cur = vs_next; vs_next = (vs_next == 2) ? 0 : vs_next + 1; } while (0)
#define AT_EX(v) __builtin_amdgcn_exp2f(v)
#define AT_RESC() do { if (resc) { _Pragma("unroll") for (int d_ = 0; d_ < 2; ++d_) _Pragma("unroll") for (int r = 0; r < 16; ++r) o[d_][r] *= wsf[crow(r, hi)]; } } while (0)
    AT_WAIT_BAR(5);
    { const f32x16 z = f32x16{};
      at_kload2(kf, kp0, 0); pA0 = AT_MFMA(kf[0], qr[0], z); pA1 = AT_MFMA(kf[1], qr[0], z);
#pragma unroll
      for (int d0 = 1; d0 < 6; ++d0) { at_kload2(kf, kp0, d0); pA0 = AT_MFMA(kf[2 * d0], qr[d0], pA0); pA1 = AT_MFMA(kf[2 * d0 + 1], qr[d0], pA1); } }
    if (NT == 4) at_cmask(pA0, pA1, 0, qrel, hi);
    { const float rm = at_rowmax(pA0, pA1); nm = -rm;
#pragma unroll
      for (int r = 0; r < 16; ++r) { pA0[r] = AT_EX(pA0[r] + nm); pA1[r] = AT_EX(pA1[r] + nm); negm[r] = nm; } }
    AT_PIN(negm);
    AT_WAIT_BAR(0);
    AT_DMA_K(3, 3); AT_DMA_V(1, 1); AT_ROT();
    at_kload2(kf, kp0 + AT_KSLOT, 0); at_kload2(kf, kp0 + AT_KSLOT, 1);
#define AT_PKW(P, i) pk2(P[i], P[i + 1])
#define AT_PAF(k) __builtin_bit_cast(bf16x8, pw##k)
#define AT_VFR(i) (bf16x8){vlo[i][0], vlo[i][1], vlo[i][2], vlo[i][3], vhi[i][0], vhi[i][1], vhi[i][2], vhi[i][3]}
#define AT_VRD(i) do { vlo[i] = tr_read(vp_ + (((i) >> 2) * 4096 + ((i) & 3) * 1024)); vhi[i] = tr_read(vp_ + (((i) >> 2) * 4096 + ((i) & 3) * 1024 + 512)); } while (0)
#define AT_KJ(d0) at_kload2(kf, kp_, d0)
#define AT_KRD(G, d0) do { if (G) { at_kload2(kf, kn_, d0); } } while (0)
#define AT_GAPM(MF, RD) do { MF; RD; AT_SBAR(); } while (0)
#define AT_GAPB(MF, RD, X, i) do { MF; RD; X[i] = AT_EX(X[i]); X[i + 1] = AT_EX(X[i + 1]); X[i + 2] = AT_EX(X[i + 2]); X[i + 3] = AT_EX(X[i + 3]); AT_PIN(X); AT_SBAR(); } while (0)
#define AT_STEP(C0, C1, P0, P1, t, MASK, GK, GV, GL) do { AT_SBAR(); \
    LAS const unsigned char* const vp_ = vp0 + vs_prev * AT_VSLOT; LAS const unsigned char* const kp_ = kp0 + ((t) & 3) * AT_KSLOT; LAS const unsigned char* const kn_ = kp0 + (((t) + 1) & 3) * AT_KSLOT; \
    float sacc = P0[0] + P0[1]; \
    C0 = AT_MFMA(kf[0], qr[0], negm); AT_KJ(2); float smrg = slast + xor32(slast, hi != 0); sacc += P0[2]; sacc += P0[3]; pw0[0] = pk2(P0[0], P0[1]); AT_PIN(pw0); AT_PIN(smrg); AT_PIN(sacc); AT_SBAR(); \
    C1 = AT_MFMA(kf[1], qr[0], negm); (void)0; sacc += P0[4]; sacc += P0[5]; sacc += P0[6]; pw0[1] = pk2(P0[2], P0[3]); AT_PIN(pw0); AT_PIN(sacc); AT_SBAR(); \
    C0 = AT_MFMA(kf[2], qr[1], C0); AT_KJ(3); sacc += P0[7]; sacc += P0[8]; sacc += P0[9]; pw0[2] = pk2(P0[4], P0[5]); AT_PIN(pw0); AT_PIN(sacc); AT_SBAR(); \
    C1 = AT_MFMA(kf[3], qr[1], C1); (void)0; sacc += P0[10]; sacc += P0[11]; sacc += P0[12]; pw0[3] = pk2(P0[6], P0[7]); AT_PIN(pw0); AT_PIN(sacc); AT_SBAR(); \
    C0 = AT_MFMA(kf[4], qr[2], C0); AT_KJ(4); sacc += P0[13]; sacc += P0[14]; sacc += P0[15]; pw1[0] = pk2(P0[8], P0[9]); AT_PIN(pw1); AT_PIN(sacc); AT_SBAR(); \
    C1 = AT_MFMA(kf[5], qr[2], C1); (void)0; sacc += P1[0]; sacc += P1[1]; sacc += P1[2]; pw1[1] = pk2(P0[10], P0[11]); AT_PIN(pw1); AT_PIN(sacc); AT_SBAR(); \
    C0 = AT_MFMA(kf[6], qr[3], C0); AT_KJ(5); sacc += P1[3]; sacc += P1[4]; sacc += P1[5]; pw1[2] = pk2(P0[12], P0[13]); AT_PIN(pw1); AT_PIN(sacc); AT_SBAR(); \
    C1 = AT_MFMA(kf[7], qr[3], C1); (void)0; sacc += P1[6]; sacc += P1[7]; sacc += P1[8]; pw1[3] = pk2(P0[14], P0[15]); AT_PIN(pw1); AT_PIN(sacc); AT_SBAR(); \
    C0 = AT_MFMA(kf[8], qr[4], C0); AT_VRD(0); sacc += P1[9]; sacc += P1[10]; pw2[0] = pk2(P1[0], P1[1]); pw2[1] = pk2(P1[2], P1[3]); AT_PIN(pw2); AT_PIN(sacc); AT_SBAR(); \
    C1 = AT_MFMA(kf[9], qr[4], C1); AT_VRD(4); sacc += P1[11]; sacc += P1[12]; pw2[2] = pk2(P1[4], P1[5]); pw2[3] = pk2(P1[6], P1[7]); AT_PIN(pw2); AT_PIN(sacc); AT_SBAR(); \
    C0 = AT_MFMA(kf[10], qr[5], C0); AT_VRD(1); sacc += P1[13]; sacc += P1[14]; pw3[0] = pk2(P1[8], P1[9]); pw3[1] = pk2(P1[10], P1[11]); AT_PIN(pw3); AT_PIN(sacc); AT_SBAR(); \
    C1 = AT_MFMA(kf[11], qr[5], C1); AT_VRD(5); sacc += P1[15]; pw3[2] = pk2(P1[12], P1[13]); pw3[3] = pk2(P1[14], P1[15]); AT_PIN(pw3); AT_PIN(sacc); AT_SBAR(); \
    l_reg += sacc; \
    if (GK) AT_DMA_K((t) + 3, ((t) + 3) & 3); if (GV) AT_DMA_V((t) + 1, vs_next); \
    if (MASK) at_cmask(C0, C1, (t) - (NT - 4), qrel, hi); \
    resc = false; slast = sacc;                                                                                            \
    if (__builtin_expect(__any(smrg > AT_STHR), 0)) { const float dl = __builtin_fmaxf(__builtin_amdgcn_logf(smrg), 0.f); nm -= dl;     \
        const float f = __builtin_amdgcn_exp2f(-dl); l_reg *= f; slast *= f; if (hi == 0) wsf[r32] = f; resc = true; \
        _Pragma("unroll") for (int r = 0; r < 16; ++r) { C0[r] -= dl; C1[r] -= dl; negm[r] = nm; } } \
    AT_PIN(negm); AT_SBAR(); \
    AT_GAPB(o[0] = AT_MFMA(AT_PAF(0), AT_VFR(0), o[0]), AT_VRD(2), C0, 0); \
    AT_GAPB(o[1] = AT_MFMA(AT_PAF(0), AT_VFR(4), o[1]), AT_VRD(6), C0, 4); \
    AT_GAPB(o[0] = AT_MFMA(AT_PAF(1), AT_VFR(1), o[0]), AT_VRD(3), C0, 8); \
    AT_GAPB(o[1] = AT_MFMA(AT_PAF(1), AT_VFR(5), o[1]), AT_VRD(7), C0, 12); \
    AT_GAPB(o[0] = AT_MFMA(AT_PAF(2), AT_VFR(2), o[0]), AT_KRD(GL, 0), C1, 0); \
    AT_GAPB(o[1] = AT_MFMA(AT_PAF(2), AT_VFR(6), o[1]), AT_KRD(GL, 1), C1, 4); \
    AT_GAPB(o[0] = AT_MFMA(AT_PAF(3), AT_VFR(3), o[0]), (void)0, C1, 8); \
    AT_GAPB(o[1] = AT_MFMA(AT_PAF(3), AT_VFR(7), o[1]), (void)0, C1, 12); \
    } while (0)
    int t = 1;
    for (; t + 5 < NT; t += 2) {
        AT_STEP(pB0, pB1, pA0, pA1, t, false, true, true, true);     AT_WAIT_BAR(3); AT_RESC(); AT_ROT();
        AT_STEP(pA0, pA1, pB0, pB1, t + 1, false, true, true, true); AT_WAIT_BAR(3); AT_RESC(); AT_ROT();
    }
#define AT_ENDW(tt) do { if ((tt) + 3 < NT) { AT_WAIT_BAR(3); } else if ((tt) + 2 < NT) { AT_WAIT_BAR(1); } else { AT_WAIT_BAR(0); } } while (0)
    for (; t + 1 < NT; t += 2) {
        AT_STEP(pB0, pB1, pA0, pA1, t, true, (t + 3 < NT), (t + 1 < NT), (t + 1 < NT));         AT_ENDW(t);     AT_RESC(); AT_ROT();
        AT_STEP(pA0, pA1, pB0, pB1, t + 1, true, (t + 4 < NT), (t + 2 < NT), (t + 2 < NT));     AT_ENDW(t + 1); AT_RESC(); AT_ROT();
    }
    AT_STEP(pB0, pB1, pA0, pA1, NT - 1, true, false, false, false); AT_RESC();
    { float sacc = pB0[0] + pB0[1];
#pragma unroll
      for (int r = 2; r < 16; ++r) sacc += pB0[r];
#pragma unroll
      for (int r = 0; r < 16; ++r) sacc += pB1[r];
      l_reg += sacc;
      pw0 = (v4u){AT_PKW(pB0, 0), AT_PKW(pB0, 2), AT_PKW(pB0, 4), AT_PKW(pB0, 6)}; pw1 = (v4u){AT_PKW(pB0, 8), AT_PKW(pB0, 10), AT_PKW(pB0, 12), AT_PKW(pB0, 14)};
      pw2 = (v4u){AT_PKW(pB1, 0), AT_PKW(pB1, 2), AT_PKW(pB1, 4), AT_PKW(pB1, 6)}; pw3 = (v4u){AT_PKW(pB1, 8), AT_PKW(pB1, 10), AT_PKW(pB1, 12), AT_PKW(pB1, 14)};
      LAS const unsigned char* const vp_ = vp0 + vs_cur * AT_VSLOT; _Pragma("unroll") for (int i = 0; i < 8; ++i) AT_VRD(i);
      o[0] = AT_MFMA(AT_PAF(0), AT_VFR(0), o[0]); o[1] = AT_MFMA(AT_PAF(0), AT_VFR(4), o[1]); o[0] = AT_MFMA(AT_PAF(1), AT_VFR(1), o[0]); o[1] = AT_MFMA(AT_PAF(1), AT_VFR(5), o[1]);
      o[0] = AT_MFMA(AT_PAF(2), AT_VFR(2), o[0]); o[1] = AT_MFMA(AT_PAF(2), AT_VFR(6), o[1]); o[0] = AT_MFMA(AT_PAF(3), AT_VFR(3), o[0]); o[1] = AT_MFMA(AT_PAF(3), AT_VFR(7), o[1]); }
#undef AT_KJ
#undef AT_DMA_K
#undef AT_DMA_V
#undef AT_ROT
#undef AT_EX
#undef AT_RESC
#undef AT_PKW
#undef AT_PAF
#undef AT_VFR
#undef AT_VRD
#undef AT_KRD
#undef AT_ENDW
#undef AT_GAPM
#undef AT_GAPB
#undef AT_STEP
    float l = l_reg; l += xor32(l, hi != 0);
    if (hi == 0) wsf[32 + r32] = l;
    LAS bf16* stg = (LAS bf16*)(lds + AT_OST) + w * 2048;
#pragma unroll
    for (int i = 0; i < 16; ++i) { const int orow = crow(i, hi); const float rl = __builtin_amdgcn_rcpf(wsf[32 + orow]);
        stg[orow * 64 + r32] = (bf16)f2bf(o[0][i] * rl); stg[orow * 64 + 32 + r32] = (bf16)f2bf(o[1][i] * rl); }
#pragma unroll
    for (int i = 0; i < 4; ++i) { const int row = i * 8 + (lane >> 3), c8 = lane & 7; const unsigned lrow = (unsigned)(32 * w + row);
        const char* const gbase = (const char*)(F.Z + (R0 + q0) * ZP + ZC_GM + h * 64); char* const mbase = (char*)(F.MIX + (R0 + q0) * DM + h * 64);
        float ov[8], g[8]; unpack8(*(const LAS v4u*)(stg + row * 64 + c8 * 8), ov); unpack8(*(const GAS v4u*)(gbase + (lrow * (unsigned)ZP + c8 * 8) * 2u), g);
        v4u ovv; ovv.x = pk2(ov[0] * siluf(g[0]), ov[1] * siluf(g[1])); ovv.y = pk2(ov[2] * siluf(g[2]), ov[3] * siluf(g[3])); ovv.z = pk2(ov[4] * siluf(g[4]), ov[5] * siluf(g[5])); ovv.w = pk2(ov[6] * siluf(g[6]), ov[7] * siluf(g[7]));
        *(GAS v4u*)(mbase + (lrow * (unsigned)DM + c8 * 8) * 2u) = ovv; }
    __syncthreads();
}

constexpr int DC_RCH = 2064, DC_RI = 32768, DC_BUF = DC_RI + 4 * DC_RCH + 192, DC_WSF = 2 * DC_BUF, DC_END = DC_WSF + NWAVES * 256;
static_assert(DC_BUF % 256 == 0 && DC_END <= RING_BYTES, "decode LDS");
__device__ __forceinline__ void decode_unit(Frame& F, const int b, const int sp) {
    int ln_; FRESH_LANE_ID(ln_);
    const int lane = ln_, w = F.wave, tid = w * 64 + lane, r32 = lane & 31, hi = lane >> 5, rh = w & 1, kg = w >> 1;
    LAS unsigned char* const lds = F.lds;
    LAS float* wsf = (LAS float*)(lds + DC_WSF) + w * 64;
    const int qi = 32 * rh + r32, tq = qi >> 3, hq = qi & 7;
    const bf16* qrow = F.QS + (size_t)(b * DECT + tq) * 1280;
    bf16x8 qf[10];
#pragma unroll
    for (int d0 = 0; d0 < 8; ++d0) qf[d0] = *(const GAS bf16x8*)(qrow + hq * 128 + 16 * d0 + 8 * hi);
#pragma unroll
    for (int d0 = 8; d0 < 10; ++d0) qf[d0] = *(const GAS bf16x8*)(qrow + 1024 + hq * 32 + 16 * (d0 - 8) + 8 * hi);
    const int* pt = F.page_table + b * NPAGES + sp * (NPAGES / DSPLIT);
    f32x4 cr[8], kr[2];
#define DC_LOAD(j) do { const size_t pg_ = (size_t)pt[j]; const GAS f32x4* c_ = (const GAS f32x4*)(F.cache_ckv + pg_ * (PAGE * KVL)) + tid; const GAS f32x4* k_ = (const GAS f32x4*)(F.cache_kr + pg_ * (PAGE * QR)) + tid; \
        _Pragma("unroll") for (int i_ = 0; i_ < 8; ++i_) cr[i_] = __builtin_nontemporal_load(c_ + 512 * i_); kr[0] = __builtin_nontemporal_load(k_); kr[1] = __builtin_nontemporal_load(k_ + 512); } while (0)
    const int skb = tid >> 5, sc4 = tid & 31, sch = sc4 >> 1;
    const int st_c = 2048 * (skb >> 3) + 512 * (sch >> 2) + 64 * (skb & 7) + 16 * ((sch & 3) ^ ((skb >> 2) & 3)) + 8 * (sc4 & 1);
    const int st_r = DC_RI + ((tid & 7) >> 1) * DC_RCH + (tid >> 3) * 16 + (tid & 1) * 8;
    const int kr_b = 8192 * kg + 2048 * (r32 >> 3) + 64 * (r32 & 7);
    const int kr_e = kr_b + 16 * (hi ^ ((r32 >> 2) & 3)), kr_o = kr_b + 16 * ((2 + hi) ^ ((r32 >> 2) & 3));
    const int kr_r = DC_RI + hi * DC_RCH + (32 * kg + r32) * 16;
    const int vq = (lane & 15) >> 2, vp = lane & 3, vC = 2 * ((lane >> 4) & 1) + (vp >> 1);
    const int vr_b = 8192 * kg + 64 * (4 * hi + vq) + 8 * (vp & 1);
    const int vr_lo = vr_b + 16 * (vC ^ hi), vr_hi = vr_b + 2048 + 16 * (vC ^ (2 + hi));
#define DC_STORE(buf) do { LAS unsigned char* ib_ = lds + (buf) * DC_BUF; \
        _Pragma("unroll") for (int i = 0; i < 8; ++i) { const v2u wv = {pk2(cr[i].x, cr[i].y), pk2(cr[i].z, cr[i].w)}; *(LAS v2u*)(ib_ + st_c + 4096 * i) = wv; } \
        _Pragma("unroll") for (int i = 0; i < 2; ++i) { const v2u wv = {pk2(kr[i].x, kr[i].y), pk2(kr[i].z, kr[i].w)}; *(LAS v2u*)(ib_ + st_r + 1024 * i) = wv; } } while (0)
#define DC_COMPUTE(buf) do { LAS const unsigned char* ib_ = lds + (buf) * DC_BUF; \
        bf16x8 kf[10]; \
        _Pragma("unroll") for (int d0 = 0; d0 < 8; ++d0) kf[d0] = *(const LAS bf16x8*)(ib_ + ((d0 & 1) ? kr_o : kr_e) + 512 * (d0 >> 1)); \
        kf[8] = *(const LAS bf16x8*)(ib_ + kr_r); kf[9] = *(const LAS bf16x8*)(ib_ + kr_r + 2 * DC_RCH); \
        __builtin_amdgcn_sched_barrier(0); \
        f32x16 p = {}; \
        _Pragma("unroll") for (int d0 = 0; d0 < 10; ++d0) p = __builtin_amdgcn_mfma_f32_32x32x16_bf16(kf[d0], qf[d0], p, 0, 0, 0); \
        float rm = max16(p); rm = fmaxf(rm, xor32(rm, hi != 0)); \
        const float mn = fmaxf(m, rm); \
        if (__any(mn > m)) { const float al = fast_exp2(m - mn); l *= al; if (hi == 0) wsf[r32] = al; \
            _Pragma("unroll") for (int i = 0; i < 16; ++i) { const float f = wsf[crow(i, hi)]; o[0][i] *= f; o[1][i] *= f; o[2][i] *= f; o[3][i] *= f; } } \
        m = mn; \
        float ls = 0.f; \
        _Pragma("unroll") for (int i = 0; i < 16; ++i) { p[i] = fast_exp2(p[i] - m); ls += p[i]; } \
        l += ls; \
        const bf16x8 pa0 = pack_p(p, 0), pa1 = pack_p(p, 8); \
        _Pragma("unroll") for (int cb = 0; cb < 4; ++cb) \
            _Pragma("unroll") for (int ks2 = 0; ks2 < 2; ++ks2) { const s16x4 lo = tr_read(ib_ + vr_lo + 4096 * ks2 + 512 * cb), hi4 = tr_read(ib_ + vr_hi + 4096 * ks2 + 512 * cb); \
                o[cb] = __builtin_amdgcn_mfma_f32_32x32x16_bf16(ks2 == 0 ? pa0 : pa1, (bf16x8){lo[0], lo[1], lo[2], lo[3], hi4[0], hi4[1], hi4[2], hi4[3]}, o[cb], 0, 0, 0); } } while (0)
#define DC_LBAR() asm volatile("s_waitcnt lgkmcnt(0)\n\ts_barrier" ::: "memory")
    f32x16 o[4]; o[0] = f32x16{}; o[1] = f32x16{}; o[2] = f32x16{}; o[3] = f32x16{};
    float m = -1e30f, l = 0.f;
    constexpr int NPG = NPAGES / DSPLIT;
    DC_LOAD(0); DC_STORE(0); DC_LOAD(1);
    DC_LBAR();
    for (int j = 0; j < NPG; ++j) {
        const int cur = j & 1;
        if (w >= 4 && j + 1 < NPG) { DC_STORE(cur ^ 1); if (j + 2 < NPG) DC_LOAD(j + 2); }
        DC_COMPUTE(cur);
        if (w < 4 && j + 1 < NPG) { DC_STORE(cur ^ 1); if (j + 2 < NPG) DC_LOAD(j + 2); }
        DC_LBAR();
    }
#undef DC_LOAD
#undef DC_STORE
#undef DC_COMPUTE
#undef DC_LBAR
    l += xor32(l, hi != 0);
    const int part = sp * 4 + kg;
    float* pp = F.PART + ((size_t)(b * DPART + part) * 64 + 32 * rh) * 128 + r32;
#pragma unroll
    for (int cb = 0; cb < 4; ++cb)
#pragma unroll
        for (int i = 0; i < 16; ++i) pp[(size_t)crow(i, hi) * 128 + 32 * cb] = o[cb][i];
    if (hi == 0) { float* ml = F.ML + ((size_t)(b * DPART + part) * 64 + 32 * rh + r32) * 2; ml[0] = m; ml[1] = l; }
}

__device__ __forceinline__ void decode_combine_unit(Frame& F, const int b) {
    int ln_; FRESH_LANE_ID(ln_);
    const int tid = F.wave * 64 + ln_, i = tid >> 3, part = tid & 7, t = i >> 3, h = i & 7;
    LAS float* SC = (LAS float*)F.lds;
    LAS float* OL = SC + 512;
    const bf16* qrow = F.QS + (size_t)(b * DECT + t) * 1280;
    { float s = -INFINITY;
      if (part <= t) { const float* ck = F.out + O_CKVS + (size_t)(b * DECT + part) * KVL; const float* kr = F.out + O_KRS + (size_t)(b * DECT + part) * QR; float a = 0.f;
          for (int c = 0; c < 128; c += 8) { float q8[8]; unpack8(*(const GAS v4u*)(qrow + h * 128 + c), q8);
#pragma unroll
              for (int e = 0; e < 8; ++e) a += q8[e] * ck[c + e]; }
          for (int c = 0; c < 32; c += 8) { float q8[8]; unpack8(*(const GAS v4u*)(qrow + 1024 + h * 32 + c), q8);
#pragma unroll
              for (int e = 0; e < 8; ++e) a += q8[e] * kr[c + e]; }
          s = a; }
      SC[i * 8 + part] = s; }
    __syncthreads();
    float M = -1e30f; float mp[DPART], lp[DPART], sj[8];
#pragma unroll
    for (int p = 0; p < DPART; ++p) { const float* ml = F.ML + ((size_t)(b * DPART + p) * 64 + i) * 2; mp[p] = ml[0]; lp[p] = ml[1]; M = fmaxf(M, mp[p]); }
#pragma unroll
    for (int j = 0; j < 8; ++j) { sj[j] = SC[i * 8 + j]; M = fmaxf(M, sj[j]); }
    float L = 0.f;
#pragma unroll
    for (int p = 0; p < DPART; ++p) { mp[p] = fast_exp2(mp[p] - M); L += mp[p] * lp[p]; }
#pragma unroll
    for (int j = 0; j < 8; ++j) { sj[j] = fast_exp2(sj[j] - M); L += sj[j]; }
    { float acc[16];
#pragma unroll
      for (int e = 0; e < 16; ++e) acc[e] = 0.f;
#pragma unroll
      for (int p = 0; p < DPART; ++p) { const GAS f32x4* src = (const GAS f32x4*)(F.PART + ((size_t)(b * DPART + p) * 64 + i) * 128 + part * 16);
#pragma unroll
          for (int v = 0; v < 4; ++v) { const f32x4 x = src[v]; acc[4 * v] += mp[p] * x.x; acc[4 * v + 1] += mp[p] * x.y; acc[4 * v + 2] += mp[p] * x.z; acc[4 * v + 3] += mp[p] * x.w; } }
#pragma unroll
      for (int j = 0; j < 8; ++j) { const GAS f32x4* src = (const GAS f32x4*)(F.out + O_CKVS + (size_t)(b * DECT + j) * KVL + part * 16);
#pragma unroll
          for (int v = 0; v < 4; ++v) { const f32x4 x = src[v]; acc[4 * v] += sj[j] * x.x; acc[4 * v + 1] += sj[j] * x.y; acc[4 * v + 2] += sj[j] * x.z; acc[4 * v + 3] += sj[j] * x.w; } }
      const float rl = __builtin_amdgcn_rcpf(L);
#pragma unroll
      for (int e = 0; e < 16; ++e) OL[i * 128 + part * 16 + e] = acc[e] * rl; }
    __syncthreads();
    { float od[8];
#pragma unroll
      for (int e = 0; e < 8; ++e) od[e] = 0.f;
      const float* wv = F.w_uv + h * 64 + part * 8;
#pragma unroll 16
      for (int c = 0; c < 128; ++c) { const float x = OL[i * 128 + c]; const f32x4 w0 = *(const GAS f32x4*)(wv + (size_t)c * 512), w1 = *(const GAS f32x4*)(wv + (size_t)c * 512 + 4);
          od[0] += x * w0.x; od[1] += x * w0.y; od[2] += x * w0.z; od[3] += x * w0.w; od[4] += x * w1.x; od[5] += x * w1.y; od[6] += x * w1.z; od[7] += x * w1.w; }
      const size_t row = (size_t)(MP + b * DECT + t); float g[8]; unpack8(*(const GAS v4u*)(F.Z + row * ZP + ZC_GM + h * 64 + part * 8), g);
      v4u o; o.x = pk2(od[0] * siluf(g[0]), od[1] * siluf(g[1])); o.y = pk2(od[2] * siluf(g[2]), od[3] * siluf(g[3])); o.z = pk2(od[4] * siluf(g[4]), od[5] * siluf(g[5])); o.w = pk2(od[6] * siluf(g[6]), od[7] * siluf(g[7]));
      *(GAS v4u*)(F.MIX + row * DM + h * 64 + part * 8) = o; }
    __syncthreads();
}


namespace pg8 {
struct EpiOut {
    static constexpr bool PERM = true;
    const bf16_t* XB; bf16_t* H1B;
    __device__ __forceinline__ void operator()(const f32x4 (&acc)[2][2][4][2], const Unit& u, int wr, int wc, int, int) const {
        int ln_; FRESH_LANE_ID(ln_); const int fr = ln_ & 15, fq = ln_ >> 4;
        const char* xb = (const char*)(XB + (size_t)u.pm * BM * DM + u.pn * BM);
        char* hb = (char*)(H1B + (size_t)u.pm * BM * DM + u.pn * BM);
        const unsigned lo = (unsigned)((wr * 64 + fr) * DM + wc * 32 + 8 * fq);
#pragma unroll
        for (int ai = 0; ai < 2; ++ai) {
            u32x4 xv[4][2];
#pragma unroll
            for (int m = 0; m < 4; ++m)
#pragma unroll
                for (int bj = 0; bj < 2; ++bj) xv[m][bj] = *(const u32x4*)(xb + (lo + (unsigned)((ai * HALF + m * 16) * DM + bj * HALF)) * 2u);
#pragma unroll
            for (int m = 0; m < 4; ++m)
#pragma unroll
                for (int bj = 0; bj < 2; ++bj) { const u32x4 w = xv[m][bj];
                    const f32x4 x0 = {bflo(w.x), bfhi(w.x), bflo(w.y), bfhi(w.y)}, x1 = {bflo(w.z), bfhi(w.z), bflo(w.w), bfhi(w.w)};
                    *(u32x4*)(hb + (lo + (unsigned)((ai * HALF + m * 16) * DM + bj * HALF)) * 2u) = pack8(acc[ai][bj][m][0] + x0, acc[ai][bj][m][1] + x1); }
            asm volatile("" ::: "memory"); }
    }
};
__device__ __forceinline__ void norm_wait(unsigned* cnt, unsigned want, unsigned* tmo) {
    asm volatile("s_waitcnt vmcnt(0)" ::: "memory");
    unsigned ln; FRESH_LANE_ID(ln);
    if (ln == 0) __hip_atomic_fetch_add(cnt, 1u, __ATOMIC_RELAXED, __HIP_MEMORY_SCOPE_AGENT);
    unsigned spins = 0;
    while ((unsigned)__builtin_amdgcn_readfirstlane(__hip_atomic_load(cnt, __ATOMIC_RELAXED, __HIP_MEMORY_SCOPE_AGENT)) < want) {
        __builtin_amdgcn_s_sleep(2);
        if (++spins > (1u << 20)) { if (ln == 0) __hip_atomic_store(tmo, 1u, __ATOMIC_RELAXED, __HIP_MEMORY_SCOPE_AGENT); break; } }
}
struct EpiPle {
    static constexpr bool PERM = true;
    const bf16_t* H1B; const bf16_t* PPb; float* ssq; float* Yout; const float* g_fin; unsigned* ctl;
    __device__ __forceinline__ void operator()(f32x4 (&acc)[2][2][4][2], const Unit& u, int wr, int wc, int, int) const {
        int ln_; FRESH_LANE_ID(ln_); const int fr = ln_ & 15, fq = ln_ >> 4;
        const int col0 = u.pn * BM + wc * 32 + 8 * fq;
#pragma unroll
        for (int ai = 0; ai < 2; ++ai)
#pragma unroll
            for (int m = 0; m < 4; ++m) { const int row = u.pm * BM + ai * HALF + wr * 64 + m * 16 + fr; const size_t off = (size_t)row * DM + col0; float s = 0.f;
#pragma unroll
                for (int bj = 0; bj < 2; ++bj) { const u32x4 hw = *(const u32x4*)(H1B + off + bj * HALF), pw = *(const u32x4*)(PPb + off + bj * HALF);
#pragma unroll
                    for (int n = 0; n < 2; ++n) { const unsigned h0 = n == 0 ? hw.x : hw.z, h1w = n == 0 ? hw.y : hw.w, p0 = n == 0 ? pw.x : pw.z, p1 = n == 0 ? pw.y : pw.w;
                        const f32x4 a = acc[ai][bj][m][n]; f32x4 h2;
                        h2[0] = bflo(h0) + __builtin_amdgcn_rcpf(1.f + __expf(-a[0])) * bflo(p0); h2[1] = bfhi(h0) + __builtin_amdgcn_rcpf(1.f + __expf(-a[1])) * bfhi(p0);
                        h2[2] = bflo(h1w) + __builtin_amdgcn_rcpf(1.f + __expf(-a[2])) * bflo(p1); h2[3] = bfhi(h1w) + __builtin_amdgcn_rcpf(1.f + __expf(-a[3])) * bfhi(p1);
                        acc[ai][bj][m][n] = h2; s += (h2[0] * h2[0] + h2[1] * h2[1]) + (h2[2] * h2[2] + h2[3] * h2[3]); } }
                s += __shfl_xor(s, 16); s += xor32(s, fq >= 2);
                if (fq == 0) unsafeAtomicAdd(ssq + row, s);
                if (m & 1) asm volatile("" ::: "memory"); }
        norm_wait(ctl + CW_PCNT + 64 * u.pm, 32u, ctl + CW_TMO);
        f32x4 gv[2][2];
#pragma unroll
        for (int bj = 0; bj < 2; ++bj)
#pragma unroll
            for (int n = 0; n < 2; ++n) gv[bj][n] = *(const f32x4*)(g_fin + col0 + bj * HALF + n * 4);
#pragma unroll
        for (int ai = 0; ai < 2; ++ai)
#pragma unroll
            for (int m = 0; m < 4; ++m) { const int row = u.pm * BM + ai * HALF + wr * 64 + m * 16 + fr; const size_t off = (size_t)row * DM + col0;
                const float rstd = rsq(__hip_atomic_load(ssq + row, __ATOMIC_RELAXED, __HIP_MEMORY_SCOPE_AGENT) * (1.f / DM) + EPS);
#pragma unroll
                for (int bj = 0; bj < 2; ++bj)
#pragma unroll
                    for (int n = 0; n < 2; ++n) *(f32x4*)(Yout + off + bj * HALF + n * 4) = acc[ai][bj][m][n] * rstd * gv[bj][n]; }
    }
};
}
__device__ __forceinline__ void p6_final(Frame& F) {
    const int gw = F.vcu * NWAVES + F.wave, NGW = F.G * NWAVES, lane = F.lane;
    for (int m = gw; m < MT; m += NGW) {
        GAS f32x4* yr = (GAS f32x4*)(F.out + O_Y + (size_t)m * DM) + lane; const float rstd = rsq(F.SSQ_Y[m] * (1.f / DM) + EPS);
#pragma unroll
        for (int j = 0; j < 4; ++j) { const f32x4 g = ((const GAS f32x4*)F.g_fin)[lane + 64 * j]; yr[64 * j] = yr[64 * j] * rstd * g; }
    }
}

template <int MODE  >
__device__ __forceinline__ void small_gemm_tile(Frame& F, const int tile) {
    const int lane = F.lane, w = F.wave, rb = w >> 1, cg = w & 1, l15 = lane & 15, kq = lane >> 4;
    const int tm = tile >> 4, tn = tile & 15;
    f32x4 acc0, acc1;
    { const bf16* A = (MODE == 4 ? F.MIX : F.H1B) + (size_t)(MP + tm * 64 + l15) * DM + 128 * w + 8 * kq;
      const bf16* B = (MODE == 4 ? F.WOUT : F.WPG) + (size_t)(tn * 64 + l15) * DM + 128 * w + 8 * kq;
      bf16x8 a[4][4], b[4][4];
#pragma unroll
      for (int i = 0; i < 4; ++i)
#pragma unroll
          for (int ks = 0; ks < 4; ++ks) { a[i][ks] = *(const GAS bf16x8*)(A + (size_t)(16 * i) * DM + 32 * ks); b[i][ks] = *(const GAS bf16x8*)(B + (size_t)(16 * i) * DM + 32 * ks); }
      LAS float* P = (LAS float*)F.lds + (size_t)w * 4096 + lane;
#pragma unroll
      for (int i = 0; i < 4; ++i)
#pragma unroll
          for (int j = 0; j < 4; ++j) { f32x4 t = {0.f, 0.f, 0.f, 0.f};
#pragma unroll
              for (int ks = 0; ks < 4; ++ks) t = __builtin_amdgcn_mfma_f32_16x16x32_bf16(a[i][ks], b[j][ks], t, 0, 0, 0);
#pragma unroll
              for (int r = 0; r < 4; ++r) P[((i * 4 + j) * 4 + r) * 64] = t[r]; }
      __syncthreads();
      LAS const float* Q = (LAS const float*)F.lds + (size_t)(8 * w) * 64 + lane;
      acc0 = (f32x4){0.f, 0.f, 0.f, 0.f}; acc1 = acc0;
#pragma unroll
      for (int w2 = 0; w2 < 8; ++w2)
#pragma unroll
          for (int r = 0; r < 4; ++r) { acc0[r] += Q[w2 * 4096 + r * 64]; acc1[r] += Q[w2 * 4096 + (4 + r) * 64]; }
      __syncthreads(); }
    if (MODE == 4) {
#pragma unroll
        for (int r = 0; r < 4; ++r) { const int rs = tm * 64 + rb * 16 + 4 * kq + r; const size_t row = (size_t)(MP + rs);
#pragma unroll
            for (int c = 0; c < 2; ++c) { const int col = tn * 64 + cg * 32 + 16 * c + l15; const float av = c == 0 ? acc0[r] : acc1[r];
                F.H1B[row * DM + col] = (bf16)f2bf(av + bf2f(F.XN[row * DM + col])); } }
    } else {
        float hv[4][2];
#pragma unroll
        for (int r = 0; r < 4; ++r) { const int rs = tm * 64 + rb * 16 + 4 * kq + r; const size_t row = (size_t)(MP + rs); float ss = 0.f;
#pragma unroll
            for (int c = 0; c < 2; ++c) { const int col = tn * 64 + cg * 32 + 16 * c + l15; const float av = c == 0 ? acc0[r] : acc1[r];
                hv[r][c] = bf2f(F.H1B[row * DM + col]) + __builtin_amdgcn_rcpf(1.f + __expf(-av)) * bf2f(F.PP[row * DM + col]); ss += hv[r][c] * hv[r][c]; }
            ss += __shfl_xor(ss, 1); ss += __shfl_xor(ss, 2); ss += __shfl_xor(ss, 4); ss += __shfl_xor(ss, 8); if (l15 == 0) unsafeAtomicAdd(F.SSQ_Y + row, ss); }
        pg8::norm_wait((unsigned*)F.ctl + CW_SCNT + 64 * tm, 128u, (unsigned*)F.ctl + CW_TMO);
#pragma unroll
        for (int r = 0; r < 4; ++r) { const int rs = tm * 64 + rb * 16 + 4 * kq + r; const size_t row = (size_t)(MP + rs);
            const float rstd = rsq(__hip_atomic_load(F.SSQ_Y + row, __ATOMIC_RELAXED, __HIP_MEMORY_SCOPE_AGENT) * (1.f / DM) + EPS);
#pragma unroll
            for (int c = 0; c < 2; ++c) { const int col = tn * 64 + cg * 32 + 16 * c + l15; F.out[O_Y + row * DM + col] = hv[r][c] * rstd * F.g_fin[col]; } }
    }
}


__global__ void __launch_bounds__(NTHREADS, 2) hymba_fwd(Args args) {
    extern __shared__ __attribute__((aligned(16))) unsigned char lds_raw[];
    LAS unsigned char* const lds = (LAS unsigned char*)lds_raw;
    const int wave_s = __builtin_amdgcn_readfirstlane(threadIdx.x >> 6);
    for (int u = threadIdx.x; u < (LDS_BYTES - LDSCTL_OFF) / 4; u += NTHREADS) ((LAS unsigned*)(lds + LDSCTL_OFF))[u] = 0u;
    __syncthreads();
    XcdBarrier bar = xcd_barrier_post((unsigned*)((gu32*)(args.ws + WS_CTL) + CW_BAR), (volatile LAS unsigned*)(lds + MISC_OFF) + 8);
#define GRID_BAR() xcd_barrier(bar)
#define PHASE_BEGIN { Frame F; make_frame(F, lds, wave_s); const int bx = (int)blockIdx.x; (void)bx;
#define PHASE_END }

    { PHASE_BEGIN p0_prologue(F); PHASE_END PHASE_BEGIN p0_rows(F); PHASE_END }
    GRID_BAR();

    PHASE_BEGIN
        pg8::Gemm g{F.XN, F.WIN, MT, ZP, DM, DM, DM}; pg8::StaticOrder S; S.init(MT, ZP, F.G, bx);
        pg8::EpiZ E{F.Z, F.SSQ_Q, F.SSQ_KV, F.RSX};
        pg8::gemm_phase<pg8::EpiZ, pg8::StaticOrder, true>(F.lds, g, S, E, wave_s);
    PHASE_END
    PHASE_BEGIN const bool tail = (F.G == 256); const int nfree = 216, first = 40;
      pg8::Gemm g{F.PB, F.WPP, MT, 1024, 256, 256, 256}; pg8::StaticOrder S; S.init(MT, 1024, tail ? nfree : F.G, tail ? (bx >= first ? bx - first : (1 << 24)) : bx);
      pg8::EpiScale E{F.PP, F.PP, 99, 1024, nullptr, 0.f, 0, -1, F.ROPE, 0, 0};
      pg8::gemm_phase<pg8::EpiScale, pg8::StaticOrder, true>(F.lds, g, S, E, wave_s); PHASE_END
    GRID_BAR();

    {
    PHASE_BEGIN pg8::Gemm g{F.Z, F.WQP, MP, 768, 256, ZP, 256}; pg8::StaticOrder S; S.init(MP, 768, F.G, bx);
      pg8::EpiScale E{F.QP, F.QP, 99, 768, F.SSQ_Q, 1.f / 256.f, 0, 2, F.ROPE, SEQ - 1, 0};
      pg8::gemm_phase<pg8::EpiScale, pg8::StaticOrder, true>(F.lds, g, S, E, wave_s); PHASE_END
    PHASE_BEGIN pg8::Gemm g{F.Z + (size_t)MP * ZP, F.WQS, MS, 1280, 256, ZP, 256}; pg8::StaticOrder S; S.init(MS, 1280, F.G, (bx + 256 - (384 % 256)) % F.G);
      pg8::EpiScale E{F.QS, F.QS, 99, 1280, F.SSQ_Q, 1.f / 256.f, MP, 4, F.ROPE, DECT - 1, SEQ};
      pg8::gemm_phase<pg8::EpiScale, pg8::StaticOrder, true>(F.lds, g, S, E, wave_s); PHASE_END
    PHASE_BEGIN pg8::Gemm g{F.Z + ZC_KV, F.WKV, MP, 1024, 256, ZP, 256}; pg8::StaticOrder S; S.init(MP, 1024, F.G, (bx + 512 - (404 % 256)) % F.G);
      pg8::EpiScale E{F.KN, F.VV, 2, 512, F.SSQ_KV, 1.f / 128.f, 0, -1, F.ROPE, 0, 0};
      pg8::gemm_phase<pg8::EpiScale, pg8::StaticOrder, true>(F.lds, g, S, E, wave_s); PHASE_END
    }
    PHASE_BEGIN p2_rows(F); PHASE_END
    PHASE_BEGIN gla_local_phase(F); PHASE_END
    PHASE_BEGIN for (int u = F.vcu; u < DECB * HG; u += F.G) gla_sample_unit(F, u); PHASE_END
    GRID_BAR();

    PHASE_BEGIN gla_scan(F); PHASE_END
    GRID_BAR();

    PHASE_BEGIN
        const int xl = bx & 7, rk = bx >> 3, nrk = (F.G - xl + 7) >> 3, rd = nrk < 16 ? nrk : 16;
        if (rk < rd) for (int jb = rk; jb < 16; jb += rd) { const int b = xl * 16 + jb;
            decode_unit(F, b, 0); decode_unit(F, b, 1);
            __syncthreads();
            decode_combine_unit(F, b); }
        volatile LAS int* qs = (volatile LAS int*)(F.lds + LDSCTL_OFF + 128);
        unsigned* const qhead = (unsigned*)F.ctl + CW_ATQ + 64 * xl;
#define Q_PULL(dst) do { if (F.tid == 0) qs[0] = (int)__hip_atomic_fetch_add(qhead, 1u, __ATOMIC_RELAXED, __HIP_MEMORY_SCOPE_AGENT); __syncthreads(); dst = __builtin_amdgcn_readfirstlane(qs[0]); __syncthreads(); } while (0)
        int i; Q_PULL(i);
        while (i < 128) { const int qb = 31 - ((i & 63) >> 1), bh = 4 * xl + 2 * (i >> 6) + (i & 1);
            attn_prompt_unit(F, bh >> 3, bh & 7, qb); Q_PULL(i); }
        { int lane; FRESH_LANE_ID(lane); float gon[16];
#pragma unroll
          for (int e = 0; e < 16; ++e) gon[e] = F.g_on[(lane & 7) * 16 + e];
          GoLd nxt; if (i < 384) gla_out_load(F, xl * 256 + (i - 128), lane, nxt);
          while (i < 384) { int j; Q_PULL(j); const GoLd cur = nxt; if (j < 384) gla_out_load(F, xl * 256 + (j - 128), lane, nxt); gla_out_compute(F, xl * 256 + (i - 128), lane, cur, gon); i = j; } }
#undef Q_PULL
    PHASE_END
    GRID_BAR();

    { PHASE_BEGIN pg8::Gemm g{F.MIX, F.WOUT, MP, DM, DM, DM, DM}; pg8::StaticOrder S; S.init(MP, DM, F.G, bx);
      pg8::EpiOut E{F.XN, F.H1B};
      pg8::gemm_phase<pg8::EpiOut, pg8::StaticOrder, true>(F.lds, g, S, E, wave_s); PHASE_END
    PHASE_BEGIN for (int t = F.vcu; t < 256; t += F.G) small_gemm_tile<4>(F, t); PHASE_END }
    GRID_BAR();

    PHASE_BEGIN pg8::Gemm g{F.H1B, F.WPG, MP, DM, DM, DM, DM}; pg8::StaticOrder S; S.init(MP, DM, F.G, bx);
      pg8::EpiPle E{F.H1B, F.PP, F.SSQ_Y, F.out + O_Y, F.g_fin, (unsigned*)F.ctl};
      pg8::gemm_phase<pg8::EpiPle, pg8::StaticOrder, true>(F.lds, g, S, E, wave_s); PHASE_END
    PHASE_BEGIN for (int t = F.vcu; t < 256; t += F.G) small_gemm_tile<5>(F, t); PHASE_END
}

extern "C" void kernel_launch(void* const* d_in, const int* in_sizes, int n_in, void* d_out, int out_size, void* d_ws, size_t ws_size, hipStream_t stream) {
    static int grid = 0;
    if (grid == 0) {
        if (n_in != 22 || (size_t)out_size != O_END || ws_size < WS_END) { fprintf(stderr, "kernel_launch: unexpected shapes: n_in %d out %d ws %zu (need %zu)\n", n_in, out_size, ws_size, (size_t)WS_END); grid = -1; return; }
        int dev = 0, cus = 0, per_cu = 0;
        if (hipGetDevice(&dev) != hipSuccess || hipDeviceGetAttribute(&cus, hipDeviceAttributeMultiprocessorCount, dev) != hipSuccess) { grid = -1; return; }
        if (hipFuncSetAttribute((const void*)hymba_fwd, hipFuncAttributeMaxDynamicSharedMemorySize, LDS_BYTES) != hipSuccess) { fprintf(stderr, "kernel_launch: hipFuncSetAttribute failed\n"); grid = -1; return; }
        if (hipOccupancyMaxActiveBlocksPerMultiprocessor(&per_cu, (const void*)hymba_fwd, NTHREADS, LDS_BYTES) != hipSuccess || per_cu < 1)
            fprintf(stderr, "kernel_launch: note: occupancy query reports %d workgroups per CU\n", per_cu);
        (void)hipGetLastError();
        grid = cus;
    }
    if (grid < 0) return;
    if (hipMemsetAsync((char*)d_ws + WS_CTL, 0, CTL_ZERO_BYTES, stream) != hipSuccess) { fprintf(stderr, "kernel_launch: memset failed\n"); return; }
    Args a{};
    for (int i = 0; i < 22; ++i) a.in[i] = (const float*)d_in[i];
    a.out = (float*)d_out; a.ws = (unsigned char*)d_ws;
    hipLaunchKernelGGL(hymba_fwd, dim3(grid), dim3(NTHREADS), LDS_BYTES, stream, a);
    const hipError_t le = hipPeekAtLastError();
    if (le != hipSuccess) fprintf(stderr, "kernel_launch: launch failed: %s\n", hipGetErrorName(le));
}
```

```cpp
#include <hip/hip_runtime.h>
#include <cstdio>
#include <cstdint>

namespace pg8 {
#define PG8_LAS __attribute__((address_space(3)))
typedef unsigned short bf16_t;
typedef short bf16x8 __attribute__((ext_vector_type(8)));
typedef float f32x4 __attribute__((ext_vector_type(4)));
typedef float f32x2 __attribute__((ext_vector_type(2)));
typedef unsigned u32x4 __attribute__((ext_vector_type(4)));
typedef unsigned u32x2 __attribute__((ext_vector_type(2)));
constexpr int BM = 256, BK = 64, HALF = 128, HTB = HALF * BK * 2, STAGE_BYTES = 8 * HTB, NXCD = 8, WGM = 8;

__host__ __device__ __forceinline__ int lds_byte(int r, int c) { const int st = (r >> 4) * 2 + (c >> 5), rr = r & 15, cc = c & 31, ob = rr * 64 + cc * 2; return st * 1024 + (ob ^ (((ob >> 9) & 1) << 5)); }
__host__ __device__ __forceinline__ void stage_rc(int b, int& R, int& C) { const int st = b / 1024, sb = b % 1024, swz = sb ^ (((sb >> 9) & 1) << 5); R = (st >> 1) * 16 + swz / 64; C = (st & 1) * 32 + (swz % 64) / 2; }
__host__ __device__ __forceinline__ int perm32(int rho) { const int n = rho >> 4, i = rho & 15; return 8 * (i >> 2) + 4 * n + (i & 3); }

struct Unit { int pm, pn; };
struct Gemm { const bf16_t* A; const bf16_t* Bt; int M, N, K, lda, ldb; };

struct StaticOrder {
    int nM, nN, nwg, G, c, base, lim;
    __host__ __device__ void init(int M, int N, int G_, int c_) { nM = M / BM; nN = N / BM; nwg = nM * nN; G = G_; c = c_; base = 0; lim = nwg; }
    __host__ __device__ bool next(int i, Unit& u) const {
        const long L = (long)base + (long)i * G + c; if (L >= lim) return false;
        int wgid = (int)L; { const int q = nwg / NXCD, r = nwg % NXCD, xcd = wgid % NXCD, off = wgid / NXCD; wgid = (xcd < r ? xcd * (q + 1) : r * (q + 1) + (xcd - r) * q) + off; }
        const int nig = WGM * nN, gid = wgid / nig, fm = gid * WGM, gsz = (nM - fm) < WGM ? (nM - fm) : WGM;
        u.pm = fm + ((wgid % nig) % gsz); u.pn = (wgid % nig) / gsz; return true;
    }
    __device__ __forceinline__ void a_ready(const Unit&) const {}
    __device__ __forceinline__ void done(const Unit&) const {}
};

__device__ __forceinline__ unsigned cvt_pk_bf16(float lo, float hi) { unsigned r; asm volatile("v_cvt_pk_bf16_f32 %0, %1, %2" : "=v"(r) : "v"(lo), "v"(hi)); return r; }

template <class Epi, class Sched, bool ALIGN_EPI = false>
__device__ __forceinline__ void gemm_phase(PG8_LAS unsigned char* lds, const Gemm g, const Sched& S, const Epi& E, const int wid) {
    int lane_; asm volatile("v_mbcnt_lo_u32_b32 %0, -1, 0\n\tv_mbcnt_hi_u32_b32 %0, -1, %0" : "=v"(lane_));
    const int lane = lane_, tid = wid * 64 + lane, wr = wid >> 2, wc = wid & 3, fr = lane & 15, fq = lane >> 4;
    const int K = g.K, nt = K / BK;
    unsigned voffA[2], voffB[2];
#pragma unroll
    for (int i = 0; i < 2; ++i) { int R, C; stage_rc(tid * 16 + i * 8192, R, C); const int Rb = Epi::PERM ? ((R & ~31) + perm32(R & 31)) : R;
        voffA[i] = (unsigned)(R * g.lda + C) * 2u; voffB[i] = (unsigned)(Rb * g.ldb + C) * 2u; }
    const size_t kstep = (size_t)(BK * 2);
    const size_t hstepA = (size_t)HALF * g.lda * 2, hstepB = (size_t)HALF * g.ldb * 2;
    const size_t tstepA = 2 * hstepA, tstepB = 2 * hstepB;
    const unsigned ldsw = (unsigned)wid * 1024u;
    const int aoff = lds_byte(wr * 64 + fr, fq * 8), boff = lds_byte(wc * 32 + fr, fq * 8);
#define PG8_SA(b, h) (((b) * 2 + (h)) * HTB)
#define PG8_SB(b, h) ((4 + (b) * 2 + (h)) * HTB)
#define PG8_STAGE(bufoff, gbase, voff) do { _Pragma("unroll") for (int _i = 0; _i < 2; ++_i) \
        __builtin_amdgcn_global_load_lds((const unsigned*)((const char*)(gbase) + (voff)[_i]), (PG8_LAS unsigned*)(lds + (bufoff) + ldsw + _i * 8192), 16, 0, 0); } while (0)
#define PG8_LDA(dst, b, h) do { _Pragma("unroll") for (int m = 0; m < 4; ++m) _Pragma("unroll") for (int k = 0; k < 2; ++k) dst[m][k] = *(const PG8_LAS bf16x8*)(lds + PG8_SA(b, h) + aoff + m * 2048 + k * 1024); } while (0)
#define PG8_LDB(dst, b, h) do { _Pragma("unroll") for (int n = 0; n < 2; ++n) _Pragma("unroll") for (int k = 0; k < 2; ++k) dst[n][k] = *(const PG8_LAS bf16x8*)(lds + PG8_SB(b, h) + boff + n * 2048 + k * 1024); } while (0)
#define PG8_MMA(ai, bj, At, Bt) do { __builtin_amdgcn_s_setprio(1); _Pragma("unroll") for (int m = 0; m < 4; ++m) _Pragma("unroll") for (int n = 0; n < 2; ++n) _Pragma("unroll") for (int k = 0; k < 2; ++k) \
        acc[ai][bj][m][n] = __builtin_amdgcn_mfma_f32_16x16x32_bf16(Bt[n][k], At[m][k], acc[ai][bj][m][n], 0, 0, 0); __builtin_amdgcn_s_setprio(0); } while (0)
#define PG8_WAIT_V(n) asm volatile("s_waitcnt vmcnt(" #n ")" ::: "memory")
#define PG8_WAIT_L(n) asm volatile("s_waitcnt lgkmcnt(" #n ")" ::: "memory")
#define PG8_BAR __builtin_amdgcn_s_barrier()
#define PG8_SCHED __builtin_amdgcn_sched_barrier(0)
    Unit cur, nxt; int ui = 0;
    if (!S.next(0, cur)) return;
    f32x4 acc[2][2][4][2];
#pragma unroll
    for (int a = 0; a < 2; ++a)
#pragma unroll
        for (int b = 0; b < 2; ++b)
#pragma unroll
            for (int m = 0; m < 4; ++m)
#pragma unroll
                for (int n = 0; n < 2; ++n) acc[a][b][m][n] = (f32x4){0.f, 0.f, 0.f, 0.f};
    bf16x8 At[4][2], B0[2][2], B1[2][2];
    const char* cA = (const char*)g.A + (size_t)cur.pm * tstepA; const char* cB = (const char*)g.Bt + (size_t)cur.pn * tstepB;
    S.a_ready(cur);
    PG8_STAGE(PG8_SB(0, 0), cB, voffB); PG8_STAGE(PG8_SB(0, 1), cB + hstepB, voffB); PG8_STAGE(PG8_SA(0, 0), cA, voffA); PG8_STAGE(PG8_SA(0, 1), cA + hstepA, voffA);
    if (wr == 1) PG8_BAR;
    PG8_WAIT_V(2); PG8_BAR;
    PG8_STAGE(PG8_SB(1, 0), cB + kstep, voffB); PG8_STAGE(PG8_SA(1, 0), cA + kstep, voffA); PG8_STAGE(PG8_SB(1, 1), cB + hstepB + kstep, voffB);
    PG8_WAIT_V(6); PG8_BAR;
    for (;;) {
        const bool has_next = S.next(ui + 1, nxt);
        const char* nA = has_next ? (const char*)g.A + (size_t)nxt.pm * tstepA : cA; const char* nB = has_next ? (const char*)g.Bt + (size_t)nxt.pn * tstepB : cB;
        for (int t = 0; t < nt; t += 2) {
            const bool last = (t == nt - 2);
            const char* a1 = cA + (size_t)(t + 1) * kstep;
            const char* a2 = last ? nA : cA + (size_t)(t + 2) * kstep; const char* b2 = last ? nB : cB + (size_t)(t + 2) * kstep;
            const char* a3 = a2 + kstep; const char* b3 = b2 + kstep;
            if (last && has_next) S.a_ready(nxt);
            PG8_LDB(B0, 0, 0); PG8_LDB(B1, 0, 1); PG8_SCHED; PG8_LDA(At, 0, 0); PG8_STAGE(PG8_SA(1, 1), a1 + hstepA, voffA);
            PG8_WAIT_V(8); PG8_WAIT_L(0); PG8_BAR; PG8_MMA(0, 0, At, B0); PG8_MMA(0, 1, At, B1); PG8_BAR; PG8_SCHED;
            PG8_LDA(At, 0, 1); PG8_STAGE(PG8_SB(0, 0), b2, voffB); PG8_STAGE(PG8_SB(0, 1), b2 + hstepB, voffB); PG8_STAGE(PG8_SA(0, 0), a2, voffA);
            PG8_WAIT_V(8); PG8_WAIT_L(0); PG8_BAR; PG8_MMA(1, 0, At, B0); PG8_MMA(1, 1, At, B1); PG8_BAR; PG8_SCHED;
            PG8_LDB(B0, 1, 0); PG8_LDB(B1, 1, 1); PG8_SCHED; PG8_LDA(At, 1, 0); PG8_STAGE(PG8_SA(0, 1), a2 + hstepA, voffA);
            PG8_WAIT_V(8); PG8_WAIT_L(0); PG8_BAR; PG8_MMA(0, 0, At, B0); PG8_MMA(0, 1, At, B1); PG8_BAR; PG8_SCHED;
            PG8_LDA(At, 1, 1); PG8_STAGE(PG8_SB(1, 0), b3, voffB); PG8_STAGE(PG8_SB(1, 1), b3 + hstepB, voffB); PG8_STAGE(PG8_SA(1, 0), a3, voffA);
            PG8_WAIT_V(8); PG8_WAIT_L(0); PG8_BAR; PG8_MMA(1, 0, At, B0); PG8_MMA(1, 1, At, B1); PG8_BAR; PG8_SCHED;
        }
        if constexpr (ALIGN_EPI) { if (wr == 0) PG8_BAR; }
        E(acc, cur, wr, wc, fr, fq); S.done(cur);
        if (!has_next) break;
#pragma unroll
        for (int a = 0; a < 2; ++a)
#pragma unroll
            for (int b = 0; b < 2; ++b)
#pragma unroll
                for (int m = 0; m < 4; ++m)
#pragma unroll
                    for (int n = 0; n < 2; ++n) acc[a][b][m][n] = (f32x4){0.f, 0.f, 0.f, 0.f};
        cur = nxt; cA = nA; cB = nB; ++ui;
        if constexpr (ALIGN_EPI) { if (wr == 1) PG8_BAR; }
    }
    PG8_WAIT_V(0);
    if constexpr (!ALIGN_EPI) { if (wr == 0) PG8_BAR; }
    PG8_BAR;
#undef PG8_SA
#undef PG8_SB
#undef PG8_STAGE
#undef PG8_LDA
#undef PG8_LDB
#undef PG8_MMA
#undef PG8_WAIT_V
#undef PG8_WAIT_L
#undef PG8_BAR
#undef PG8_SCHED
}
}

constexpr int NWAVES = 8, NTHREADS = 512;
constexpr int DM = 1024, SEQ = 8192, NB = 4, MP = NB * SEQ  , DECB = 128, DECT = 8, MS = DECB * DECT  , MT = MP + MS  ;
constexpr int NPAGES = 128, PAGE = 128, PAST = NPAGES * PAGE;
constexpr int HM = 8, QN = 64, QR = 32, VH = 64, KVL = 128, QL = 256;
constexpr int HG = 4, GDK = 64, GDV = 128, GRANK = 16;
constexpr int PD = 256, INDIM = 2480;
constexpr int ZP = 2560;
constexpr int ZC_KV = 256, ZC_KR = 384, ZC_AG = 416, ZC_GM = 512, ZC_QG = 1024, ZC_KG = 1280, ZC_VG = 1536, ZC_GG = 2048;
constexpr float EPS = 1e-6f;
constexpr float QSCALE = 0.10206207261596577f * 1.4426950408889634f;
constexpr int NPOS = SEQ + DECT;
constexpr int NCH = SEQ / 64;
constexpr int NGU = NB * HG * NCH;
constexpr int DSPLIT = 2, DPART = DSPLIT * 4;

constexpr size_t O_Y = 0;
constexpr size_t O_CKVP = (size_t)MT * DM;
constexpr size_t O_KRP = O_CKVP + (size_t)MP * KVL;
constexpr size_t O_GSP = O_KRP + (size_t)MP * QR;
constexpr size_t O_CKVS = O_GSP + (size_t)NB * HG * GDK * GDV;
constexpr size_t O_KRS = O_CKVS + (size_t)MS * KVL;
constexpr size_t O_GSS = O_KRS + (size_t)MS * QR;
constexpr size_t O_END = O_GSS + (size_t)DECB * HG * GDK * GDV;

constexpr size_t MiB = 1u << 20;
constexpr size_t WS_CTL = 0, CTL_ZERO_BYTES = 2 * MiB;
constexpr int CW_BAR = 4096;
constexpr int CW_PCNT = 16384, CW_SCNT = CW_PCNT + 64 * 128;
constexpr int CW_ATQ = 32768;
constexpr int CW_TMO = 64;
constexpr size_t WS_SSQ_Q = 256 * 1024, WS_SSQ_KV = WS_SSQ_Q + (size_t)MT * 4, WS_SSQ_Y = WS_SSQ_KV + (size_t)MT * 4;
static_assert(WS_SSQ_Y + (size_t)MT * 4 <= CTL_ZERO_BYTES, "ctl map");
constexpr size_t WS_WIN = 2 * MiB;
constexpr size_t WS_WQP = WS_WIN + (size_t)ZP * DM * 2;
constexpr size_t WS_WQS = WS_WQP + 768 * 256 * 2;
constexpr size_t WS_WKV = WS_WQS + 1280 * 256 * 2;
constexpr size_t WS_WPP = WS_WKV + 1024 * 256 * 2;
constexpr size_t WS_WOUT = WS_WPP + 1024 * 256 * 2;
constexpr size_t WS_WPG = WS_WOUT + (size_t)DM * DM * 2;
constexpr size_t WS_ROPE = WS_WPG + (size_t)DM * DM * 2;
constexpr size_t WS_W2T = WS_ROPE + (size_t)NPOS * 32 * 4;
constexpr size_t WS_RSX = WS_W2T + 256 * 16 * 2;
constexpr size_t WS_XN = 16 * MiB;
constexpr size_t WS_PB = WS_XN + (size_t)MT * DM * 2;
constexpr size_t WS_Z = WS_PB + (size_t)MT * PD * 2;
constexpr size_t WS_QP = WS_Z + (size_t)MT * ZP * 2;
constexpr size_t WS_QS = WS_QP + (size_t)MP * 768 * 2;
constexpr size_t WS_KN = WS_QS + (size_t)MS * 1280 * 2;
constexpr size_t WS_VV = WS_KN + (size_t)MP * 512 * 2;
constexpr size_t WS_KR = WS_VV + (size_t)MP * 512 * 2;
constexpr size_t WS_PP = WS_KR + (size_t)MT * 32 * 2;
constexpr size_t WS_QT = WS_PP + (size_t)MT * DM * 2;
constexpr size_t WS_KT = WS_QT + (size_t)MP * 256 * 2;
constexpr size_t WS_U = WS_KT + (size_t)MP * 256 * 2;
constexpr size_t WS_DEC = WS_U + (size_t)NGU * GDK * GDV * 4;
constexpr size_t WS_SPREV = WS_DEC + (size_t)NGU * GDK * 4;
constexpr size_t WS_PART = WS_SPREV + (size_t)NGU * GDK * GDV * 2;
constexpr size_t WS_ML = WS_PART + (size_t)DECB * DPART * 64 * 128 * 4;
constexpr size_t WS_MIX = WS_ML + (size_t)DECB * DPART * 64 * 2 * 4;
constexpr size_t WS_H1B = WS_MIX + (size_t)MT * DM * 2;
constexpr size_t WS_END = WS_H1B + (size_t)MT * DM * 2;
static_assert(WS_RSX + (size_t)MT * 4 <= WS_XN, "weights map");

constexpr int RING_BYTES = 131072;
constexpr int LDSCTL_OFF = RING_BYTES, MISC_OFF = LDSCTL_OFF + 320;
constexpr int LDS_BYTES = 147456;

#define FRESH_LANE_ID(l) asm volatile("v_mbcnt_lo_u32_b32 %0, -1, 0\n\tv_mbcnt_hi_u32_b32 %0, -1, %0" : "=v"(l))
#define GAS __attribute__((address_space(1)))
#define LAS __attribute__((address_space(3)))
typedef unsigned short bf16;
typedef unsigned v4u __attribute__((ext_vector_type(4)));
typedef unsigned v2u __attribute__((ext_vector_type(2)));
typedef float f32x4 __attribute__((ext_vector_type(4)));
typedef float f32x2 __attribute__((ext_vector_type(2)));
typedef float f32x16 __attribute__((ext_vector_type(16)));
typedef short bf16x8 __attribute__((ext_vector_type(8)));
typedef short s16x4 __attribute__((ext_vector_type(4)));
typedef GAS unsigned gu32;
#define LDS_WAIT() asm volatile("s_waitcnt lgkmcnt(0)" ::: "memory")
#define VM_WAIT() asm volatile("s_waitcnt vmcnt(0)" ::: "memory")
__device__ __forceinline__ unsigned f2bf(float f) { unsigned u = __builtin_bit_cast(unsigned, f); return (u + 0x7fffu + ((u >> 16) & 1u)) >> 16; }
typedef float f32x2_cv __attribute__((ext_vector_type(2))); typedef __bf16 bf16x2_cv __attribute__((ext_vector_type(2)));
__device__ __forceinline__ unsigned pk2(float lo, float hi) { f32x2_cv v = {lo, hi}; bf16x2_cv b = __builtin_convertvector(v, bf16x2_cv); return __builtin_bit_cast(unsigned, b); }
__device__ __forceinline__ float bf2f(unsigned short b) { return __builtin_bit_cast(float, (unsigned)b << 16); }
__device__ __forceinline__ float bflo(unsigned w) { return __builtin_bit_cast(float, w << 16); }
__device__ __forceinline__ float bfhi(unsigned w) { return __builtin_bit_cast(float, w & 0xffff0000u); }
__device__ __forceinline__ float wave_sum(float v) {
#pragma unroll
    for (int o = 1; o < 64; o <<= 1) v += __shfl_xor(v, o);
    return v;
}
__device__ __forceinline__ float fast_exp2(float x) { return __builtin_amdgcn_exp2f(x); }
__device__ __forceinline__ float siluf(float x) { return x * __builtin_amdgcn_rcpf(1.f + __expf(-x)); }
__device__ __forceinline__ float sigmoidf_(float x) { return __builtin_amdgcn_rcpf(1.f + __expf(-x)); }
__device__ __forceinline__ float rsq(float x) { return __builtin_amdgcn_rsqf(x); }
__device__ __forceinline__ float xor32(float v, bool upper) {
    auto rr = __builtin_amdgcn_permlane32_swap(__float_as_uint(v), __float_as_uint(v), false, false);
    return __uint_as_float(upper ? rr[0] : rr[1]);
}
__device__ __forceinline__ int crow(int r, int hi) { return (r & 3) + 8 * (r >> 2) + 4 * hi; }
#define XB_TMO      128
#define XB_XCNT(j)  (256  + 64 * (j))
#define XB_XSUB(j)  (1280 + 64 * (j))
#define XB_XGEN(j)  (2304 + 64 * (j))
#define XB_TOP      3328
#define XB_TOPGEN   3392
#define XCD_BAR_WORDS 3456
#define XB_SPIN_CAP (1u << 18)

__device__ __forceinline__ unsigned xb_ld(unsigned* p)              { return __hip_atomic_load(p, __ATOMIC_RELAXED, __HIP_MEMORY_SCOPE_AGENT); }
__device__ __forceinline__ unsigned xb_add(unsigned* p, unsigned v) { return __hip_atomic_fetch_add(p, v, __ATOMIC_RELAXED, __HIP_MEMORY_SCOPE_AGENT); }
__device__ __forceinline__ unsigned xb_xcc_id() { return (unsigned)__builtin_amdgcn_s_getreg((3 << 11) | 20) & 0xFu; }
#define XB_SPIN(cond, bar) do { unsigned _sp = 0; while (cond) { __builtin_amdgcn_s_sleep(1); \
    if ((++_sp & 255u) == 0u) { if (xb_ld(&(bar)[XB_TMO])) break; if (_sp > XB_SPIN_CAP) { atomicAdd(&(bar)[XB_TMO], 1u); break; } } } } while (0)

struct XcdBarrier {
    int w;
    unsigned* bar; unsigned x;
    volatile LAS unsigned* st;
};

__device__ __forceinline__ XcdBarrier xcd_barrier_post(unsigned* bar, volatile LAS unsigned* st) {
    XcdBarrier b; b.w = (int)__builtin_amdgcn_readfirstlane(threadIdx.x >> 6); b.bar = bar; b.x = xb_xcc_id(); b.st = st;
    if (threadIdx.x == 0) (void)xb_add(&bar[XB_XCNT(b.x)], 1u);
    return b;
}
__device__ __forceinline__ void xcd_barrier_complete(unsigned* bar, unsigned x, unsigned& nloc, unsigned& nx) {
    const unsigned G = gridDim.x * gridDim.y * gridDim.z;
    unsigned sum, cnt, mine, sp = 0u;
    for (;;) {
        sum = 0u; cnt = 0u; mine = 0u;
#pragma unroll
        for (unsigned j = 0; j < 16; ++j) { const unsigned c = xb_ld(&bar[XB_XCNT(j)]); sum += c; cnt += (c > 0u) ? 1u : 0u; mine = (j == x) ? c : mine; }
        if (sum == G) break;
        __builtin_amdgcn_s_sleep(1);
        if ((++sp & 255u) == 0u) { if (xb_ld(&bar[XB_TMO])) break; if (sp > XB_SPIN_CAP) { atomicAdd(&bar[XB_TMO], 1u); break; } }
    }
    nloc = mine > 0u ? mine : 1u; nx = cnt > 0u ? cnt : 1u;
}

__device__ __forceinline__ void xcd_barrier(const XcdBarrier& b) {
    asm volatile("s_waitcnt vmcnt(0)" ::: "memory");
    __syncthreads();
    unsigned xb_lane; asm volatile("v_mbcnt_lo_u32_b32 %0, -1, 0\n\tv_mbcnt_hi_u32_b32 %0, -1, %0" : "=v"(xb_lane));
    if (b.w == 0 && xb_lane == 0u) {
        unsigned* bar = b.bar;
        __builtin_amdgcn_s_waitcnt(0);
        unsigned nloc = b.st[0], nx = b.st[1];
        if (nloc == 0u) { xcd_barrier_complete(bar, b.x, nloc, nx); b.st[0] = nloc; b.st[1] = nx; }
        const unsigned old = xb_add(&bar[XB_XSUB(b.x)], 1u);
        const unsigned gen = old / nloc;
        if (old + 1u == (gen + 1u) * nloc) {
            __builtin_amdgcn_fence(__ATOMIC_RELEASE, "agent");
            asm volatile("s_waitcnt vmcnt(0)" ::: "memory");
            const unsigned og = xb_add(&bar[XB_TOP], 1u);
            const unsigned tg = og / nx;
            if (og + 1u == (tg + 1u) * nx) xb_add(&bar[XB_TOPGEN], 1u);
            else XB_SPIN(xb_ld(&bar[XB_TOPGEN]) == tg, bar);
            __builtin_amdgcn_fence(__ATOMIC_ACQUIRE, "agent");
            xb_add(&bar[XB_XGEN(b.x)], 1u);
            asm volatile("s_waitcnt vmcnt(0)" ::: "memory");
        } else {
            XB_SPIN(xb_ld(&bar[XB_XGEN(b.x)]) == gen, bar);
            __builtin_amdgcn_fence(__ATOMIC_ACQUIRE, "agent");
            asm volatile("s_waitcnt vmcnt(0)" ::: "memory");
        }
    }
    __syncthreads();
}

struct Args { const float* in[22]; float* out; unsigned char* ws; };
struct Frame {
    LAS unsigned char* lds; gu32* ctl;
    int tid, lane, wave, vcu, G;
    const float *x_p, *x_s, *p_p, *p_s, *cache_ckv, *cache_kr, *state_gla; const int* page_table;
    const float *g_mix, *w_in, *g_q, *w_qup, *g_kv, *w_uk, *w_uv, *w_a2, *b_a, *g_on, *w_out, *w_pg, *w_pp, *g_fin;
    float* out; unsigned char* ws;
    bf16 *WIN, *WQP, *WQS, *WKV, *WPP, *WOUT, *WPG, *W2T; float* ROPE;
    bf16 *XN, *PB, *Z, *QP, *QS, *KN, *VV, *KR, *PP, *QT, *KT, *SPREV, *MIX, *H1B;
    float *U, *DEC, *PART, *ML, *SSQ_Q, *SSQ_KV, *SSQ_Y, *RSX;
};
typedef __attribute__((address_space(4))) const unsigned long long* kargp_t;
__device__ __forceinline__ void make_frame(Frame& F, LAS unsigned char* lds, int wave_s) {
    kargp_t ka = (kargp_t)__builtin_amdgcn_kernarg_segment_ptr(); asm volatile("" : "+s"(ka));
    int lane_; FRESH_LANE_ID(lane_);
    F.lds = lds; F.lane = lane_; F.wave = wave_s; F.tid = wave_s * 64 + lane_;
    F.G = gridDim.x; { const int bx = blockIdx.x; F.vcu = (F.G % 8 == 0) ? (bx % 8) * (F.G / 8) + bx / 8 : bx; }
#define KIN(i) ((const float*)(GAS const float*)ka[i])
    F.x_p = KIN(0); F.x_s = KIN(1); F.p_p = KIN(2); F.p_s = KIN(3); F.cache_ckv = KIN(4); F.cache_kr = KIN(5); F.state_gla = KIN(6);
    F.page_table = (const int*)(GAS const int*)ka[7]; F.g_mix = KIN(8); F.w_in = KIN(9); F.g_q = KIN(10); F.w_qup = KIN(11); F.g_kv = KIN(12);
    F.w_uk = KIN(13); F.w_uv = KIN(14); F.w_a2 = KIN(15); F.b_a = KIN(16); F.g_on = KIN(17); F.w_out = KIN(18); F.w_pg = KIN(19);
    F.w_pp = KIN(20); F.g_fin = KIN(21);
    F.out = (float*)(GAS float*)ka[22]; unsigned char* ws = (unsigned char*)(GAS unsigned char*)ka[23]; F.ws = ws;
#undef KIN
    F.ctl = (gu32*)(ws + WS_CTL);
    F.WIN = (bf16*)(ws + WS_WIN); F.WQP = (bf16*)(ws + WS_WQP); F.WQS = (bf16*)(ws + WS_WQS); F.WKV = (bf16*)(ws + WS_WKV); F.WPP = (bf16*)(ws + WS_WPP);
    F.WOUT = (bf16*)(ws + WS_WOUT); F.WPG = (bf16*)(ws + WS_WPG); F.ROPE = (float*)(ws + WS_ROPE); F.W2T = (bf16*)(ws + WS_W2T);
    F.XN = (bf16*)(ws + WS_XN); F.PB = (bf16*)(ws + WS_PB); F.Z = (bf16*)(ws + WS_Z); F.QP = (bf16*)(ws + WS_QP); F.QS = (bf16*)(ws + WS_QS);
    F.KN = (bf16*)(ws + WS_KN); F.VV = (bf16*)(ws + WS_VV); F.KR = (bf16*)(ws + WS_KR); F.PP = (bf16*)(ws + WS_PP); F.QT = (bf16*)(ws + WS_QT); F.KT = (bf16*)(ws + WS_KT);
    F.SPREV = (bf16*)(ws + WS_SPREV); F.MIX = (bf16*)(ws + WS_MIX); F.H1B = (bf16*)(ws + WS_H1B);
    F.U = (float*)(ws + WS_U); F.DEC = (float*)(ws + WS_DEC); F.PART = (float*)(ws + WS_PART); F.ML = (float*)(ws + WS_ML);
    F.SSQ_Q = (float*)(ws + WS_SSQ_Q); F.SSQ_KV = (float*)(ws + WS_SSQ_KV); F.SSQ_Y = (float*)(ws + WS_SSQ_Y); F.RSX = (float*)(ws + WS_RSX);
}
__device__ __forceinline__ const float* xrow_ptr(const Frame& F, int row) { return row < MP ? F.x_p + (size_t)row * DM : F.x_s + (size_t)(row - MP) * DM; }

template <class Fn> __device__ __forceinline__ void tr_item(const Fn& f, int K, bf16* WT, LAS float* scr, int kb, int nb, int lane) {
    const int k0 = 64 * kb, n0 = 32 * nb;
#pragma unroll 8
    for (int i = 0; i < 32; ++i) { const int kk = 2 * i + (lane >> 5); scr[kk * 33 + (lane & 31)] = f(k0 + kk, n0 + (lane & 31)); }
    LDS_WAIT(); asm volatile("" ::: "memory");
    const int c = lane & 7;
#pragma unroll
    for (int j = 0; j < 4; ++j) { const int n = (lane >> 3) + 8 * j; const LAS float* s = scr + (8 * c) * 33 + n;
        v4u o; o.x = pk2(s[0 * 33], s[1 * 33]); o.y = pk2(s[2 * 33], s[3 * 33]); o.z = pk2(s[4 * 33], s[5 * 33]); o.w = pk2(s[6 * 33], s[7 * 33]);
        *(GAS v4u*)(WT + (size_t)(n0 + n) * K + k0 + 8 * c) = o; }
    LDS_WAIT(); asm volatile("" ::: "memory");
}
__device__ __forceinline__ int win_src_col(int n) {
    if (n < 416) return n;
    if (n < 432) return 1952 + (n - 416);
    if (n < 512) return -1;
    if (n < 1024) return 416 + (n - 512);
    if (n < 1280) return 928 + (n - 1024);
    if (n < 1536) return 1184 + (n - 1280);
    if (n < 2048) return 1440 + (n - 1536);
    return 1968 + (n - 2048);
}
__device__ __forceinline__ int qup_src_col(int n) {
    return n < 512 ? (n >> 6) * 96 + (n & 63) : ((n - 512) >> 5) * 96 + 64 + ((n - 512) & 31);
}
__device__ __forceinline__ void sincos_d(double a, float& s, float& c) {
    const double q = __builtin_rint(a * 0.63661977236758134308);
    const double r = __builtin_fma(-q, 1.57079632679489655800, a) - q * 6.12323399573676603587e-17;
    const double r2 = r * r;
    double sp = -7.6471637318198164759e-13; sp = sp * r2 + 1.6059043836821614599e-10; sp = sp * r2 - 2.5052108385441718775e-8; sp = sp * r2 + 2.7557319223985890653e-6;
    sp = sp * r2 - 1.9841269841269841270e-4; sp = sp * r2 + 8.3333333333333333333e-3; sp = sp * r2 - 1.6666666666666666667e-1; const double sn = r + r * r2 * sp;
    double cp = 4.7794773323873852974e-14; cp = cp * r2 - 1.1470745597729724714e-11; cp = cp * r2 + 2.0876756987868098979e-9; cp = cp * r2 - 2.7557319223985890653e-7;
    cp = cp * r2 + 2.4801587301587301587e-5; cp = cp * r2 - 1.3888888888888888889e-3; cp = cp * r2 + 4.1666666666666666667e-2; cp = cp * r2 - 0.5; const double cs = 1.0 + r2 * cp;
    const int qi = (int)((long long)q & 3);
    const double so = (qi == 0) ? sn : (qi == 1) ? cs : (qi == 2) ? -sn : -cs;
    const double co = (qi == 0) ? cs : (qi == 1) ? -sn : (qi == 2) ? -cs : sn;
    s = (float)so; c = (float)co;
}
__device__ __forceinline__ void p0_prologue(Frame& F) {
    LAS float* scr = (LAS float*)(F.lds + F.wave * 16384);
    const int gw = F.vcu * NWAVES + F.wave, NGW = F.G * NWAVES, lane = F.lane;
    constexpr int I_WIN = 16 * 80, I_WQP = 4 * 24, I_WKV = 4 * 32, I_WPP = 4 * 32, I_WOUT = 16 * 32, I_WPG = 16 * 32;
    constexpr int NITEMS = I_WIN + I_WQP + I_WKV + I_WPP + I_WOUT + I_WPG;
    for (int it = gw; it < NITEMS; it += NGW) {
        int r = it;
        if (r < I_WIN) { const float* w = F.w_in; const float* g = F.g_mix;
            tr_item([&](int k, int n) -> float { const int s = win_src_col(n); return s >= 0 ? g[k] * w[(size_t)k * INDIM + s] : 0.f; }, DM, F.WIN, scr, r / 80, r % 80, lane); continue; } r -= I_WIN;
        if (r < I_WQP) { const float* w = F.w_qup; const float* g = F.g_q;
            tr_item([&](int k, int n) -> float { return g[k] * w[(size_t)k * 768 + qup_src_col(n)] * QSCALE; }, QL, F.WQP, scr, r / 24, r % 24, lane); continue; } r -= I_WQP;
        if (r < I_WKV) { const float* uk = F.w_uk; const float* uv = F.w_uv; const float* g = F.g_kv;
            tr_item([&](int k, int n) -> float { if (k >= KVL) return 0.f; return g[k] * (n < 512 ? uk[(size_t)k * 512 + n] : uv[(size_t)k * 512 + (n - 512)]); }, 256, F.WKV, scr, r / 32, r % 32, lane); continue; } r -= I_WKV;
        if (r < I_WPP) { const float* w = F.w_pp;
            tr_item([&](int k, int n) -> float { return w[(size_t)k * DM + n]; }, PD, F.WPP, scr, r / 32, r % 32, lane); continue; } r -= I_WPP;
        if (r < I_WOUT) { const float* w = F.w_out;
            tr_item([&](int k, int n) -> float { return w[(size_t)k * DM + n]; }, DM, F.WOUT, scr, r / 32, r % 32, lane); continue; } r -= I_WOUT;
        { const float* w = F.w_pg;
            tr_item([&](int k, int n) -> float { return w[(size_t)k * DM + n]; }, DM, F.WPG, scr, r / 32, r % 32, lane); }
    }
    for (int e = (F.vcu * NTHREADS + F.tid); e < NPOS * 16; e += F.G * NTHREADS) {
        const int pi = e >> 4, i = e & 15; const double pos = (double)(pi < SEQ ? pi : PAST + (pi - SEQ));
        double inv = 1.0; for (int j = 0; j < i; ++j) inv *= 0.56234132519034908039;
        float s, c; sincos_d(pos * inv, s, c);
        F.ROPE[(size_t)pi * 32 + i] = c; F.ROPE[(size_t)pi * 32 + 16 + i] = s;
    }
    for (int e = F.vcu * NTHREADS + F.tid; e < 256 * 16; e += F.G * NTHREADS) F.W2T[e] = (bf16)f2bf(F.w_a2[(e & 15) * 256 + (e >> 4)]);
    for (int e = F.vcu * NTHREADS + F.tid; e < 512 * QL; e += F.G * NTHREADS) {
        const int q = e >> 8, k = e & 255, h = q >> 6, c = 2 * (q & 63);
        const GAS f32x4* wq = (const GAS f32x4*)(F.w_qup + (size_t)k * 768 + h * 96);
        const GAS f32x4* wu0 = (const GAS f32x4*)(F.w_uk + (size_t)(c * 8 + h) * 64); const GAS f32x4* wu1 = (const GAS f32x4*)(F.w_uk + (size_t)((c + 1) * 8 + h) * 64);
        float s0 = 0.f, s1 = 0.f;
#pragma unroll
        for (int d = 0; d < 16; ++d) { const f32x4 a = wq[d], b0 = wu0[d], b1 = wu1[d];
            s0 += (a.x * b0.x + a.y * b0.y) + (a.z * b0.z + a.w * b0.w); s1 += (a.x * b1.x + a.y * b1.y) + (a.z * b1.z + a.w * b1.w); }
        const float gs = F.g_q[k] * QSCALE;
        F.WQS[(size_t)(h * 128 + c) * QL + k] = (bf16)f2bf(s0 * gs); F.WQS[(size_t)(h * 128 + c + 1) * QL + k] = (bf16)f2bf(s1 * gs);
    }
    for (int e = F.vcu * NTHREADS + F.tid; e < 256 * QL; e += F.G * NTHREADS) {
        const int n = 1024 + (e >> 8), k = e & 255;
        F.WQS[(size_t)n * QL + k] = (bf16)f2bf(F.w_qup[(size_t)k * 768 + qup_src_col(n - 1024 + 512)] * F.g_q[k] * QSCALE);
    }
}
__device__ __forceinline__ void p0_rows(Frame& F) {
    const int gw = F.vcu * NWAVES + F.wave, NGW = F.G * NWAVES, lane = F.lane;
    for (int m0 = 4 * gw; m0 < MT; m0 += 4 * NGW) {
        f32x4 v[4][4], pv[4];
#pragma unroll
        for (int r = 0; r < 4; ++r) { const int m = m0 + r; const GAS f32x4* xr = (const GAS f32x4*)xrow_ptr(F, m) + lane;
#pragma unroll
            for (int j = 0; j < 4; ++j) v[r][j] = xr[64 * j];
            const float* prow = m < MP ? F.p_p + (size_t)m * PD : F.p_s + (size_t)(m - MP) * PD; pv[r] = ((const GAS f32x4*)prow)[lane]; }
#pragma unroll
        for (int r = 0; r < 4; ++r) { const int m = m0 + r; float s = 0.f;
#pragma unroll
            for (int j = 0; j < 4; ++j) s += (v[r][j].x * v[r][j].x + v[r][j].y * v[r][j].y) + (v[r][j].z * v[r][j].z + v[r][j].w * v[r][j].w);
            const float rstd = 1.f / sqrtf(wave_sum(s) * (1.f / DM) + EPS);
            if (lane == 0) F.RSX[m] = rstd;
            GAS unsigned long long* o8 = (GAS unsigned long long*)(F.XN + (size_t)m * DM) + lane;
#pragma unroll
            for (int j = 0; j < 4; ++j) o8[64 * j] = (unsigned long long)pk2(v[r][j].x, v[r][j].y) | ((unsigned long long)pk2(v[r][j].z, v[r][j].w) << 32);
            ((GAS unsigned long long*)(F.PB + (size_t)m * PD))[lane] = (unsigned long long)pk2(pv[r].x, pv[r].y) | ((unsigned long long)pk2(pv[r].z, pv[r].w) << 32); }
    }
}

namespace pg8 {
__device__ __forceinline__ u32x4 pack8(const f32x4 v0, const f32x4 v1) { u32x4 w; w.x = cvt_pk_bf16(v0[0], v0[1]); w.y = cvt_pk_bf16(v0[2], v0[3]); w.z = cvt_pk_bf16(v1[0], v1[1]); w.w = cvt_pk_bf16(v1[2], v1[3]); return w; }
struct EpiZ {
    static constexpr bool PERM = true;
    bf16_t* Z; float* ssq_q; float* ssq_kv; const float* rsx;
    __device__ __forceinline__ void operator()(const f32x4 (&acc)[2][2][4][2], const Unit& u, int wr, int wc, int, int) const {
        int ln_; FRESH_LANE_ID(ln_); const int fr = ln_ & 15, fq = ln_ >> 4;
        const int row0 = u.pm * BM + wr * 64 + fr, col0 = u.pn * BM + wc * 32 + 8 * fq;
#pragma unroll
        for (int ai = 0; ai < 2; ++ai)
#pragma unroll
            for (int m = 0; m < 4; ++m) { bf16_t* rowp = Z + (size_t)(row0 + ai * HALF + m * 16) * ZP + col0; const float rs = rsx[row0 + ai * HALF + m * 16];
#pragma unroll
                for (int bj = 0; bj < 2; ++bj) *(u32x4*)(rowp + bj * HALF) = pack8(acc[ai][bj][m][0] * rs, acc[ai][bj][m][1] * rs); }
        if (u.pn < 2) {
            float* dst = u.pn == 0 ? ssq_q : ssq_kv; const bool both = (u.pn == 0);
#pragma unroll
            for (int ai = 0; ai < 2; ++ai)
#pragma unroll
                for (int m = 0; m < 4; ++m) { float s = 0.f; const float rs = rsx[row0 + ai * HALF + m * 16];
#pragma unroll
                    for (int n = 0; n < 2; ++n) { const f32x4 a = acc[ai][0][m][n], b = acc[ai][1][m][n];
                        s += (a[0] * a[0] + a[1] * a[1]) + (a[2] * a[2] + a[3] * a[3]);
                        if (both) s += (b[0] * b[0] + b[1] * b[1]) + (b[2] * b[2] + b[3] * b[3]); }
                    s += __shfl_xor(s, 16); s += xor32(s, fq >= 2);
                    if (fq == 0) unsafeAtomicAdd(dst + row0 + ai * HALF + m * 16, s * rs * rs); }
        }
    }
};
struct EpiScale {
    static constexpr bool PERM = true;
    bf16_t* O0; bf16_t* O1; int split_tile; int ldc;
    const float* ssq; float inv_dim; int row_base;
    int rope_tile; const float* rope; int pos_mask, pos_base;
    __device__ __forceinline__ void operator()(const f32x4 (&acc)[2][2][4][2], const Unit& u, int wr, int wc, int, int) const {
        int ln_; FRESH_LANE_ID(ln_); const int fr = ln_ & 15, fq = ln_ >> 4;
        const int row0 = u.pm * BM + wr * 64 + fr;
        bf16_t* base = u.pn < split_tile ? O0 + u.pn * BM : O1 + (u.pn - split_tile) * BM;
        const int col0 = wc * 32 + 8 * fq;
        if (u.pn != rope_tile) {
#pragma unroll
            for (int ai = 0; ai < 2; ++ai)
#pragma unroll
                for (int m = 0; m < 4; ++m) { const int row = row0 + ai * HALF + m * 16;
                    const float rs = ssq ? rsq(ssq[row_base + row] * inv_dim + EPS) : 1.f;
                    bf16_t* rowp = base + (size_t)row * ldc + col0;
#pragma unroll
                    for (int bj = 0; bj < 2; ++bj) *(u32x4*)(rowp + bj * HALF) = pack8(acc[ai][bj][m][0] * rs, acc[ai][bj][m][1] * rs); }
        } else {
#pragma unroll
            for (int ai = 0; ai < 2; ++ai)
#pragma unroll
                for (int m = 0; m < 4; ++m) { const int row = row0 + ai * HALF + m * 16;
                    const float rs = ssq ? rsq(ssq[row_base + row] * inv_dim + EPS) : 1.f;
                    bf16_t* rowp = base + (size_t)row * ldc + col0;
                    const float* tb = rope + (size_t)(pos_base + (row & pos_mask)) * 32 + 8 * (fq & 1);
                    const f32x4 cs0 = *(const f32x4*)tb, cs1 = *(const f32x4*)(tb + 4), sn0 = *(const f32x4*)(tb + 16), sn1 = *(const f32x4*)(tb + 20);
#pragma unroll
                    for (int bj = 0; bj < 2; ++bj) { f32x4 v0 = acc[ai][bj][m][0] * rs, v1 = acc[ai][bj][m][1] * rs; f32x4 o0, o1;
#pragma unroll
                        for (int e = 0; e < 4; ++e) { o0[e] = xor32(v0[e], fq >= 2); o1[e] = xor32(v1[e], fq >= 2); }
                        if (fq < 2) { v0 = v0 * cs0 - o0 * sn0; v1 = v1 * cs1 - o1 * sn1; } else { v0 = o0 * sn0 + v0 * cs0; v1 = o1 * sn1 + v1 * cs1; }
                        *(u32x4*)(rowp + bj * HALF) = pack8(v0, v1); }
                    asm volatile("" ::: "memory"); }
        }
    }
};
}

__device__ __forceinline__ void p2_rows(Frame& F) {
    const int gw = F.vcu * NWAVES + F.wave, NGW = F.G * NWAVES, lane = F.lane, g4 = lane >> 4, l16 = lane & 15;
    const f32x4 gk0 = *(const GAS f32x4*)(F.g_kv + 8 * l16), gk1 = *(const GAS f32x4*)(F.g_kv + 8 * l16 + 4);
    for (int m0 = 4 * gw; m0 < MT; m0 += 4 * NGW) {
        const int m = m0 + g4; const bf16* zr = F.Z + (size_t)m * ZP;
        const v4u zz = *(const GAS v4u*)(zr + ZC_KV + 8 * l16);
        const float x1 = bf2f(zr[ZC_KR + l16]), x2 = bf2f(zr[ZC_KR + 16 + l16]);
        const float rstd = rsq(F.SSQ_KV[m] * (1.f / KVL) + EPS);
        const int pi = m < MP ? (m & (SEQ - 1)) : SEQ + ((m - MP) & (DECT - 1));
        const float c = F.ROPE[(size_t)pi * 32 + l16], s = F.ROPE[(size_t)pi * 32 + 16 + l16];
        float* co = (m < MP ? F.out + O_CKVP + (size_t)m * KVL : F.out + O_CKVS + (size_t)(m - MP) * KVL) + 8 * l16;
        *(GAS f32x4*)co = (f32x4){bflo(zz.x) * rstd * gk0.x, bfhi(zz.x) * rstd * gk0.y, bflo(zz.y) * rstd * gk0.z, bfhi(zz.y) * rstd * gk0.w};
        *(GAS f32x4*)(co + 4) = (f32x4){bflo(zz.z) * rstd * gk1.x, bfhi(zz.z) * rstd * gk1.y, bflo(zz.w) * rstd * gk1.z, bfhi(zz.w) * rstd * gk1.w};
        const float o1 = x1 * c - x2 * s, o2 = x1 * s + x2 * c;
        float* ko = (m < MP ? F.out + O_KRP + (size_t)m * QR : F.out + O_KRS + (size_t)(m - MP) * QR);
        ko[l16] = o1; ko[16 + l16] = o2;
        F.KR[(size_t)m * 32 + l16] = (bf16)f2bf(o1); F.KR[(size_t)m * 32 + 16 + l16] = (bf16)f2bf(o2);
    }
}

__device__ __forceinline__ float logsig16(float x) { return (fminf(x, 0.f) - __logf(1.f + __expf(-fabsf(x)))) * 0.0625f; }
__device__ __forceinline__ void unpack8(const v4u w, float* f) { f[0] = bflo(w.x); f[1] = bfhi(w.x); f[2] = bflo(w.y); f[3] = bfhi(w.y); f[4] = bflo(w.z); f[5] = bfhi(w.z); f[6] = bflo(w.w); f[7] = bfhi(w.w); }

constexpr int TRI_CB = 4160, TRI_BYTES = 4 * TRI_CB;
__device__ __forceinline__ s16x4 tr_read(LAS const unsigned char* p) { typedef short v4i16_t __attribute__((ext_vector_type(4))); return __builtin_bit_cast(s16x4, __builtin_amdgcn_ds_read_tr16_b64_v4i16((LAS v4i16_t*)p)); }
__device__ __forceinline__ bf16x8 tri_frag(LAS const unsigned char* img, int cb, int ks, int lane) {
    const int hh = lane >> 5, g1 = (lane >> 4) & 1, i = lane & 15;
    LAS const unsigned char* p = img + cb * TRI_CB + (16 * ks + 4 * hh + (i >> 2)) * 64 + g1 * 32 + (i & 3) * 8;
    const s16x4 lo = tr_read(p), hi = tr_read(p + 512);
    return (bf16x8){lo[0], lo[1], lo[2], lo[3], hi[0], hi[1], hi[2], hi[3]};
}
__device__ __forceinline__ void tri_store(LAS unsigned char* img, int row, int c8, v4u v) { *(LAS v4u*)(img + (c8 >> 2) * TRI_CB + row * 64 + (c8 & 3) * 16) = v; }

struct GlLd { bf16x8 af; v4u q, k, v[2]; };
__device__ __forceinline__ void gla_local_load(Frame& F, const int unit, const int lane, GlLd& L) {
    const int c = unit & (NCH - 1), bh = unit >> 7, h = bh & 3, b = bh >> 2, tid = F.wave * 64 + lane;
    const size_t row0 = (size_t)b * SEQ + c * 64; const int t = tid >> 3, kg = tid & 7; const bf16* zr = F.Z + (row0 + t) * ZP;
    { const int w = F.wave, r32 = lane & 31, hh = lane >> 5; L.af = *(const GAS bf16x8*)(F.Z + (row0 + 32 * (w & 1) + r32) * ZP + ZC_AG + 8 * hh); }
    L.q = *(const GAS v4u*)(zr + ZC_QG + h * 64 + kg * 8); L.k = *(const GAS v4u*)(zr + ZC_KG + h * 64 + kg * 8);
#pragma unroll
    for (int i = 0; i < 2; ++i) { const int p = tid + 512 * i, tt = p >> 4, dch = p & 15; L.v[i] = *(const GAS v4u*)(F.Z + (row0 + tt) * ZP + ZC_VG + h * 128 + dch * 8); }
}
__device__ __forceinline__ void gla_local_compute(Frame& F, const int unit, const int lane, const GlLd& L) {
    const int c = unit & (NCH - 1), bh = unit >> 7, h = bh & 3, b = bh >> 2;
    const int row0 = b * SEQ + c * 64, tid = F.wave * 64 + lane;
    LAS float* LA = (LAS float*)F.lds;
    LAS float* SEG = (LAS float*)(F.lds + 16640);
    LAS unsigned char* KHI = F.lds + 20480;
    LAS unsigned char* VI = F.lds + 20480 + 2 * TRI_CB;
    if (F.wave < 4) { const int tb = F.wave & 1, kb = F.wave >> 1, r32 = lane & 31, hh = lane >> 5; const int col = h * 64 + 32 * kb + r32;
        const bf16x8 bfr = *(const GAS bf16x8*)(F.W2T + col * 16 + 8 * hh); const float bias = F.b_a[col];
        f32x16 x = {}; x = __builtin_amdgcn_mfma_f32_32x32x16_bf16(L.af, bfr, x, 0, 0, 0);
#pragma unroll
        for (int i = 0; i < 16; ++i) LA[(32 * tb + crow(i, hh)) * 65 + 32 * kb + r32] = logsig16(x[i] + bias); }
    __syncthreads();
    { const int k = tid & 63, seg = tid >> 6; float s = 0.f;
#pragma unroll
      for (int i = 0; i < 8; ++i) s += LA[(seg * 8 + i) * 65 + k];
      SEG[seg * 64 + k] = s;
      __syncthreads();
      float run = 0.f;
      for (int s2 = 0; s2 < seg; ++s2) run += SEG[s2 * 64 + k];
#pragma unroll
      for (int i = 0; i < 8; ++i) { run += LA[(seg * 8 + i) * 65 + k]; LA[(seg * 8 + i) * 65 + k] = run; } }
    __syncthreads();
    { const int t = tid >> 3, kg = tid & 7; const size_t row = (size_t)(row0 + t);
      float q[8], kk8[8]; unpack8(L.q, q); unpack8(L.k, kk8);
      float qt[8], kt[8], kh[8];
#pragma unroll
      for (int e = 0; e < 8; ++e) { const int k = kg * 8 + e; const float bv = LA[t * 65 + k], bl = LA[63 * 65 + k];
          qt[e] = q[e] * __expf(bv) * 0.125f; kt[e] = kk8[e] * __expf(-bv); kh[e] = kk8[e] * __expf(bl - bv); }
      v4u o; o.x = pk2(qt[0], qt[1]); o.y = pk2(qt[2], qt[3]); o.z = pk2(qt[4], qt[5]); o.w = pk2(qt[6], qt[7]);
      *(GAS v4u*)(F.QT + row * 256 + h * 64 + kg * 8) = o;
      o.x = pk2(kt[0], kt[1]); o.y = pk2(kt[2], kt[3]); o.z = pk2(kt[4], kt[5]); o.w = pk2(kt[6], kt[7]);
      *(GAS v4u*)(F.KT + row * 256 + h * 64 + kg * 8) = o;
      o.x = pk2(kh[0], kh[1]); o.y = pk2(kh[2], kh[3]); o.z = pk2(kh[4], kh[5]); o.w = pk2(kh[6], kh[7]);
      tri_store(KHI, t, kg, o);
#pragma unroll
      for (int i = 0; i < 2; ++i) { const int p = tid + 512 * i, tt = p >> 4, dch = p & 15; tri_store(VI, tt, dch, L.v[i]); }
      if (tid < 64) F.DEC[(size_t)unit * 64 + tid] = __expf(LA[63 * 65 + tid]); }
    __syncthreads();
    { const int mb = F.wave & 1, nb = F.wave >> 1, r = lane & 31, hh = lane >> 5; f32x16 acc = {};
#pragma unroll
      for (int ks = 0; ks < 4; ++ks) acc = __builtin_amdgcn_mfma_f32_32x32x16_bf16(tri_frag(KHI, mb, ks, lane), tri_frag(VI, nb, ks, lane), acc, 0, 0, 0);
      GAS bf16* up = (GAS bf16*)F.U + (size_t)unit * (GDK * GDV) + 32 * nb + r;
#pragma unroll
      for (int i = 0; i < 16; ++i) up[(size_t)(32 * mb + crow(i, hh)) * GDV] = (bf16)f2bf(acc[i]); }
    __syncthreads();
}
__device__ __forceinline__ void gla_local_phase(Frame& F) {
    int lane; FRESH_LANE_ID(lane);
    GlLd nxt; int u = F.vcu;
    if (u < NGU) gla_local_load(F, u, lane, nxt);
    for (; u < NGU; u += F.G) { const GlLd cur = nxt; if (u + F.G < NGU) gla_local_load(F, u + F.G, lane, nxt); gla_local_compute(F, u, lane, cur); }
}

__device__ __forceinline__ void gla_scan(Frame& F) {
    for (int e = F.vcu * NTHREADS + F.tid; e < NB * HG * GDK * GDV; e += F.G * NTHREADS) {
        const int bh = e >> 13, k = (e >> 7) & 63, dv = e & 127; float S = 0.f;
        const GAS bf16* up = (const GAS bf16*)F.U + (size_t)bh * NCH * (GDK * GDV) + k * GDV + dv; const float* dp = F.DEC + (size_t)bh * NCH * 64 + k; bf16* sp = F.SPREV + (size_t)bh * NCH * (GDK * GDV) + k * GDV + dv;
        for (int c0 = 0; c0 < NCH; c0 += 16) { float u[16], d[16];
#pragma unroll
            for (int i = 0; i < 16; ++i) { u[i] = bf2f(up[(size_t)(c0 + i) * (GDK * GDV)]); d[i] = dp[(size_t)(c0 + i) * 64]; }
#pragma unroll
            for (int i = 0; i < 16; ++i) { sp[(size_t)(c0 + i) * (GDK * GDV)] = (bf16)f2bf(S); S = d[i] * S + u[i]; } }
        F.out[O_GSP + (size_t)e] = S;
    }
}

struct GoLd { v4u sv[2], vv[2]; v2u qp[8]; bf16x8 qn[4]; bf16x8 kf[2][4]; v4u gate[2]; };
__device__ __forceinline__ void gla_out_load(Frame& F, const int unit, const int lane, GoLd& L) {
    const int c = unit & (NCH - 1), bh = unit >> 7, h = bh & 3, b = bh >> 2, w = F.wave, tid = w * 64 + lane, r = lane & 31, hh = lane >> 5, tb = w >> 2;
    const size_t row0 = (size_t)b * SEQ + c * 64;
#pragma unroll
    for (int i = 0; i < 2; ++i) { const int p = tid + 512 * i, row = p >> 4, c8 = p & 15;
        L.sv[i] = *(const GAS v4u*)(F.SPREV + (size_t)unit * (GDK * GDV) + row * GDV + c8 * 8);
        L.vv[i] = *(const GAS v4u*)(F.Z + (row0 + row) * ZP + ZC_VG + h * 128 + c8 * 8); }
    const bf16* qrow = F.QT + (row0 + 32 * tb + r) * 256 + h * 64;
#pragma unroll
    for (int ks = 0; ks < 4; ++ks) { L.qp[2 * ks] = *(const GAS v2u*)(qrow + 16 * ks + 4 * hh); L.qp[2 * ks + 1] = *(const GAS v2u*)(qrow + 16 * ks + 8 + 4 * hh); L.qn[ks] = *(const GAS bf16x8*)(qrow + 16 * ks + 8 * hh); }
#pragma unroll
    for (int sb = 0; sb < 2; ++sb) { const bf16* krow = F.KT + (row0 + 32 * sb + r) * 256 + h * 64;
#pragma unroll
        for (int ks = 0; ks < 4; ++ks) L.kf[sb][ks] = *(const GAS bf16x8*)(krow + 16 * ks + 8 * hh); }
    { const int t = tid >> 3, part = tid & 7; const bf16* gp = F.Z + (row0 + t) * ZP + ZC_GG + h * 128 + part * 16; L.gate[0] = *(const GAS v4u*)gp; L.gate[1] = *(const GAS v4u*)(gp + 8); }
}
__device__ __forceinline__ void gla_out_compute(Frame& F, const int unit, const int lane, const GoLd& L, const float (&gon)[16]) {
    const int c = unit & (NCH - 1), bh = unit >> 7, h = bh & 3, b = bh >> 2;
    const int row0 = b * SEQ + c * 64, tid = F.wave * 64 + lane, r = lane & 31, hh = lane >> 5;
    LAS unsigned char* SI = F.lds;
    LAS unsigned char* VI = F.lds + TRI_BYTES;
    LAS float* OS = (LAS float*)(F.lds + 2 * TRI_BYTES);
#pragma unroll
    for (int i = 0; i < 2; ++i) { const int p = tid + 512 * i, row = p >> 4, c8 = p & 15; tri_store(SI, row, c8, L.sv[i]); tri_store(VI, row, c8, L.vv[i]); }
    __syncthreads();
    const int dvb = F.wave & 3, tb = F.wave >> 2;
    f32x16 o = {};
#pragma unroll
    for (int ks = 0; ks < 4; ++ks) { const bf16x8 sf = tri_frag(SI, dvb, ks, lane);
        const v4u qw = {L.qp[2 * ks].x, L.qp[2 * ks].y, L.qp[2 * ks + 1].x, L.qp[2 * ks + 1].y};
        o = __builtin_amdgcn_mfma_f32_32x32x16_bf16(__builtin_bit_cast(bf16x8, qw), sf, o, 0, 0, 0); }
#pragma unroll
    for (int sb = 0; sb < 2; ++sb) if (sb <= tb) { f32x16 at = {};
#pragma unroll
        for (int ks = 0; ks < 4; ++ks) at = __builtin_amdgcn_mfma_f32_32x32x16_bf16(L.kf[sb][ks], L.qn[ks], at, 0, 0, 0);
        if (sb == tb) {
#pragma unroll
            for (int i = 0; i < 16; ++i) if (crow(i, hh) > r) at[i] = 0.f; }
#pragma unroll
        for (int k2 = 0; k2 < 2; ++k2) { v4u pw; pw.x = pk2(at[8 * k2 + 0], at[8 * k2 + 1]); pw.y = pk2(at[8 * k2 + 2], at[8 * k2 + 3]); pw.z = pk2(at[8 * k2 + 4], at[8 * k2 + 5]); pw.w = pk2(at[8 * k2 + 6], at[8 * k2 + 7]);
            o = __builtin_amdgcn_mfma_f32_32x32x16_bf16(__builtin_bit_cast(bf16x8, pw), tri_frag(VI, dvb, 2 * sb + k2, lane), o, 0, 0, 0); } }
#pragma unroll
    for (int i = 0; i < 16; ++i) OS[(32 * tb + crow(i, hh)) * 132 + 32 * dvb + r] = o[i];
    __syncthreads();
    { const int t = tid >> 3, part = tid & 7; const LAS float* orow = OS + t * 132 + part * 16; float v[16]; float ss = 0.f;
#pragma unroll
      for (int e = 0; e < 16; ++e) { v[e] = orow[e]; ss += v[e] * v[e]; }
      ss += __shfl_xor(ss, 1); ss += __shfl_xor(ss, 2); ss += __shfl_xor(ss, 4);
      const float rstd = rsq(ss * (1.f / GDV) + EPS);
      const size_t row = (size_t)(row0 + t); float g[16]; unpack8(L.gate[0], g); unpack8(L.gate[1], g + 8);
      float res[16];
#pragma unroll
      for (int e = 0; e < 16; ++e) res[e] = v[e] * rstd * gon[e] * siluf(g[e]);
      v4u w0, w1; w0.x = pk2(res[0], res[1]); w0.y = pk2(res[2], res[3]); w0.z = pk2(res[4], res[5]); w0.w = pk2(res[6], res[7]);
      w1.x = pk2(res[8], res[9]); w1.y = pk2(res[10], res[11]); w1.z = pk2(res[12], res[13]); w1.w = pk2(res[14], res[15]);
      bf16* mp = F.MIX + row * DM + 512 + h * 128 + part * 16; *(GAS v4u*)mp = w0; *(GAS v4u*)(mp + 8) = w1; }
    __syncthreads();
}
__device__ __forceinline__ void gla_out_phase(Frame& F) {
    int lane; FRESH_LANE_ID(lane);
    float gon[16];
#pragma unroll
    for (int e = 0; e < 16; ++e) gon[e] = F.g_on[(lane & 7) * 16 + e];
    GoLd nxt; int u = F.vcu;
    if (u < NGU) gla_out_load(F, u, lane, nxt);
    for (; u < NGU; u += F.G) { const GoLd cur = nxt; if (u + F.G < NGU) gla_out_load(F, u + F.G, lane, nxt); gla_out_compute(F, u, lane, cur, gon); }
}

__device__ __forceinline__ void gla_sample_unit(Frame& F, const int unit) {
    int ln_; FRESH_LANE_ID(ln_);
    const int h = unit & 3, b = unit >> 2, tid = F.wave * 64 + ln_; const int row0 = MP + b * DECT;
    LAS float* LA = (LAS float*)F.lds;
    LAS float* QS_ = LA + 512;
    LAS float* KS_ = QS_ + 512;
    LAS float* KH_ = KS_ + 512;
    LAS float* VS_ = KH_ + 512;
    LAS float* AI = VS_ + 1024;
    LAS float* RED = AI + 64;
    { const int t = tid >> 6, k = tid & 63; const bf16* zr = F.Z + (size_t)(row0 + t) * ZP;
      float a[16]; unpack8(*(const GAS v4u*)(zr + ZC_AG), a); unpack8(*(const GAS v4u*)(zr + ZC_AG + 8), a + 8);
      const int col = h * 64 + k; float x = F.b_a[col];
#pragma unroll
      for (int r = 0; r < 16; ++r) x += a[r] * F.w_a2[r * 256 + col];
      LA[t * 64 + k] = logsig16(x); }
    __syncthreads();
    if (tid < 64) { float run = 0.f;
#pragma unroll
        for (int t = 0; t < 8; ++t) { run += LA[t * 64 + tid]; LA[t * 64 + tid] = run; } }
    __syncthreads();
    { const int t = tid >> 6, k = tid & 63; const bf16* zr = F.Z + (size_t)(row0 + t) * ZP;
      const float bv = LA[t * 64 + k], bl = LA[7 * 64 + k], q = bf2f(zr[ZC_QG + h * 64 + k]), kk = bf2f(zr[ZC_KG + h * 64 + k]);
      QS_[t * 64 + k] = q * __expf(bv) * 0.125f; KS_[t * 64 + k] = kk * __expf(-bv); KH_[t * 64 + k] = kk * __expf(bl - bv);
#pragma unroll
      for (int i = 0; i < 2; ++i) { const int p = tid + 512 * i, tt = p >> 7, dv = p & 127; VS_[tt * 128 + dv] = bf2f(F.Z[(size_t)(row0 + tt) * ZP + ZC_VG + h * 128 + dv]); } }
    __syncthreads();
    if (tid < 64) { const int t = tid >> 3, s = tid & 7; float a = 0.f;
        if (s <= t) {
#pragma unroll 8
            for (int k = 0; k < 64; ++k) a += QS_[t * 64 + k] * KS_[s * 64 + k]; }
        AI[t * 8 + s] = a; }
    { const int kq = tid >> 7, dv = tid & 127; const float* s0p = F.state_gla + (((size_t)b * HG + h) * GDK + kq * 16) * GDV + dv; float* snp = F.out + O_GSS + (((size_t)b * HG + h) * GDK + kq * 16) * GDV + dv;
      float s0[16];
#pragma unroll
      for (int kk = 0; kk < 16; ++kk) s0[kk] = s0p[(size_t)kk * GDV];
      float po[8];
#pragma unroll
      for (int t = 0; t < 8; ++t) { float a = 0.f;
#pragma unroll
          for (int kk = 0; kk < 16; ++kk) a += QS_[t * 64 + kq * 16 + kk] * s0[kk];
          po[t] = a; }
#pragma unroll
      for (int t = 0; t < 8; ++t) RED[(kq * 8 + t) * 128 + dv] = po[t];
#pragma unroll
      for (int kk = 0; kk < 16; ++kk) { const int k = kq * 16 + kk; float sn = __expf(LA[7 * 64 + k]) * s0[kk];
#pragma unroll
          for (int t = 0; t < 8; ++t) sn += KH_[t * 64 + k] * VS_[t * 128 + dv];
          snp[(size_t)kk * GDV] = sn; } }
    __syncthreads();
    { const int t = tid >> 6, j = tid & 63; float ov[2]; float ss = 0.f;
#pragma unroll
      for (int i = 0; i < 2; ++i) { const int dv = j + 64 * i; float o = RED[(0 * 8 + t) * 128 + dv] + RED[(1 * 8 + t) * 128 + dv] + RED[(2 * 8 + t) * 128 + dv] + RED[(3 * 8 + t) * 128 + dv];
          for (int s = 0; s <= t; ++s) o += AI[t * 8 + s] * VS_[s * 128 + dv];
          ov[i] = o; ss += o * o; }
      const float rstd = rsq(wave_sum(ss) * (1.f / GDV) + EPS); const size_t row = (size_t)(row0 + t);
#pragma unroll
      for (int i = 0; i < 2; ++i) { const int dv = j + 64 * i; const float g = bf2f(F.Z[row * ZP + ZC_GG + h * 128 + dv]);
          F.MIX[row * DM + 512 + h * 128 + dv] = (bf16)f2bf(ov[i] * rstd * F.g_on[dv] * siluf(g)); } }
    __syncthreads();
}

constexpr int AT_KSLOT = 12288, AT_VSLOT = 8192, AT_V0 = 4 * AT_KSLOT, AT_WSF = AT_V0 + 3 * AT_VSLOT, AT_OST = AT_WSF + NWAVES * 256, AT_END = AT_OST + NWAVES * 4096;
static_assert(AT_END <= RING_BYTES, "attention LDS");
__device__ __forceinline__ float max16(const f32x16& p) {
    float a = fmaxf(fmaxf(p[0], p[1]), fmaxf(p[2], p[3])), b = fmaxf(fmaxf(p[4], p[5]), fmaxf(p[6], p[7]));
    float c = fmaxf(fmaxf(p[8], p[9]), fmaxf(p[10], p[11])), d = fmaxf(fmaxf(p[12], p[13]), fmaxf(p[14], p[15]));
    return fmaxf(fmaxf(a, b), fmaxf(c, d));
}
__device__ __forceinline__ bf16x8 pack_p(const f32x16& p, int base) {
    v4u w; w.x = pk2(p[base + 0], p[base + 1]); w.y = pk2(p[base + 2], p[base + 3]); w.z = pk2(p[base + 4], p[base + 5]); w.w = pk2(p[base + 6], p[base + 7]); return __builtin_bit_cast(bf16x8, w);
}
#ifndef AT_STHR
#define AT_STHR 1024.0f
#endif
#define AT_SBAR() __builtin_amdgcn_sched_barrier(0)
#define AT_PIN(x) asm volatile("" : "+v"(x))
#define AT_MFMA(a, b, c) __builtin_amdgcn_mfma_f32_32x32x16_bf16(a, b, c, 0, 0, 0)
#define AT_WAIT_BAR(N) asm volatile("s_waitcnt vmcnt(" #N ") lgkmcnt(0)\n\ts_barrier" ::: "memory")
__device__ __forceinline__ void at_glds16(const char* sbase, unsigned voff, unsigned lds_base) {
    unsigned sv; asm volatile("s_mov_b32 %0, m0\n\ts_mov_b32 m0, %3\n\ts_nop 0\n\tglobal_load_lds_dwordx4 %1, %2\n\ts_mov_b32 m0, %0" : "=&s"(sv) : "v"(voff), "s"(sbase), "s"(lds_base) : "memory"); }
__device__ __forceinline__ void at_kload2(bf16x8* kf, LAS const unsigned char* kp, int d0) { kf[2 * d0] = *(const LAS bf16x8*)(kp + d0 * 2048); kf[2 * d0 + 1] = *(const LAS bf16x8*)(kp + d0 * 2048 + 512); }
#define AT_MX3(a, b, c) __builtin_fmaxf(__builtin_fmaxf((a), (b)), (c))
__device__ __forceinline__ float at_rowmax(const f32x16& p0, const f32x16& p1) {
    float a = AT_MX3(p0[0], p0[1], p1[0]), b = AT_MX3(p0[2], p0[3], p1[1]); a = AT_MX3(a, p1[2], p1[3]);
#pragma unroll
    for (int r = 4; r < 16; r += 4) { a = AT_MX3(a, p0[r], p0[r + 1]); b = AT_MX3(b, p0[r + 2], p0[r + 3]); a = AT_MX3(a, p1[r], p1[r + 1]); b = AT_MX3(b, p1[r + 2], p1[r + 3]); }
    float m = __builtin_fmaxf(a, b); auto rr = __builtin_amdgcn_permlane32_swap(__float_as_uint(m), __float_as_uint(m), false, false);
    return __builtin_fmaxf(__uint_as_float(rr[0]), __uint_as_float(rr[1])); }
__device__ __forceinline__ void at_cmask(f32x16& p0, f32x16& p1, int jb, int qrel, int hi) {
    const int d_ = qrel - 64 * jb - 4 * hi;
#pragma unroll
    for (int i = 0; i < 16; ++i) { if ((i & 3) + 8 * (i >> 2) > d_) p0[i] = -INFINITY; if ((i & 3) + 8 * (i >> 2) + 32 > d_) p1[i] = -INFINITY; } }
__device__ __forceinline__ void attn_prompt_unit(Frame& F, const int b, const int h, const int qb) {
    int ln_; FRESH_LANE_ID(ln_);
    const int lane = ln_, w = F.wave, r32 = lane & 31, hi = lane >> 5;
    const size_t R0 = (size_t)b * SEQ; const int q0 = qb * 256;
    LAS unsigned char* const lds = F.lds; const unsigned lds0 = (unsigned)(size_t)lds;
    LAS float* wsf = (LAS float*)(lds + AT_WSF) + w * 64;
    const int NT = 4 * (qb + 1);
    const char* const qbase = (const char*)(F.QP + (R0 + q0) * 768);
    const unsigned qoff = (unsigned)((32 * w + r32) * 768 + 8 * hi) * 2u;
    bf16x8 qr[6];
#pragma unroll
    for (int d0 = 0; d0 < 4; ++d0) qr[d0] = *(const GAS bf16x8*)(qbase + (qoff + (unsigned)(h * 64 + 16 * d0) * 2u));
#pragma unroll
    for (int d0 = 4; d0 < 6; ++d0) qr[d0] = *(const GAS bf16x8*)(qbase + (qoff + (unsigned)(512 + h * 32 + 16 * (d0 - 4)) * 2u));
    const char* const kbase = (const char*)(F.KN + R0 * 512 + h * 64);
    const char* const rbase = (const char*)(F.KR + R0 * 32);
    const char* const vbase = (const char*)(F.VV + R0 * 512 + h * 64);
    const unsigned koff = (unsigned)(lane * 512 + w * 8) * 2u, roff = (unsigned)(lane * 32 + (w & 3) * 8) * 2u;
    const unsigned voff = (unsigned)((16 * (w & 3) + (lane >> 2)) * 512 + (w >> 2) * 32 + (lane & 3) * 8) * 2u;
    const unsigned kdst = lds0 + w * 1024, rdst = lds0 + (8 + (w & 3)) * 1024, vdst = lds0 + AT_V0 + w * 1024;
#define AT_DMA_K(t, slot) do { at_glds16(kbase + (size_t)(t) * 65536u, koff, (unsigned)__builtin_amdgcn_readfirstlane(kdst + (slot) * AT_KSLOT)); \
                               at_glds16(rbase + (size_t)(t) * 4096u, roff, (unsigned)__builtin_amdgcn_readfirstlane(rdst + (slot) * AT_KSLOT)); } while (0)
#define AT_DMA_V(t, slot) at_glds16(vbase + (size_t)(t) * 65536u, voff, (unsigned)__builtin_amdgcn_readfirstlane(vdst + (slot) * AT_VSLOT))
    LAS const unsigned char* const vp0 = lds + AT_V0 + ((lane >> 4) & 1) * 32 + (lane & 3) * 8 + (4 * hi + ((lane & 15) >> 2)) * 64;
    LAS const unsigned char* const kp0 = lds + hi * 1024 + r32 * 16;
    AT_DMA_K(0, 0); AT_DMA_V(0, 0); AT_DMA_K(1, 1); AT_DMA_K(2, 2);
    float nm, l_reg = 0.f, slast = 0.f; f32x16 o[2]; o[0] = f32x16{}; o[1] = f32x16{};
    f32x16 negm;
    const int qrel = w * 32 + r32; bool resc = false;
    f32x16 pA0, pA1, pB0, pB1; bf16x8 kf[12]; s16x4 vlo[8], vhi[8]; v4u pw0, pw1, pw2, pw3;
    int vs_prev = 0, vs_cur = 0, vs_next = 1;
#define AT_ROT() do { vs_prev = vs_cur; vs_cur = vs_next; vs_next = (vs_next == 2) ? 0 : vs_next + 1; } while (0)
#define AT_EX(v) __builtin_amdgcn_exp2f(v)
#define AT_RESC() do { if (resc) { _Pragma("unroll") for (int d_ = 0; d_ < 2; ++d_) _Pragma("unroll") for (int r = 0; r < 16; ++r) o[d_][r] *= wsf[crow(r, hi)]; } } while (0)
    AT_WAIT_BAR(5);
    { const f32x16 z = f32x16{};
      at_kload2(kf, kp0, 0); pA0 = AT_MFMA(kf[0], qr[0], z); pA1 = AT_MFMA(kf[1], qr[0], z);
#pragma unroll
      for (int d0 = 1; d0 < 6; ++d0) { at_kload2(kf, kp0, d0); pA0 = AT_MFMA(kf[2 * d0], qr[d0], pA0); pA1 = AT_MFMA(kf[2 * d0 + 1], qr[d0], pA1); } }
    if (NT == 4) at_cmask(pA0, pA1, 0, qrel, hi);
    { const float rm = at_rowmax(pA0, pA1); nm = -rm;
#pragma unroll
      for (int r = 0; r < 16; ++r) { pA0[r] = AT_EX(pA0[r] + nm); pA1[r] = AT_EX(pA1[r] + nm); negm[r] = nm; } }
    AT_PIN(negm);
    AT_WAIT_BAR(0);
    AT_DMA_K(3, 3); AT_DMA_V(1, 1); AT_ROT();
    at_kload2(kf, kp0 + AT_KSLOT, 0); at_kload2(kf, kp0 + AT_KSLOT, 1);
#define AT_PKW(P, i) pk2(P[i], P[i + 1])
#define AT_PAF(k) __builtin_bit_cast(bf16x8, pw##k)
#define AT_VFR(i) (bf16x8){vlo[i][0], vlo[i][1], vlo[i][2], vlo[i][3], vhi[i][0], vhi[i][1], vhi[i][2], vhi[i][3]}
#define AT_VRD(i) do { vlo[i] = tr_read(vp_ + (((i) >> 2) * 4096 + ((i) & 3) * 1024)); vhi[i] = tr_read(vp_ + (((i) >> 2) * 4096 + ((i) & 3) * 1024 + 512)); } while (0)
#define AT_KJ(d0) at_kload2(kf, kp_, d0)
#define AT_KRD(G, d0) do { if (G) { at_kload2(kf, kn_, d0); } } while (0)
#define AT_GAPM(MF, RD) do { MF; RD; AT_SBAR(); } while (0)
#define AT_GAPB(MF, RD, X, i) do { MF; RD; X[i] = AT_EX(X[i]); X[i + 1] = AT_EX(X[i + 1]); X[i + 2] = AT_EX(X[i + 2]); X[i + 3] = AT_EX(X[i + 3]); AT_PIN(X); AT_SBAR(); } while (0)
#define AT_STEP(C0, C1, P0, P1, t, MASK, GK, GV, GL) do { AT_SBAR(); \
    LAS const unsigned char* const vp_ = vp0 + vs_prev * AT_VSLOT; LAS const unsigned char* const kp_ = kp0 + ((t) & 3) * AT_KSLOT; LAS const unsigned char* const kn_ = kp0 + (((t) + 1) & 3) * AT_KSLOT; \
    float sacc = P0[0] + P0[1]; \
    C0 = AT_MFMA(kf[0], qr[0], negm); AT_KJ(2); float smrg = slast + xor32(slast, hi != 0); sacc += P0[2]; sacc += P0[3]; pw0[0] = pk2(P0[0], P0[1]); AT_PIN(pw0); AT_PIN(smrg); AT_PIN(sacc); AT_SBAR(); \
    C1 = AT_MFMA(kf[1], qr[0], negm); (void)0; sacc += P0[4]; sacc += P0[5]; sacc += P0[6]; pw0[1] = pk2(P0[2], P0[3]); AT_PIN(pw0); AT_PIN(sacc); AT_SBAR(); \
    C0 = AT_MFMA(kf[2], qr[1], C0); AT_KJ(3); sacc += P0[7]; sacc += P0[8]; sacc += P0[9]; pw0[2] = pk2(P0[4], P0[5]); AT_PIN(pw0); AT_PIN(sacc); AT_SBAR(); \
    C1 = AT_MFMA(kf[3], qr[1], C1); (void)0; sacc += P0[10]; sacc += P0[11]; sacc += P0[12]; pw0[3] = pk2(P0[6], P0[7]); AT_PIN(pw0); AT_PIN(sacc); AT_SBAR(); \
    C0 = AT_MFMA(kf[4], qr[2], C0); AT_KJ(4); sacc += P0[13]; sacc += P0[14]; sacc += P0[15]; pw1[0] = pk2(P0[8], P0[9]); AT_PIN(pw1); AT_PIN(sacc); AT_SBAR(); \
    C1 = AT_MFMA(kf[5], qr[2], C1); (void)0; sacc += P1[0]; sacc += P1[1]; sacc += P1[2]; pw1[1] = pk2(P0[10], P0[11]); AT_PIN(pw1); AT_PIN(sacc); AT_SBAR(); \
    C0 = AT_MFMA(kf[6], qr[3], C0); AT_KJ(5); sacc += P1[3]; sacc += P1[4]; sacc += P1[5]; pw1[2] = pk2(P0[12], P0[13]); AT_PIN(pw1); AT_PIN(sacc); AT_SBAR(); \
    C1 = AT_MFMA(kf[7], qr[3], C1); (void)0; sacc += P1[6]; sacc += P1[7]; sacc += P1[8]; pw1[3] = pk2(P0[14], P0[15]); AT_PIN(pw1); AT_PIN(sacc); AT_SBAR(); \
    C0 = AT_MFMA(kf[8], qr[4], C0); AT_VRD(0); sacc += P1[9]; sacc += P1[10]; pw2[0] = pk2(P1[0], P1[1]); pw2[1] = pk2(P1[2], P1[3]); AT_PIN(pw2); AT_PIN(sacc); AT_SBAR(); \
    C1 = AT_MFMA(kf[9], qr[4], C1); AT_VRD(4); sacc += P1[11]; sacc += P1[12]; pw2[2] = pk2(P1[4], P1[5]); pw2[3] = pk2(P1[6], P1[7]); AT_PIN(pw2); AT_PIN(sacc); AT_SBAR(); \
    C0 = AT_MFMA(kf[10], qr[5], C0); AT_VRD(1); sacc += P1[13]; sacc += P1[14]; pw3[0] = pk2(P1[8], P1[9]); pw3[1] = pk2(P1[10], P1[11]); AT_PIN(pw3); AT_PIN(sacc); AT_SBAR(); \
    C1 = AT_MFMA(kf[11], qr[5], C1); AT_VRD(5); sacc += P1[15]; pw3[2] = pk2(P1[12], P1[13]); pw3[3] = pk2(P1[14], P1[15]); AT_PIN(pw3); AT_PIN(sacc); AT_SBAR(); \
    l_reg += sacc; \
    if (GK) AT_DMA_K((t) + 3, ((t) + 3) & 3); if (GV) AT_DMA_V((t) + 1, vs_next); \
    if (MASK) at_cmask(C0, C1, (t) - (NT - 4), qrel, hi); \
    resc = false; slast = sacc;                                                                                            \
    if (__builtin_expect(__any(smrg > AT_STHR), 0)) { const float dl = __builtin_fmaxf(__builtin_amdgcn_logf(smrg), 0.f); nm -= dl;     \
        const float f = __builtin_amdgcn_exp2f(-dl); l_reg *= f; slast *= f; if (hi == 0) wsf[r32] = f; resc = true; \
        _Pragma("unroll") for (int r = 0; r < 16; ++r) { C0[r] -= dl; C1[r] -= dl; negm[r] = nm; } } \
    AT_PIN(negm); AT_SBAR(); \
    AT_GAPB(o[0] = AT_MFMA(AT_PAF(0), AT_VFR(0), o[0]), AT_VRD(2), C0, 0); \
    AT_GAPB(o[1] = AT_MFMA(AT_PAF(0), AT_VFR(4), o[1]), AT_VRD(6), C0, 4); \
    AT_GAPB(o[0] = AT_MFMA(AT_PAF(1), AT_VFR(1), o[0]), AT_VRD(3), C0, 8); \
    AT_GAPB(o[1] = AT_MFMA(AT_PAF(1), AT_VFR(5), o[1]), AT_VRD(7), C0, 12); \
    AT_GAPB(o[0] = AT_MFMA(AT_PAF(2), AT_VFR(2), o[0]), AT_KRD(GL, 0), C1, 0); \
    AT_GAPB(o[1] = AT_MFMA(AT_PAF(2), AT_VFR(6), o[1]), AT_KRD(GL, 1), C1, 4); \
    AT_GAPB(o[0] = AT_MFMA(AT_PAF(3), AT_VFR(3), o[0]), (void)0, C1, 8); \
    AT_GAPB(o[1] = AT_MFMA(AT_PAF(3), AT_VFR(7), o[1]), (void)0, C1, 12); \
    } while (0)
    int t = 1;
    for (; t + 5 < NT; t += 2) {
        AT_STEP(pB0, pB1, pA0, pA1, t, false, true, true, true);     AT_WAIT_BAR(3); AT_RESC(); AT_ROT();
        AT_STEP(pA0, pA1, pB0, pB1, t + 1, false, true, true, true); AT_WAIT_BAR(3); AT_RESC(); AT_ROT();
    }
#define AT_ENDW(tt) do { if ((tt) + 3 < NT) { AT_WAIT_BAR(3); } else if ((tt) + 2 < NT) { AT_WAIT_BAR(1); } else { AT_WAIT_BAR(0); } } while (0)
    for (; t + 1 < NT; t += 2) {
        AT_STEP(pB0, pB1, pA0, pA1, t, true, (t + 3 < NT), (t + 1 < NT), (t + 1 < NT));         AT_ENDW(t);     AT_RESC(); AT_ROT();
        AT_STEP(pA0, pA1, pB0, pB1, t + 1, true, (t + 4 < NT), (t + 2 < NT), (t + 2 < NT));     AT_ENDW(t + 1); AT_RESC(); AT_ROT();
    }
    AT_STEP(pB0, pB1, pA0, pA1, NT - 1, true, false, false, false); AT_RESC();
    { float sacc = pB0[0] + pB0[1];
#pragma unroll
      for (int r = 2; r < 16; ++r) sacc += pB0[r];
#pragma unroll
      for (int r = 0; r < 16; ++r) sacc += pB1[r];
      l_reg += sacc;
      pw0 = (v4u){AT_PKW(pB0, 0), AT_PKW(pB0, 2), AT_PKW(pB0, 4), AT_PKW(pB0, 6)}; pw1 = (v4u){AT_PKW(pB0, 8), AT_PKW(pB0, 10), AT_PKW(pB0, 12), AT_PKW(pB0, 14)};
      pw2 = (v4u){AT_PKW(pB1, 0), AT_PKW(pB1, 2), AT_PKW(pB1, 4), AT_PKW(pB1, 6)}; pw3 = (v4u){AT_PKW(pB1, 8), AT_PKW(pB1, 10), AT_PKW(pB1, 12), AT_PKW(pB1, 14)};
      LAS const unsigned char* const vp_ = vp0 + vs_cur * AT_VSLOT; _Pragma("unroll") for (int i = 0; i < 8; ++i) AT_VRD(i);
      o[0] = AT_MFMA(AT_PAF(0), AT_VFR(0), o[0]); o[1] = AT_MFMA(AT_PAF(0), AT_VFR(4), o[1]); o[0] = AT_MFMA(AT_PAF(1), AT_VFR(1), o[0]); o[1] = AT_MFMA(AT_PAF(1), AT_VFR(5), o[1]);
      o[0] = AT_MFMA(AT_PAF(2), AT_VFR(2), o[0]); o[1] = AT_MFMA(AT_PAF(2), AT_VFR(6), o[1]); o[0] = AT_MFMA(AT_PAF(3), AT_VFR(3), o[0]); o[1] = AT_MFMA(AT_PAF(3), AT_VFR(7), o[1]); }
#undef AT_KJ
#undef AT_DMA_K
#undef AT_DMA_V
#undef AT_ROT
#undef AT_EX
#undef AT_RESC
#undef AT_PKW
#undef AT_PAF
#undef AT_VFR
#undef AT_VRD
#undef AT_KRD
#undef AT_ENDW
#undef AT_GAPM
#undef AT_GAPB
#undef AT_STEP
    float l = l_reg; l += xor32(l, hi != 0);
    if (hi == 0) wsf[32 + r32] = l;
    LAS bf16* stg = (LAS bf16*)(lds + AT_OST) + w * 2048;
#pragma unroll
    for (int i = 0; i < 16; ++i) { const int orow = crow(i, hi); const float rl = __builtin_amdgcn_rcpf(wsf[32 + orow]);
        stg[orow * 64 + r32] = (bf16)f2bf(o[0][i] * rl); stg[orow * 64 + 32 + r32] = (bf16)f2bf(o[1][i] * rl); }
#pragma unroll
    for (int i = 0; i < 4; ++i) { const int row = i * 8 + (lane >> 3), c8 = lane & 7; const unsigned lrow = (unsigned)(32 * w + row);
        const char* const gbase = (const char*)(F.Z + (R0 + q0) * ZP + ZC_GM + h * 64); char* const mbase = (char*)(F.MIX + (R0 + q0) * DM + h * 64);
        float ov[8], g[8]; unpack8(*(const LAS v4u*)(stg + row * 64 + c8 * 8), ov); unpack8(*(const GAS v4u*)(gbase + (lrow * (unsigned)ZP + c8 * 8) * 2u), g);
        v4u ovv; ovv.x = pk2(ov[0] * siluf(g[0]), ov[1] * siluf(g[1])); ovv.y = pk2(ov[2] * siluf(g[2]), ov[3] * siluf(g[3])); ovv.z = pk2(ov[4] * siluf(g[4]), ov[5] * siluf(g[5])); ovv.w = pk2(ov[6] * siluf(g[6]), ov[7] * siluf(g[7]));
        *(GAS v4u*)(mbase + (lrow * (unsigned)DM + c8 * 8) * 2u) = ovv; }
    __syncthreads();
}

constexpr int DC_RCH = 2064, DC_RI = 32768, DC_BUF = DC_RI + 4 * DC_RCH + 192, DC_WSF = 2 * DC_BUF, DC_END = DC_WSF + NWAVES * 256;
static_assert(DC_BUF % 256 == 0 && DC_END <= RING_BYTES, "decode LDS");
__device__ __forceinline__ void decode_unit(Frame& F, const int b, const int sp) {
    int ln_; FRESH_LANE_ID(ln_);
    const int lane = ln_, w = F.wave, tid = w * 64 + lane, r32 = lane & 31, hi = lane >> 5, rh = w & 1, kg = w >> 1;
    LAS unsigned char* const lds = F.lds;
    LAS float* wsf = (LAS float*)(lds + DC_WSF) + w * 64;
    const int qi = 32 * rh + r32, tq = qi >> 3, hq = qi & 7;
    const bf16* qrow = F.QS + (size_t)(b * DECT + tq) * 1280;
    bf16x8 qf[10];
#pragma unroll
    for (int d0 = 0; d0 < 8; ++d0) qf[d0] = *(const GAS bf16x8*)(qrow + hq * 128 + 16 * d0 + 8 * hi);
#pragma unroll
    for (int d0 = 8; d0 < 10; ++d0) qf[d0] = *(const GAS bf16x8*)(qrow + 1024 + hq * 32 + 16 * (d0 - 8) + 8 * hi);
    const int* pt = F.page_table + b * NPAGES + sp * (NPAGES / DSPLIT);
    f32x4 cr[8], kr[2];
#define DC_LOAD(j) do { const size_t pg_ = (size_t)pt[j]; const GAS f32x4* c_ = (const GAS f32x4*)(F.cache_ckv + pg_ * (PAGE * KVL)) + tid; const GAS f32x4* k_ = (const GAS f32x4*)(F.cache_kr + pg_ * (PAGE * QR)) + tid; \
        _Pragma("unroll") for (int i_ = 0; i_ < 8; ++i_) cr[i_] = __builtin_nontemporal_load(c_ + 512 * i_); kr[0] = __builtin_nontemporal_load(k_); kr[1] = __builtin_nontemporal_load(k_ + 512); } while (0)
    const int skb = tid >> 5, sc4 = tid & 31, sch = sc4 >> 1;
    const int st_c = 2048 * (skb >> 3) + 512 * (sch >> 2) + 64 * (skb & 7) + 16 * ((sch & 3) ^ ((skb >> 2) & 3)) + 8 * (sc4 & 1);
    const int st_r = DC_RI + ((tid & 7) >> 1) * DC_RCH + (tid >> 3) * 16 + (tid & 1) * 8;
    const int kr_b = 8192 * kg + 2048 * (r32 >> 3) + 64 * (r32 & 7);
    const int kr_e = kr_b + 16 * (hi ^ ((r32 >> 2) & 3)), kr_o = kr_b + 16 * ((2 + hi) ^ ((r32 >> 2) & 3));
    const int kr_r = DC_RI + hi * DC_RCH + (32 * kg + r32) * 16;
    const int vq = (lane & 15) >> 2, vp = lane & 3, vC = 2 * ((lane >> 4) & 1) + (vp >> 1);
    const int vr_b = 8192 * kg + 64 * (4 * hi + vq) + 8 * (vp & 1);
    const int vr_lo = vr_b + 16 * (vC ^ hi), vr_hi = vr_b + 2048 + 16 * (vC ^ (2 + hi));
#define DC_STORE(buf) do { LAS unsigned char* ib_ = lds + (buf) * DC_BUF; \
        _Pragma("unroll") for (int i = 0; i < 8; ++i) { const v2u wv = {pk2(cr[i].x, cr[i].y), pk2(cr[i].z, cr[i].w)}; *(LAS v2u*)(ib_ + st_c + 4096 * i) = wv; } \
        _Pragma("unroll") for (int i = 0; i < 2; ++i) { const v2u wv = {pk2(kr[i].x, kr[i].y), pk2(kr[i].z, kr[i].w)}; *(LAS v2u*)(ib_ + st_r + 1024 * i) = wv; } } while (0)
#define DC_COMPUTE(buf) do { LAS const unsigned char* ib_ = lds + (buf) * DC_BUF; \
        bf16x8 kf[10]; \
        _Pragma("unroll") for (int d0 = 0; d0 < 8; ++d0) kf[d0] = *(const LAS bf16x8*)(ib_ + ((d0 & 1) ? kr_o : kr_e) + 512 * (d0 >> 1)); \
        kf[8] = *(const LAS bf16x8*)(ib_ + kr_r); kf[9] = *(const LAS bf16x8*)(ib_ + kr_r + 2 * DC_RCH); \
        __builtin_amdgcn_sched_barrier(0); \
        f32x16 p = {}; \
        _Pragma("unroll") for (int d0 = 0; d0 < 10; ++d0) p = __builtin_amdgcn_mfma_f32_32x32x16_bf16(kf[d0], qf[d0], p, 0, 0, 0); \
        float rm = max16(p); rm = fmaxf(rm, xor32(rm, hi != 0)); \
        const float mn = fmaxf(m, rm); \
        if (__any(mn > m)) { const float al = fast_exp2(m - mn); l *= al; if (hi == 0) wsf[r32] = al; \
            _Pragma("unroll") for (int i = 0; i < 16; ++i) { const float f = wsf[crow(i, hi)]; o[0][i] *= f; o[1][i] *= f; o[2][i] *= f; o[3][i] *= f; } } \
        m = mn; \
        float ls = 0.f; \
        _Pragma("unroll") for (int i = 0; i < 16; ++i) { p[i] = fast_exp2(p[i] - m); ls += p[i]; } \
        l += ls; \
        const bf16x8 pa0 = pack_p(p, 0), pa1 = pack_p(p, 8); \
        _Pragma("unroll") for (int cb = 0; cb < 4; ++cb) \
            _Pragma("unroll") for (int ks2 = 0; ks2 < 2; ++ks2) { const s16x4 lo = tr_read(ib_ + vr_lo + 4096 * ks2 + 512 * cb), hi4 = tr_read(ib_ + vr_hi + 4096 * ks2 + 512 * cb); \
                o[cb] = __builtin_amdgcn_mfma_f32_32x32x16_bf16(ks2 == 0 ? pa0 : pa1, (bf16x8){lo[0], lo[1], lo[2], lo[3], hi4[0], hi4[1], hi4[2], hi4[3]}, o[cb], 0, 0, 0); } } while (0)
#define DC_LBAR() asm volatile("s_waitcnt lgkmcnt(0)\n\ts_barrier" ::: "memory")
    f32x16 o[4]; o[0] = f32x16{}; o[1] = f32x16{}; o[2] = f32x16{}; o[3] = f32x16{};
    float m = -1e30f, l = 0.f;
    constexpr int NPG = NPAGES / DSPLIT;
    DC_LOAD(0); DC_STORE(0); DC_LOAD(1);
    DC_LBAR();
    for (int j = 0; j < NPG; ++j) {
        const int cur = j & 1;
        if (w >= 4 && j + 1 < NPG) { DC_STORE(cur ^ 1); if (j + 2 < NPG) DC_LOAD(j + 2); }
        DC_COMPUTE(cur);
        if (w < 4 && j + 1 < NPG) { DC_STORE(cur ^ 1); if (j + 2 < NPG) DC_LOAD(j + 2); }
        DC_LBAR();
    }
#undef DC_LOAD
#undef DC_STORE
#undef DC_COMPUTE
#undef DC_LBAR
    l += xor32(l, hi != 0);
    const int part = sp * 4 + kg;
    float* pp = F.PART + ((size_t)(b * DPART + part) * 64 + 32 * rh) * 128 + r32;
#pragma unroll
    for (int cb = 0; cb < 4; ++cb)
#pragma unroll
        for (int i = 0; i < 16; ++i) pp[(size_t)crow(i, hi) * 128 + 32 * cb] = o[cb][i];
    if (hi == 0) { float* ml = F.ML + ((size_t)(b * DPART + part) * 64 + 32 * rh + r32) * 2; ml[0] = m; ml[1] = l; }
}

__device__ __forceinline__ void decode_combine_unit(Frame& F, const int b) {
    int ln_; FRESH_LANE_ID(ln_);
    const int tid = F.wave * 64 + ln_, i = tid >> 3, part = tid & 7, t = i >> 3, h = i & 7;
    LAS float* SC = (LAS float*)F.lds;
    LAS float* OL = SC + 512;
    const bf16* qrow = F.QS + (size_t)(b * DECT + t) * 1280;
    { float s = -INFINITY;
      if (part <= t) { const float* ck = F.out + O_CKVS + (size_t)(b * DECT + part) * KVL; const float* kr = F.out + O_KRS + (size_t)(b * DECT + part) * QR; float a = 0.f;
          for (int c = 0; c < 128; c += 8) { float q8[8]; unpack8(*(const GAS v4u*)(qrow + h * 128 + c), q8);
#pragma unroll
              for (int e = 0; e < 8; ++e) a += q8[e] * ck[c + e]; }
          for (int c = 0; c < 32; c += 8) { float q8[8]; unpack8(*(const GAS v4u*)(qrow + 1024 + h * 32 + c), q8);
#pragma unroll
              for (int e = 0; e < 8; ++e) a += q8[e] * kr[c + e]; }
          s = a; }
      SC[i * 8 + part] = s; }
    __syncthreads();
    float M = -1e30f; float mp[DPART], lp[DPART], sj[8];
#pragma unroll
    for (int p = 0; p < DPART; ++p) { const float* ml = F.ML + ((size_t)(b * DPART + p) * 64 + i) * 2; mp[p] = ml[0]; lp[p] = ml[1]; M = fmaxf(M, mp[p]); }
#pragma unroll
    for (int j = 0; j < 8; ++j) { sj[j] = SC[i * 8 + j]; M = fmaxf(M, sj[j]); }
    float L = 0.f;
#pragma unroll
    for (int p = 0; p < DPART; ++p) { mp[p] = fast_exp2(mp[p] - M); L += mp[p] * lp[p]; }
#pragma unroll
    for (int j = 0; j < 8; ++j) { sj[j] = fast_exp2(sj[j] - M); L += sj[j]; }
    { float acc[16];
#pragma unroll
      for (int e = 0; e < 16; ++e) acc[e] = 0.f;
#pragma unroll
      for (int p = 0; p < DPART; ++p) { const GAS f32x4* src = (const GAS f32x4*)(F.PART + ((size_t)(b * DPART + p) * 64 + i) * 128 + part * 16);
#pragma unroll
          for (int v = 0; v < 4; ++v) { const f32x4 x = src[v]; acc[4 * v] += mp[p] * x.x; acc[4 * v + 1] += mp[p] * x.y; acc[4 * v + 2] += mp[p] * x.z; acc[4 * v + 3] += mp[p] * x.w; } }
#pragma unroll
      for (int j = 0; j < 8; ++j) { const GAS f32x4* src = (const GAS f32x4*)(F.out + O_CKVS + (size_t)(b * DECT + j) * KVL + part * 16);
#pragma unroll
          for (int v = 0; v < 4; ++v) { const f32x4 x = src[v]; acc[4 * v] += sj[j] * x.x; acc[4 * v + 1] += sj[j] * x.y; acc[4 * v + 2] += sj[j] * x.z; acc[4 * v + 3] += sj[j] * x.w; } }
      const float rl = __builtin_amdgcn_rcpf(L);
#pragma unroll
      for (int e = 0; e < 16; ++e) OL[i * 128 + part * 16 + e] = acc[e] * rl; }
    __syncthreads();
    { float od[8];
#pragma unroll
      for (int e = 0; e < 8; ++e) od[e] = 0.f;
      const float* wv = F.w_uv + h * 64 + part * 8;
#pragma unroll 16
      for (int c = 0; c < 128; ++c) { const float x = OL[i * 128 + c]; const f32x4 w0 = *(const GAS f32x4*)(wv + (size_t)c * 512), w1 = *(const GAS f32x4*)(wv + (size_t)c * 512 + 4);
          od[0] += x * w0.x; od[1] += x * w0.y; od[2] += x * w0.z; od[3] += x * w0.w; od[4] += x * w1.x; od[5] += x * w1.y; od[6] += x * w1.z; od[7] += x * w1.w; }
      const size_t row = (size_t)(MP + b * DECT + t); float g[8]; unpack8(*(const GAS v4u*)(F.Z + row * ZP + ZC_GM + h * 64 + part * 8), g);
      v4u o; o.x = pk2(od[0] * siluf(g[0]), od[1] * siluf(g[1])); o.y = pk2(od[2] * siluf(g[2]), od[3] * siluf(g[3])); o.z = pk2(od[4] * siluf(g[4]), od[5] * siluf(g[5])); o.w = pk2(od[6] * siluf(g[6]), od[7] * siluf(g[7]));
      *(GAS v4u*)(F.MIX + row * DM + h * 64 + part * 8) = o; }
    __syncthreads();
}


namespace pg8 {
struct EpiOut {
    static constexpr bool PERM = true;
    const bf16_t* XB; bf16_t* H1B;
    __device__ __forceinline__ void operator()(const f32x4 (&acc)[2][2][4][2], const Unit& u, int wr, int wc, int, int) const {
        int ln_; FRESH_LANE_ID(ln_); const int fr = ln_ & 15, fq = ln_ >> 4;
        const char* xb = (const char*)(XB + (size_t)u.pm * BM * DM + u.pn * BM);
        char* hb = (char*)(H1B + (size_t)u.pm * BM * DM + u.pn * BM);
        const unsigned lo = (unsigned)((wr * 64 + fr) * DM + wc * 32 + 8 * fq);
#pragma unroll
        for (int ai = 0; ai < 2; ++ai) {
            u32x4 xv[4][2];
#pragma unroll
            for (int m = 0; m < 4; ++m)
#pragma unroll
                for (int bj = 0; bj < 2; ++bj) xv[m][bj] = *(const u32x4*)(xb + (lo + (unsigned)((ai * HALF + m * 16) * DM + bj * HALF)) * 2u);
#pragma unroll
            for (int m = 0; m < 4; ++m)
#pragma unroll
                for (int bj = 0; bj < 2; ++bj) { const u32x4 w = xv[m][bj];
                    const f32x4 x0 = {bflo(w.x), bfhi(w.x), bflo(w.y), bfhi(w.y)}, x1 = {bflo(w.z), bfhi(w.z), bflo(w.w), bfhi(w.w)};
                    *(u32x4*)(hb + (lo + (unsigned)((ai * HALF + m * 16) * DM + bj * HALF)) * 2u) = pack8(acc[ai][bj][m][0] + x0, acc[ai][bj][m][1] + x1); }
            asm volatile("" ::: "memory"); }
    }
};
__device__ __forceinline__ void norm_wait(unsigned* cnt, unsigned want, unsigned* tmo) {
    asm volatile("s_waitcnt vmcnt(0)" ::: "memory");
    unsigned ln; FRESH_LANE_ID(ln);
    if (ln == 0) __hip_atomic_fetch_add(cnt, 1u, __ATOMIC_RELAXED, __HIP_MEMORY_SCOPE_AGENT);
    unsigned spins = 0;
    while ((unsigned)__builtin_amdgcn_readfirstlane(__hip_atomic_load(cnt, __ATOMIC_RELAXED, __HIP_MEMORY_SCOPE_AGENT)) < want) {
        __builtin_amdgcn_s_sleep(2);
        if (++spins > (1u << 20)) { if (ln == 0) __hip_atomic_store(tmo, 1u, __ATOMIC_RELAXED, __HIP_MEMORY_SCOPE_AGENT); break; } }
}
struct EpiPle {
    static constexpr bool PERM = true;
    const bf16_t* H1B; const bf16_t* PPb; float* ssq; float* Yout; const float* g_fin; unsigned* ctl;
    __device__ __forceinline__ void operator()(f32x4 (&acc)[2][2][4][2], const Unit& u, int wr, int wc, int, int) const {
        int ln_; FRESH_LANE_ID(ln_); const int fr = ln_ & 15, fq = ln_ >> 4;
        const int col0 = u.pn * BM + wc * 32 + 8 * fq;
#pragma unroll
        for (int ai = 0; ai < 2; ++ai)
#pragma unroll
            for (int m = 0; m < 4; ++m) { const int row = u.pm * BM + ai * HALF + wr * 64 + m * 16 + fr; const size_t off = (size_t)row * DM + col0; float s = 0.f;
#pragma unroll
                for (int bj = 0; bj < 2; ++bj) { const u32x4 hw = *(const u32x4*)(H1B + off + bj * HALF), pw = *(const u32x4*)(PPb + off + bj * HALF);
#pragma unroll
                    for (int n = 0; n < 2; ++n) { const unsigned h0 = n == 0 ? hw.x : hw.z, h1w = n == 0 ? hw.y : hw.w, p0 = n == 0 ? pw.x : pw.z, p1 = n == 0 ? pw.y : pw.w;
                        const f32x4 a = acc[ai][bj][m][n]; f32x4 h2;
                        h2[0] = bflo(h0) + __builtin_amdgcn_rcpf(1.f + __expf(-a[0])) * bflo(p0); h2[1] = bfhi(h0) + __builtin_amdgcn_rcpf(1.f + __expf(-a[1])) * bfhi(p0);
                        h2[2] = bflo(h1w) + __builtin_amdgcn_rcpf(1.f + __expf(-a[2])) * bflo(p1); h2[3] = bfhi(h1w) + __builtin_amdgcn_rcpf(1.f + __expf(-a[3])) * bfhi(p1);
                        acc[ai][bj][m][n] = h2; s += (h2[0] * h2[0] + h2[1] * h2[1]) + (h2[2] * h2[2] + h2[3] * h2[3]); } }
                s += __shfl_xor(s, 16); s += xor32(s, fq >= 2);
                if (fq == 0) unsafeAtomicAdd(ssq + row, s);
                if (m & 1) asm volatile("" ::: "memory"); }
        norm_wait(ctl + CW_PCNT + 64 * u.pm, 32u, ctl + CW_TMO);
        f32x4 gv[2][2];
#pragma unroll
        for (int bj = 0; bj < 2; ++bj)
#pragma unroll
            for (int n = 0; n < 2; ++n) gv[bj][n] = *(const f32x4*)(g_fin + col0 + bj * HALF + n * 4);
#pragma unroll
        for (int ai = 0; ai < 2; ++ai)
#pragma unroll
            for (int m = 0; m < 4; ++m) { const int row = u.pm * BM + ai * HALF + wr * 64 + m * 16 + fr; const size_t off = (size_t)row * DM + col0;
                const float rstd = rsq(__hip_atomic_load(ssq + row, __ATOMIC_RELAXED, __HIP_MEMORY_SCOPE_AGENT) * (1.f / DM) + EPS);
#pragma unroll
                for (int bj = 0; bj < 2; ++bj)
#pragma unroll
                    for (int n = 0; n < 2; ++n) *(f32x4*)(Yout + off + bj * HALF + n * 4) = acc[ai][bj][m][n] * rstd * gv[bj][n]; }
    }
};
}
__device__ __forceinline__ void p6_final(Frame& F) {
    const int gw = F.vcu * NWAVES + F.wave, NGW = F.G * NWAVES, lane = F.lane;
    for (int m = gw; m < MT; m += NGW) {
        GAS f32x4* yr = (GAS f32x4*)(F.out + O_Y + (size_t)m * DM) + lane; const float rstd = rsq(F.SSQ_Y[m] * (1.f / DM) + EPS);
#pragma unroll
        for (int j = 0; j < 4; ++j) { const f32x4 g = ((const GAS f32x4*)F.g_fin)[lane + 64 * j]; yr[64 * j] = yr[64 * j] * rstd * g; }
    }
}

template <int MODE  >
__device__ __forceinline__ void small_gemm_tile(Frame& F, const int tile) {
    const int lane = F.lane, w = F.wave, rb = w >> 1, cg = w & 1, l15 = lane & 15, kq = lane >> 4;
    const int tm = tile >> 4, tn = tile & 15;
    f32x4 acc0, acc1;
    { const bf16* A = (MODE == 4 ? F.MIX : F.H1B) + (size_t)(MP + tm * 64 + l15) * DM + 128 * w + 8 * kq;
      const bf16* B = (MODE == 4 ? F.WOUT : F.WPG) + (size_t)(tn * 64 + l15) * DM + 128 * w + 8 * kq;
      bf16x8 a[4][4], b[4][4];
#pragma unroll
      for (int i = 0; i < 4; ++i)
#pragma unroll
          for (int ks = 0; ks < 4; ++ks) { a[i][ks] = *(const GAS bf16x8*)(A + (size_t)(16 * i) * DM + 32 * ks); b[i][ks] = *(const GAS bf16x8*)(B + (size_t)(16 * i) * DM + 32 * ks); }
      LAS f32x4* P = (LAS f32x4*)F.lds + w * 1024 + lane;
#pragma unroll
      for (int i = 0; i < 4; ++i)
#pragma unroll
          for (int j = 0; j < 4; ++j) { f32x4 t = {0.f, 0.f, 0.f, 0.f};
#pragma unroll
              for (int ks = 0; ks < 4; ++ks) t = __builtin_amdgcn_mfma_f32_16x16x32_bf16(a[i][ks], b[j][ks], t, 0, 0, 0);
              P[(i * 4 + j) * 64] = t; }
      __syncthreads();
      LAS const f32x4* Q = (LAS const f32x4*)F.lds + (2 * w) * 64 + lane;
      acc0 = (f32x4){0.f, 0.f, 0.f, 0.f}; acc1 = acc0;
#pragma unroll
      for (int w2 = 0; w2 < 8; ++w2) { acc0 += Q[w2 * 1024]; acc1 += Q[w2 * 1024 + 64]; }
      __syncthreads(); }
    if (MODE == 4) {
#pragma unroll
        for (int r = 0; r < 4; ++r) { const int rs = tm * 64 + rb * 16 + 4 * kq + r; const size_t row = (size_t)(MP + rs);
#pragma unroll
            for (int c = 0; c < 2; ++c) { const int col = tn * 64 + cg * 32 + 16 * c + l15; const float av = c == 0 ? acc0[r] : acc1[r];
                F.H1B[row * DM + col] = (bf16)f2bf(av + bf2f(F.XN[row * DM + col])); } }
    } else {
        float hv[4][2];
#pragma unroll
        for (int r = 0; r < 4; ++r) { const int rs = tm * 64 + rb * 16 + 4 * kq + r; const size_t row = (size_t)(MP + rs); float ss = 0.f;
#pragma unroll
            for (int c = 0; c < 2; ++c) { const int col = tn * 64 + cg * 32 + 16 * c + l15; const float av = c == 0 ? acc0[r] : acc1[r];
                hv[r][c] = bf2f(F.H1B[row * DM + col]) + __builtin_amdgcn_rcpf(1.f + __expf(-av)) * bf2f(F.PP[row * DM + col]); ss += hv[r][c] * hv[r][c]; }
            ss += __shfl_xor(ss, 1); ss += __shfl_xor(ss, 2); ss += __shfl_xor(ss, 4); ss += __shfl_xor(ss, 8); if (l15 == 0) unsafeAtomicAdd(F.SSQ_Y + row, ss); }
        pg8::norm_wait((unsigned*)F.ctl + CW_SCNT + 64 * tm, 128u, (unsigned*)F.ctl + CW_TMO);
#pragma unroll
        for (int r = 0; r < 4; ++r) { const int rs = tm * 64 + rb * 16 + 4 * kq + r; const size_t row = (size_t)(MP + rs);
            const float rstd = rsq(__hip_atomic_load(F.SSQ_Y + row, __ATOMIC_RELAXED, __HIP_MEMORY_SCOPE_AGENT) * (1.f / DM) + EPS);
#pragma unroll
            for (int c = 0; c < 2; ++c) { const int col = tn * 64 + cg * 32 + 16 * c + l15; F.out[O_Y + row * DM + col] = hv[r][c] * rstd * F.g_fin[col]; } }
    }
}


__global__ void __launch_bounds__(NTHREADS, 2) hymba_fwd(Args args) {
    extern __shared__ __attribute__((aligned(16))) unsigned char lds_raw[];
    LAS unsigned char* const lds = (LAS unsigned char*)lds_raw;
    const int wave_s = __builtin_amdgcn_readfirstlane(threadIdx.x >> 6);
    for (int u = threadIdx.x; u < (LDS_BYTES - LDSCTL_OFF) / 4; u += NTHREADS) ((LAS unsigned*)(lds + LDSCTL_OFF))[u] = 0u;
    __syncthreads();
    XcdBarrier bar = xcd_barrier_post((unsigned*)((gu32*)(args.ws + WS_CTL) + CW_BAR), (volatile LAS unsigned*)(lds + MISC_OFF) + 8);
#define GRID_BAR() xcd_barrier(bar)
#define PHASE_BEGIN { Frame F; make_frame(F, lds, wave_s); const int bx = (int)blockIdx.x; (void)bx;
#define PHASE_END }

    { PHASE_BEGIN p0_prologue(F); PHASE_END PHASE_BEGIN p0_rows(F); PHASE_END }
    GRID_BAR();

    PHASE_BEGIN
        pg8::Gemm g{F.XN, F.WIN, MT, ZP, DM, DM, DM}; pg8::StaticOrder S; S.init(MT, ZP, F.G, bx);
        pg8::EpiZ E{F.Z, F.SSQ_Q, F.SSQ_KV, F.RSX};
        pg8::gemm_phase<pg8::EpiZ, pg8::StaticOrder, true>(F.lds, g, S, E, wave_s);
    PHASE_END
    PHASE_BEGIN const bool tail = (F.G == 256); const int nfree = 216, first = 40;
      pg8::Gemm g{F.PB, F.WPP, MT, 1024, 256, 256, 256}; pg8::StaticOrder S; S.init(MT, 1024, tail ? nfree : F.G, tail ? (bx >= first ? bx - first : (1 << 24)) : bx);
      pg8::EpiScale E{F.PP, F.PP, 99, 1024, nullptr, 0.f, 0, -1, F.ROPE, 0, 0};
      pg8::gemm_phase<pg8::EpiScale, pg8::StaticOrder, true>(F.lds, g, S, E, wave_s); PHASE_END
    GRID_BAR();

    {
    PHASE_BEGIN pg8::Gemm g{F.Z, F.WQP, MP, 768, 256, ZP, 256}; pg8::StaticOrder S; S.init(MP, 768, F.G, bx);
      pg8::EpiScale E{F.QP, F.QP, 99, 768, F.SSQ_Q, 1.f / 256.f, 0, 2, F.ROPE, SEQ - 1, 0};
      pg8::gemm_phase<pg8::EpiScale, pg8::StaticOrder, true>(F.lds, g, S, E, wave_s); PHASE_END
    PHASE_BEGIN pg8::Gemm g{F.Z + (size_t)MP * ZP, F.WQS, MS, 1280, 256, ZP, 256}; pg8::StaticOrder S; S.init(MS, 1280, F.G, (bx + 256 - (384 % 256)) % F.G);
      pg8::EpiScale E{F.QS, F.QS, 99, 1280, F.SSQ_Q, 1.f / 256.f, MP, 4, F.ROPE, DECT - 1, SEQ};
      pg8::gemm_phase<pg8::EpiScale, pg8::StaticOrder, true>(F.lds, g, S, E, wave_s); PHASE_END
    PHASE_BEGIN pg8::Gemm g{F.Z + ZC_KV, F.WKV, MP, 1024, 256, ZP, 256}; pg8::StaticOrder S; S.init(MP, 1024, F.G, (bx + 512 - (404 % 256)) % F.G);
      pg8::EpiScale E{F.KN, F.VV, 2, 512, F.SSQ_KV, 1.f / 128.f, 0, -1, F.ROPE, 0, 0};
      pg8::gemm_phase<pg8::EpiScale, pg8::StaticOrder, true>(F.lds, g, S, E, wave_s); PHASE_END
    }
    PHASE_BEGIN p2_rows(F); PHASE_END
    PHASE_BEGIN gla_local_phase(F); PHASE_END
    PHASE_BEGIN for (int u = F.vcu; u < DECB * HG; u += F.G) gla_sample_unit(F, u); PHASE_END
    GRID_BAR();

    PHASE_BEGIN gla_scan(F); PHASE_END
    GRID_BAR();

    PHASE_BEGIN
        const int xl = bx & 7, rk = bx >> 3, nrk = (F.G - xl + 7) >> 3, rd = nrk < 16 ? nrk : 16;
        if (rk < rd) for (int jb = rk; jb < 16; jb += rd) { const int b = xl * 16 + jb;
            decode_unit(F, b, 0); decode_unit(F, b, 1);
            __syncthreads();
            decode_combine_unit(F, b); }
        volatile LAS int* qs = (volatile LAS int*)(F.lds + LDSCTL_OFF + 128);
        unsigned* const qhead = (unsigned*)F.ctl + CW_ATQ + 64 * xl;
#define Q_PULL(dst) do { if (F.tid == 0) qs[0] = (int)__hip_atomic_fetch_add(qhead, 1u, __ATOMIC_RELAXED, __HIP_MEMORY_SCOPE_AGENT); __syncthreads(); dst = __builtin_amdgcn_readfirstlane(qs[0]); __syncthreads(); } while (0)
        int i; Q_PULL(i);
        while (i < 128) { const int qb = 31 - ((i & 63) >> 1), bh = 4 * xl + 2 * (i >> 6) + (i & 1);
            attn_prompt_unit(F, bh >> 3, bh & 7, qb); Q_PULL(i); }
        { int lane; FRESH_LANE_ID(lane); float gon[16];
#pragma unroll
          for (int e = 0; e < 16; ++e) gon[e] = F.g_on[(lane & 7) * 16 + e];
          GoLd nxt; if (i < 384) gla_out_load(F, xl * 256 + (i - 128), lane, nxt);
          while (i < 384) { int j; Q_PULL(j); const GoLd cur = nxt; if (j < 384) gla_out_load(F, xl * 256 + (j - 128), lane, nxt); gla_out_compute(F, xl * 256 + (i - 128), lane, cur, gon); i = j; } }
#undef Q_PULL
    PHASE_END
    GRID_BAR();

    { PHASE_BEGIN pg8::Gemm g{F.MIX, F.WOUT, MP, DM, DM, DM, DM}; pg8::StaticOrder S; S.init(MP, DM, F.G, bx);
      pg8::EpiOut E{F.XN, F.H1B};
      pg8::gemm_phase<pg8::EpiOut, pg8::StaticOrder, true>(F.lds, g, S, E, wave_s); PHASE_END
    PHASE_BEGIN for (int t = F.vcu; t < 256; t += F.G) small_gemm_tile<4>(F, t); PHASE_END }
    GRID_BAR();

    PHASE_BEGIN pg8::Gemm g{F.H1B, F.WPG, MP, DM, DM, DM, DM}; pg8::StaticOrder S; S.init(MP, DM, F.G, bx);
      pg8::EpiPle E{F.H1B, F.PP, F.SSQ_Y, F.out + O_Y, F.g_fin, (unsigned*)F.ctl};
      pg8::gemm_phase<pg8::EpiPle, pg8::StaticOrder, true>(F.lds, g, S, E, wave_s); PHASE_END
    PHASE_BEGIN for (int t = F.vcu; t < 256; t += F.G) small_gemm_tile<5>(F, t); PHASE_END
}

extern "C" void kernel_launch(void* const* d_in, const int* in_sizes, int n_in, void* d_out, int out_size, void* d_ws, size_t ws_size, hipStream_t stream) {
    static int grid = 0;
    if (grid == 0) {
        if (n_in != 22 || (size_t)out_size != O_END || ws_size < WS_END) { fprintf(stderr, "kernel_launch: unexpected shapes: n_in %d out %d ws %zu (need %zu)\n", n_in, out_size, ws_size, (size_t)WS_END); grid = -1; return; }
        int dev = 0, cus = 0, per_cu = 0;
        if (hipGetDevice(&dev) != hipSuccess || hipDeviceGetAttribute(&cus, hipDeviceAttributeMultiprocessorCount, dev) != hipSuccess) { grid = -1; return; }
        if (hipFuncSetAttribute((const void*)hymba_fwd, hipFuncAttributeMaxDynamicSharedMemorySize, LDS_BYTES) != hipSuccess) { fprintf(stderr, "kernel_launch: hipFuncSetAttribute failed\n"); grid = -1; return; }
        if (hipOccupancyMaxActiveBlocksPerMultiprocessor(&per_cu, (const void*)hymba_fwd, NTHREADS, LDS_BYTES) != hipSuccess || per_cu < 1)
            fprintf(stderr, "kernel_launch: note: occupancy query reports %d workgroups per CU\n", per_cu);
        (void)hipGetLastError();
        grid = cus;
    }
    if (grid < 0) return;
    if (hipMemsetAsync((char*)d_ws + WS_CTL, 0, CTL_ZERO_BYTES, stream) != hipSuccess) { fprintf(stderr, "kernel_launch: memset failed\n"); return; }
    Args a{};
    for (int i = 0; i < 22; ++i) a.in[i] = (const float*)d_in[i];
    a.out = (float*)d_out; a.ws = (unsigned char*)d_ws;
    hipLaunchKernelGGL(hymba_fwd, dim3(grid), dim3(NTHREADS), LDS_BYTES, stream, a);
    const hipError_t le = hipPeekAtLastError();
    if (le != hipSuccess) fprintf(stderr, "kernel_launch: launch failed: %s\n", hipGetErrorName(le));
}
```

```cpp
#include <hip/hip_runtime.h>
#include <cstdio>
#include <cstdint>

namespace pg8 {
#define PG8_LAS __attribute__((address_space(3)))
typedef unsigned short bf16_t;
typedef short bf16x8 __attribute__((ext_vector_type(8)));
typedef float f32x4 __attribute__((ext_vector_type(4)));
typedef float f32x2 __attribute__((ext_vector_type(2)));
typedef unsigned u32x4 __attribute__((ext_vector_type(4)));
typedef unsigned u32x2 __attribute__((ext_vector_type(2)));
constexpr int BM = 256, BK = 64, HALF = 128, HTB = HALF * BK * 2, STAGE_BYTES = 8 * HTB, NXCD = 8, WGM = 8;

__host__ __device__ __forceinline__ int lds_byte(int r, int c) { const int st = (r >> 4) * 2 + (c >> 5), rr = r & 15, cc = c & 31, ob = rr * 64 + cc * 2; return st * 1024 + (ob ^ (((ob >> 9) & 1) << 5)); }
__host__ __device__ __forceinline__ void stage_rc(int b, int& R, int& C) { const int st = b / 1024, sb = b % 1024, swz = sb ^ (((sb >> 9) & 1) << 5); R = (st >> 1) * 16 + swz / 64; C = (st & 1) * 32 + (swz % 64) / 2; }
__host__ __device__ __forceinline__ int perm32(int rho) { const int n = rho >> 4, i = rho & 15; return 8 * (i >> 2) + 4 * n + (i & 3); }

struct Unit { int pm, pn; };
struct Gemm { const bf16_t* A; const bf16_t* Bt; int M, N, K, lda, ldb; };

struct StaticOrder {
    int nM, nN, nwg, G, c, base, lim;
    __host__ __device__ void init(int M, int N, int G_, int c_) { nM = M / BM; nN = N / BM; nwg = nM * nN; G = G_; c = c_; base = 0; lim = nwg; }
    __host__ __device__ bool next(int i, Unit& u) const {
        const long L = (long)base + (long)i * G + c; if (L >= lim) return false;
        int wgid = (int)L; { const int q = nwg / NXCD, r = nwg % NXCD, xcd = wgid % NXCD, off = wgid / NXCD; wgid = (xcd < r ? xcd * (q + 1) : r * (q + 1) + (xcd - r) * q) + off; }
        const int nig = WGM * nN, gid = wgid / nig, fm = gid * WGM, gsz = (nM - fm) < WGM ? (nM - fm) : WGM;
        u.pm = fm + ((wgid % nig) % gsz); u.pn = (wgid % nig) / gsz; return true;
    }
    __device__ __forceinline__ void a_ready(const Unit&) const {}
    __device__ __forceinline__ void done(const Unit&) const {}
};

__device__ __forceinline__ unsigned cvt_pk_bf16(float lo, float hi) { unsigned r; asm volatile("v_cvt_pk_bf16_f32 %0, %1, %2" : "=v"(r) : "v"(lo), "v"(hi)); return r; }

template <class Epi, class Sched, bool ALIGN_EPI = false>
__device__ __forceinline__ void gemm_phase(PG8_LAS unsigned char* lds, const Gemm g, const Sched& S, const Epi& E, const int wid) {
    int lane_; asm volatile("v_mbcnt_lo_u32_b32 %0, -1, 0\n\tv_mbcnt_hi_u32_b32 %0, -1, %0" : "=v"(lane_));
    const int lane = lane_, tid = wid * 64 + lane, wr = wid >> 2, wc = wid & 3, fr = lane & 15, fq = lane >> 4;
    const int K = g.K, nt = K / BK;
    unsigned voffA[2], voffB[2];
#pragma unroll
    for (int i = 0; i < 2; ++i) { int R, C; stage_rc(tid * 16 + i * 8192, R, C); const int Rb = Epi::PERM ? ((R & ~31) + perm32(R & 31)) : R;
        voffA[i] = (unsigned)(R * g.lda + C) * 2u; voffB[i] = (unsigned)(Rb * g.ldb + C) * 2u; }
    const size_t kstep = (size_t)(BK * 2);
    const size_t hstepA = (size_t)HALF * g.lda * 2, hstepB = (size_t)HALF * g.ldb * 2;
    const size_t tstepA = 2 * hstepA, tstepB = 2 * hstepB;
    const unsigned ldsw = (unsigned)wid * 1024u;
    const int aoff = lds_byte(wr * 64 + fr, fq * 8), boff = lds_byte(wc * 32 + fr, fq * 8);
#define PG8_SA(b, h) (((b) * 2 + (h)) * HTB)
#define PG8_SB(b, h) ((4 + (b) * 2 + (h)) * HTB)
#define PG8_STAGE(bufoff, gbase, voff) do { _Pragma("unroll") for (int _i = 0; _i < 2; ++_i) \
        __builtin_amdgcn_global_load_lds((const unsigned*)((const char*)(gbase) + (voff)[_i]), (PG8_LAS unsigned*)(lds + (bufoff) + ldsw + _i * 8192), 16, 0, 0); } while (0)
#define PG8_LDA(dst, b, h) do { _Pragma("unroll") for (int m = 0; m < 4; ++m) _Pragma("unroll") for (int k = 0; k < 2; ++k) dst[m][k] = *(const PG8_LAS bf16x8*)(lds + PG8_SA(b, h) + aoff + m * 2048 + k * 1024); } while (0)
#define PG8_LDB(dst, b, h) do { _Pragma("unroll") for (int n = 0; n < 2; ++n) _Pragma("unroll") for (int k = 0; k < 2; ++k) dst[n][k] = *(const PG8_LAS bf16x8*)(lds + PG8_SB(b, h) + boff + n * 2048 + k * 1024); } while (0)
#define PG8_MMA(ai, bj, At, Bt) do { __builtin_amdgcn_s_setprio(1); _Pragma("unroll") for (int m = 0; m < 4; ++m) _Pragma("unroll") for (int n = 0; n < 2; ++n) _Pragma("unroll") for (int k = 0; k < 2; ++k) \
        acc[ai][bj][m][n] = __builtin_amdgcn_mfma_f32_16x16x32_bf16(Bt[n][k], At[m][k], acc[ai][bj][m][n], 0, 0, 0); __builtin_amdgcn_s_setprio(0); } while (0)
#define PG8_WAIT_V(n) asm volatile("s_waitcnt vmcnt(" #n ")" ::: "memory")
#define PG8_WAIT_L(n) asm volatile("s_waitcnt lgkmcnt(" #n ")" ::: "memory")
#define PG8_BAR __builtin_amdgcn_s_barrier()
#define PG8_SCHED __builtin_amdgcn_sched_barrier(0)
    Unit cur, nxt; int ui = 0;
    if (!S.next(0, cur)) return;
    f32x4 acc[2][2][4][2];
#pragma unroll
    for (int a = 0; a < 2; ++a)
#pragma unroll
        for (int b = 0; b < 2; ++b)
#pragma unroll
            for (int m = 0; m < 4; ++m)
#pragma unroll
                for (int n = 0; n < 2; ++n) acc[a][b][m][n] = (f32x4){0.f, 0.f, 0.f, 0.f};
    bf16x8 At[4][2], B0[2][2], B1[2][2];
    const char* cA = (const char*)g.A + (size_t)cur.pm * tstepA; const char* cB = (const char*)g.Bt + (size_t)cur.pn * tstepB;
    S.a_ready(cur);
    PG8_STAGE(PG8_SB(0, 0), cB, voffB); PG8_STAGE(PG8_SB(0, 1), cB + hstepB, voffB); PG8_STAGE(PG8_SA(0, 0), cA, voffA); PG8_STAGE(PG8_SA(0, 1), cA + hstepA, voffA);
    if (wr == 1) PG8_BAR;
    PG8_WAIT_V(2); PG8_BAR;
    PG8_STAGE(PG8_SB(1, 0), cB + kstep, voffB); PG8_STAGE(PG8_SA(1, 0), cA + kstep, voffA); PG8_STAGE(PG8_SB(1, 1), cB + hstepB + kstep, voffB);
    PG8_WAIT_V(6); PG8_BAR;
    for (;;) {
        const bool has_next = S.next(ui + 1, nxt);
        const char* nA = has_next ? (const char*)g.A + (size_t)nxt.pm * tstepA : cA; const char* nB = has_next ? (const char*)g.Bt + (size_t)nxt.pn * tstepB : cB;
        for (int t = 0; t < nt; t += 2) {
            const bool last = (t == nt - 2);
            const char* a1 = cA + (size_t)(t + 1) * kstep;
            const char* a2 = last ? nA : cA + (size_t)(t + 2) * kstep; const char* b2 = last ? nB : cB + (size_t)(t + 2) * kstep;
            const char* a3 = a2 + kstep; const char* b3 = b2 + kstep;
            if (last && has_next) S.a_ready(nxt);
            PG8_LDB(B0, 0, 0); PG8_LDB(B1, 0, 1); PG8_SCHED; PG8_LDA(At, 0, 0); PG8_STAGE(PG8_SA(1, 1), a1 + hstepA, voffA);
            PG8_WAIT_V(8); PG8_WAIT_L(0); PG8_BAR; PG8_MMA(0, 0, At, B0); PG8_MMA(0, 1, At, B1); PG8_BAR; PG8_SCHED;
            PG8_LDA(At, 0, 1); PG8_STAGE(PG8_SB(0, 0), b2, voffB); PG8_STAGE(PG8_SB(0, 1), b2 + hstepB, voffB); PG8_STAGE(PG8_SA(0, 0), a2, voffA);
            PG8_WAIT_V(8); PG8_WAIT_L(0); PG8_BAR; PG8_MMA(1, 0, At, B0); PG8_MMA(1, 1, At, B1); PG8_BAR; PG8_SCHED;
            PG8_LDB(B0, 1, 0); PG8_LDB(B1, 1, 1); PG8_SCHED; PG8_LDA(At, 1, 0); PG8_STAGE(PG8_SA(0, 1), a2 + hstepA, voffA);
            PG8_WAIT_V(8); PG8_WAIT_L(0); PG8_BAR; PG8_MMA(0, 0, At, B0); PG8_MMA(0, 1, At, B1); PG8_BAR; PG8_SCHED;
            PG8_LDA(At, 1, 1); PG8_STAGE(PG8_SB(1, 0), b3, voffB); PG8_STAGE(PG8_SB(1, 1), b3 + hstepB, voffB); PG8_STAGE(PG8_SA(1, 0), a3, voffA);
            PG8_WAIT_V(8); PG8_WAIT_L(0); PG8_BAR; PG8_MMA(1, 0, At, B0); PG8_MMA(1, 1, At, B1); PG8_BAR; PG8_SCHED;
        }
        if constexpr (ALIGN_EPI) { if (wr == 0) PG8_BAR; }
        E(acc, cur, wr, wc, fr, fq); S.done(cur);
        if (!has_next) break;
#pragma unroll
        for (int a = 0; a < 2; ++a)
#pragma unroll
            for (int b = 0; b < 2; ++b)
#pragma unroll
                for (int m = 0; m < 4; ++m)
#pragma unroll
                    for (int n = 0; n < 2; ++n) acc[a][b][m][n] = (f32x4){0.f, 0.f, 0.f, 0.f};
        cur = nxt; cA = nA; cB = nB; ++ui;
        if constexpr (ALIGN_EPI) { if (wr == 1) PG8_BAR; }
    }
    PG8_WAIT_V(0);
    if constexpr (!ALIGN_EPI) { if (wr == 0) PG8_BAR; }
    PG8_BAR;
#undef PG8_SA
#undef PG8_SB
#undef PG8_STAGE
#undef PG8_LDA
#undef PG8_LDB
#undef PG8_MMA
#undef PG8_WAIT_V
#undef PG8_WAIT_L
#undef PG8_BAR
#undef PG8_SCHED
}
}

constexpr int NWAVES = 8, NTHREADS = 512;
constexpr int DM = 1024, SEQ = 8192, NB = 4, MP = NB * SEQ  , DECB = 128, DECT = 8, MS = DECB * DECT  , MT = MP + MS  ;
constexpr int NPAGES = 128, PAGE = 128, PAST = NPAGES * PAGE;
constexpr int HM = 8, QN = 64, QR = 32, VH = 64, KVL = 128, QL = 256;
constexpr int HG = 4, GDK = 64, GDV = 128, GRANK = 16;
constexpr int PD = 256, INDIM = 2480;
constexpr int ZP = 2560;
constexpr int ZC_KV = 256, ZC_KR = 384, ZC_AG = 416, ZC_GM = 512, ZC_QG = 1024, ZC_KG = 1280, ZC_VG = 1536, ZC_GG = 2048;
constexpr float EPS = 1e-6f;
constexpr float QSCALE = 0.10206207261596577f * 1.4426950408889634f;
constexpr int NPOS = SEQ + DECT;
constexpr int NCH = SEQ / 64;
constexpr int NGU = NB * HG * NCH;
constexpr int DSPLIT = 2, DPART = DSPLIT * 4;

constexpr size_t O_Y = 0;
constexpr size_t O_CKVP = (size_t)MT * DM;
constexpr size_t O_KRP = O_CKVP + (size_t)MP * KVL;
constexpr size_t O_GSP = O_KRP + (size_t)MP * QR;
constexpr size_t O_CKVS = O_GSP + (size_t)NB * HG * GDK * GDV;
constexpr size_t O_KRS = O_CKVS + (size_t)MS * KVL;
constexpr size_t O_GSS = O_KRS + (size_t)MS * QR;
constexpr size_t O_END = O_GSS + (size_t)DECB * HG * GDK * GDV;

constexpr size_t MiB = 1u << 20;
constexpr size_t WS_CTL = 0, CTL_ZERO_BYTES = 2 * MiB;
constexpr int CW_BAR = 4096;
constexpr int CW_PCNT = 16384, CW_SCNT = CW_PCNT + 64 * 128;
constexpr int CW_ATQ = 32768;
constexpr int CW_TMO = 64;
constexpr size_t WS_SSQ_Q = 256 * 1024, WS_SSQ_KV = WS_SSQ_Q + (size_t)MT * 4, WS_SSQ_Y = WS_SSQ_KV + (size_t)MT * 4;
static_assert(WS_SSQ_Y + (size_t)MT * 4 <= CTL_ZERO_BYTES, "ctl map");
constexpr size_t WS_WIN = 2 * MiB;
constexpr size_t WS_WQP = WS_WIN + (size_t)ZP * DM * 2;
constexpr size_t WS_WQS = WS_WQP + 768 * 256 * 2;
constexpr size_t WS_WKV = WS_WQS + 1280 * 256 * 2;
constexpr size_t WS_WPP = WS_WKV + 1024 * 256 * 2;
constexpr size_t WS_WOUT = WS_WPP + 1024 * 256 * 2;
constexpr size_t WS_WPG = WS_WOUT + (size_t)DM * DM * 2;
constexpr size_t WS_ROPE = WS_WPG + (size_t)DM * DM * 2;
constexpr size_t WS_W2T = WS_ROPE + (size_t)NPOS * 32 * 4;
constexpr size_t WS_RSX = WS_W2T + 256 * 16 * 2;
constexpr size_t WS_XN = 16 * MiB;
constexpr size_t WS_PB = WS_XN + (size_t)MT * DM * 2;
constexpr size_t WS_Z = WS_PB + (size_t)MT * PD * 2;
constexpr size_t WS_QP = WS_Z + (size_t)MT * ZP * 2;
constexpr size_t WS_QS = WS_QP + (size_t)MP * 768 * 2;
constexpr size_t WS_KN = WS_QS + (size_t)MS * 1280 * 2;
constexpr size_t WS_VV = WS_KN + (size_t)MP * 512 * 2;
constexpr size_t WS_KR = WS_VV + (size_t)MP * 512 * 2;
constexpr size_t WS_PP = WS_KR + (size_t)MT * 32 * 2;
constexpr size_t WS_QT = WS_PP + (size_t)MT * DM * 2;
constexpr size_t WS_KT = WS_QT + (size_t)MP * 256 * 2;
constexpr size_t WS_U = WS_KT + (size_t)MP * 256 * 2;
constexpr size_t WS_DEC = WS_U + (size_t)NGU * GDK * GDV * 4;
constexpr size_t WS_SPREV = WS_DEC + (size_t)NGU * GDK * 4;
constexpr size_t WS_PART = WS_SPREV + (size_t)NGU * GDK * GDV * 2;
constexpr size_t WS_ML = WS_PART + (size_t)DECB * DPART * 64 * 128 * 4;
constexpr size_t WS_MIX = WS_ML + (size_t)DECB * DPART * 64 * 2 * 4;
constexpr size_t WS_H1B = WS_MIX + (size_t)MT * DM * 2;
constexpr size_t WS_END = WS_H1B + (size_t)MT * DM * 2;
static_assert(WS_RSX + (size_t)MT * 4 <= WS_XN, "weights map");

constexpr int RING_BYTES = 131072;
constexpr int LDSCTL_OFF = RING_BYTES, MISC_OFF = LDSCTL_OFF + 320;
constexpr int LDS_BYTES = 147456;

#define FRESH_LANE_ID(l) asm volatile("v_mbcnt_lo_u32_b32 %0, -1, 0\n\tv_mbcnt_hi_u32_b32 %0, -1, %0" : "=v"(l))
#define GAS __attribute__((address_space(1)))
#define LAS __attribute__((address_space(3)))
typedef unsigned short bf16;
typedef unsigned v4u __attribute__((ext_vector_type(4)));
typedef unsigned v2u __attribute__((ext_vector_type(2)));
typedef float f32x4 __attribute__((ext_vector_type(4)));
typedef float f32x2 __attribute__((ext_vector_type(2)));
typedef float f32x16 __attribute__((ext_vector_type(16)));
typedef short bf16x8 __attribute__((ext_vector_type(8)));
typedef short s16x4 __attribute__((ext_vector_type(4)));
typedef GAS unsigned gu32;
#define LDS_WAIT() asm volatile("s_waitcnt lgkmcnt(0)" ::: "memory")
#define VM_WAIT() asm volatile("s_waitcnt vmcnt(0)" ::: "memory")
__device__ __forceinline__ unsigned f2bf(float f) { unsigned u = __builtin_bit_cast(unsigned, f); return (u + 0x7fffu + ((u >> 16) & 1u)) >> 16; }
typedef float f32x2_cv __attribute__((ext_vector_type(2))); typedef __bf16 bf16x2_cv __attribute__((ext_vector_type(2)));
__device__ __forceinline__ unsigned pk2(float lo, float hi) { f32x2_cv v = {lo, hi}; bf16x2_cv b = __builtin_convertvector(v, bf16x2_cv); return __builtin_bit_cast(unsigned, b); }
__device__ __forceinline__ float bf2f(unsigned short b) { return __builtin_bit_cast(float, (unsigned)b << 16); }
__device__ __forceinline__ float bflo(unsigned w) { return __builtin_bit_cast(float, w << 16); }
__device__ __forceinline__ float bfhi(unsigned w) { return __builtin_bit_cast(float, w & 0xffff0000u); }
__device__ __forceinline__ float wave_sum(float v) {
#pragma unroll
    for (int o = 1; o < 64; o <<= 1) v += __shfl_xor(v, o);
    return v;
}
__device__ __forceinline__ float fast_exp2(float x) { return __builtin_amdgcn_exp2f(x); }
__device__ __forceinline__ float siluf(float x) { return x * __builtin_amdgcn_rcpf(1.f + __expf(-x)); }
__device__ __forceinline__ float sigmoidf_(float x) { return __builtin_amdgcn_rcpf(1.f + __expf(-x)); }
__device__ __forceinline__ float rsq(float x) { return __builtin_amdgcn_rsqf(x); }
__device__ __forceinline__ float xor32(float v, bool upper) {
    auto rr = __builtin_amdgcn_permlane32_swap(__float_as_uint(v), __float_as_uint(v), false, false);
    return __uint_as_float(upper ? rr[0] : rr[1]);
}
__device__ __forceinline__ int crow(int r, int hi) { return (r & 3) + 8 * (r >> 2) + 4 * hi; }
#define XB_TMO      128
#define XB_XCNT(j)  (256  + 64 * (j))
#define XB_XSUB(j)  (1280 + 64 * (j))
#define XB_XGEN(j)  (2304 + 64 * (j))
#define XB_TOP      3328
#define XB_TOPGEN   3392
#define XCD_BAR_WORDS 3456
#define XB_SPIN_CAP (1u << 18)

__device__ __forceinline__ unsigned xb_ld(unsigned* p)              { return __hip_atomic_load(p, __ATOMIC_RELAXED, __HIP_MEMORY_SCOPE_AGENT); }
__device__ __forceinline__ unsigned xb_add(unsigned* p, unsigned v) { return __hip_atomic_fetch_add(p, v, __ATOMIC_RELAXED, __HIP_MEMORY_SCOPE_AGENT); }
__device__ __forceinline__ unsigned xb_xcc_id() { return (unsigned)__builtin_amdgcn_s_getreg((3 << 11) | 20) & 0xFu; }
#define XB_SPIN(cond, bar) do { unsigned _sp = 0; while (cond) { __builtin_amdgcn_s_sleep(1); \
    if ((++_sp & 255u) == 0u) { if (xb_ld(&(bar)[XB_TMO])) break; if (_sp > XB_SPIN_CAP) { atomicAdd(&(bar)[XB_TMO], 1u); break; } } } } while (0)

struct XcdBarrier {
    int w;
    unsigned* bar; unsigned x;
    volatile LAS unsigned* st;
};

__device__ __forceinline__ XcdBarrier xcd_barrier_post(unsigned* bar, volatile LAS unsigned* st) {
    XcdBarrier b; b.w = (int)__builtin_amdgcn_readfirstlane(threadIdx.x >> 6); b.bar = bar; b.x = xb_xcc_id(); b.st = st;
    if (threadIdx.x == 0) (void)xb_add(&bar[XB_XCNT(b.x)], 1u);
    return b;
}
__device__ __forceinline__ void xcd_barrier_complete(unsigned* bar, unsigned x, unsigned& nloc, unsigned& nx) {
    const unsigned G = gridDim.x * gridDim.y * gridDim.z;
    unsigned sum, cnt, mine, sp = 0u;
    for (;;) {
        sum = 0u; cnt = 0u; mine = 0u;
#pragma unroll
        for (unsigned j = 0; j < 16; ++j) { const unsigned c = xb_ld(&bar[XB_XCNT(j)]); sum += c; cnt += (c > 0u) ? 1u : 0u; mine = (j == x) ? c : mine; }
        if (sum == G) break;
        __builtin_amdgcn_s_sleep(1);
        if ((++sp & 255u) == 0u) { if (xb_ld(&bar[XB_TMO])) break; if (sp > XB_SPIN_CAP) { atomicAdd(&bar[XB_TMO], 1u); break; } }
    }
    nloc = mine > 0u ? mine : 1u; nx = cnt > 0u ? cnt : 1u;
}

__device__ __forceinline__ void xcd_barrier(const XcdBarrier& b) {
    asm volatile("s_waitcnt vmcnt(0)" ::: "memory");
    __syncthreads();
    unsigned xb_lane; asm volatile("v_mbcnt_lo_u32_b32 %0, -1, 0\n\tv_mbcnt_hi_u32_b32 %0, -1, %0" : "=v"(xb_lane));
    if (b.w == 0 && xb_lane == 0u) {
        unsigned* bar = b.bar;
        __builtin_amdgcn_s_waitcnt(0);
        unsigned nloc = b.st[0], nx = b.st[1];
        if (nloc == 0u) { xcd_barrier_complete(bar, b.x, nloc, nx); b.st[0] = nloc; b.st[1] = nx; }
        const unsigned old = xb_add(&bar[XB_XSUB(b.x)], 1u);
        const unsigned gen = old / nloc;
        if (old + 1u == (gen + 1u) * nloc) {
            __builtin_amdgcn_fence(__ATOMIC_RELEASE, "agent");
            asm volatile("s_waitcnt vmcnt(0)" ::: "memory");
            const unsigned og = xb_add(&bar[XB_TOP], 1u);
            const unsigned tg = og / nx;
            if (og + 1u == (tg + 1u) * nx) xb_add(&bar[XB_TOPGEN], 1u);
            else XB_SPIN(xb_ld(&bar[XB_TOPGEN]) == tg, bar);
            __builtin_amdgcn_fence(__ATOMIC_ACQUIRE, "agent");
            xb_add(&bar[XB_XGEN(b.x)], 1u);
            asm volatile("s_waitcnt vmcnt(0)" ::: "memory");
        } else {
            XB_SPIN(xb_ld(&bar[XB_XGEN(b.x)]) == gen, bar);
            __builtin_amdgcn_fence(__ATOMIC_ACQUIRE, "agent");
            asm volatile("s_waitcnt vmcnt(0)" ::: "memory");
        }
    }
    __syncthreads();
}

struct Args { const float* in[22]; float* out; unsigned char* ws; };
struct Frame {
    LAS unsigned char* lds; gu32* ctl;
    int tid, lane, wave, vcu, G;
    const float *x_p, *x_s, *p_p, *p_s, *cache_ckv, *cache_kr, *state_gla; const int* page_table;
    const float *g_mix, *w_in, *g_q, *w_qup, *g_kv, *w_uk, *w_uv, *w_a2, *b_a, *g_on, *w_out, *w_pg, *w_pp, *g_fin;
    float* out; unsigned char* ws;
    bf16 *WIN, *WQP, *WQS, *WKV, *WPP, *WOUT, *WPG, *W2T; float* ROPE;
    bf16 *XN, *PB, *Z, *QP, *QS, *KN, *VV, *KR, *PP, *QT, *KT, *SPREV, *MIX, *H1B;
    float *U, *DEC, *PART, *ML, *SSQ_Q, *SSQ_KV, *SSQ_Y, *RSX;
};
typedef __attribute__((address_space(4))) const unsigned long long* kargp_t;
__device__ __forceinline__ void make_frame(Frame& F, LAS unsigned char* lds, int wave_s) {
    kargp_t ka = (kargp_t)__builtin_amdgcn_kernarg_segment_ptr(); asm volatile("" : "+s"(ka));
    int lane_; FRESH_LANE_ID(lane_);
    F.lds = lds; F.lane = lane_; F.wave = wave_s; F.tid = wave_s * 64 + lane_;
    F.G = gridDim.x; { const int bx = blockIdx.x; F.vcu = (F.G % 8 == 0) ? (bx % 8) * (F.G / 8) + bx / 8 : bx; }
#define KIN(i) ((const float*)(GAS const float*)ka[i])
    F.x_p = KIN(0); F.x_s = KIN(1); F.p_p = KIN(2); F.p_s = KIN(3); F.cache_ckv = KIN(4); F.cache_kr = KIN(5); F.state_gla = KIN(6);
    F.page_table = (const int*)(GAS const int*)ka[7]; F.g_mix = KIN(8); F.w_in = KIN(9); F.g_q = KIN(10); F.w_qup = KIN(11); F.g_kv = KIN(12);
    F.w_uk = KIN(13); F.w_uv = KIN(14); F.w_a2 = KIN(15); F.b_a = KIN(16); F.g_on = KIN(17); F.w_out = KIN(18); F.w_pg = KIN(19);
    F.w_pp = KIN(20); F.g_fin = KIN(21);
    F.out = (float*)(GAS float*)ka[22]; unsigned char* ws = (unsigned char*)(GAS unsigned char*)ka[23]; F.ws = ws;
#undef KIN
    F.ctl = (gu32*)(ws + WS_CTL);
    F.WIN = (bf16*)(ws + WS_WIN); F.WQP = (bf16*)(ws + WS_WQP); F.WQS = (bf16*)(ws + WS_WQS); F.WKV = (bf16*)(ws + WS_WKV); F.WPP = (bf16*)(ws + WS_WPP);
    F.WOUT = (bf16*)(ws + WS_WOUT); F.WPG = (bf16*)(ws + WS_WPG); F.ROPE = (float*)(ws + WS_ROPE); F.W2T = (bf16*)(ws + WS_W2T);
    F.XN = (bf16*)(ws + WS_XN); F.PB = (bf16*)(ws + WS_PB); F.Z = (bf16*)(ws + WS_Z); F.QP = (bf16*)(ws + WS_QP); F.QS = (bf16*)(ws + WS_QS);
    F.KN = (bf16*)(ws + WS_KN); F.VV = (bf16*)(ws + WS_VV); F.KR = (bf16*)(ws + WS_KR); F.PP = (bf16*)(ws + WS_PP); F.QT = (bf16*)(ws + WS_QT); F.KT = (bf16*)(ws + WS_KT);
    F.SPREV = (bf16*)(ws + WS_SPREV); F.MIX = (bf16*)(ws + WS_MIX); F.H1B = (bf16*)(ws + WS_H1B);
    F.U = (float*)(ws + WS_U); F.DEC = (float*)(ws + WS_DEC); F.PART = (float*)(ws + WS_PART); F.ML = (float*)(ws + WS_ML);
    F.SSQ_Q = (float*)(ws + WS_SSQ_Q); F.SSQ_KV = (float*)(ws + WS_SSQ_KV); F.SSQ_Y = (float*)(ws + WS_SSQ_Y); F.RSX = (float*)(ws + WS_RSX);
}
__device__ __forceinline__ const float* xrow_ptr(const Frame& F, int row) { return row < MP ? F.x_p + (size_t)row * DM : F.x_s + (size_t)(row - MP) * DM; }

template <class Fn> __device__ __forceinline__ void tr_item(const Fn& f, int K, bf16* WT, LAS float* scr, int kb, int nb, int lane) {
    const int k0 = 64 * kb, n0 = 32 * nb;
#pragma unroll 8
    for (int i = 0; i < 32; ++i) { const int kk = 2 * i + (lane >> 5); scr[kk * 33 + (lane & 31)] = f(k0 + kk, n0 + (lane & 31)); }
    LDS_WAIT(); asm volatile("" ::: "memory");
    const int c = lane & 7;
#pragma unroll
    for (int j = 0; j < 4; ++j) { const int n = (lane >> 3) + 8 * j; const LAS float* s = scr + (8 * c) * 33 + n;
        v4u o; o.x = pk2(s[0 * 33], s[1 * 33]); o.y = pk2(s[2 * 33], s[3 * 33]); o.z = pk2(s[4 * 33], s[5 * 33]); o.w = pk2(s[6 * 33], s[7 * 33]);
        *(GAS v4u*)(WT + (size_t)(n0 + n) * K + k0 + 8 * c) = o; }
    LDS_WAIT(); asm volatile("" ::: "memory");
}
__device__ __forceinline__ int win_src_col(int n) {
    if (n < 416) return n;
    if (n < 432) return 1952 + (n - 416);
    if (n < 512) return -1;
    if (n < 1024) return 416 + (n - 512);
    if (n < 1280) return 928 + (n - 1024);
    if (n < 1536) return 1184 + (n - 1280);
    if (n < 2048) return 1440 + (n - 1536);
    return 1968 + (n - 2048);
}
__device__ __forceinline__ int qup_src_col(int n) {
    return n < 512 ? (n >> 6) * 96 + (n & 63) : ((n - 512) >> 5) * 96 + 64 + ((n - 512) & 31);
}
__device__ __forceinline__ void sincos_d(double a, float& s, float& c) {
    const double q = __builtin_rint(a * 0.63661977236758134308);
    const double r = __builtin_fma(-q, 1.57079632679489655800, a) - q * 6.12323399573676603587e-17;
    const double r2 = r * r;
    double sp = -7.6471637318198164759e-13; sp = sp * r2 + 1.6059043836821614599e-10; sp = sp * r2 - 2.5052108385441718775e-8; sp = sp * r2 + 2.7557319223985890653e-6;
    sp = sp * r2 - 1.9841269841269841270e-4; sp = sp * r2 + 8.3333333333333333333e-3; sp = sp * r2 - 1.6666666666666666667e-1; const double sn = r + r * r2 * sp;
    double cp = 4.7794773323873852974e-14; cp = cp * r2 - 1.1470745597729724714e-11; cp = cp * r2 + 2.0876756987868098979e-9; cp = cp * r2 - 2.7557319223985890653e-7;
    cp = cp * r2 + 2.4801587301587301587e-5; cp = cp * r2 - 1.3888888888888888889e-3; cp = cp * r2 + 4.1666666666666666667e-2; cp = cp * r2 - 0.5; const double cs = 1.0 + r2 * cp;
    const int qi = (int)((long long)q & 3);
    const double so = (qi == 0) ? sn : (qi == 1) ? cs : (qi == 2) ? -sn : -cs;
    const double co = (qi == 0) ? cs : (qi == 1) ? -sn : (qi == 2) ? -cs : sn;
    s = (float)so; c = (float)co;
}
__device__ __forceinline__ void p0_prologue(Frame& F) {
    LAS float* scr = (LAS float*)(F.lds + F.wave * 16384);
    const int gw = F.vcu * NWAVES + F.wave, NGW = F.G * NWAVES, lane = F.lane;
    constexpr int I_WIN = 16 * 80, I_WQP = 4 * 24, I_WKV = 4 * 32, I_WPP = 4 * 32, I_WOUT = 16 * 32, I_WPG = 16 * 32;
    constexpr int NITEMS = I_WIN + I_WQP + I_WKV + I_WPP + I_WOUT + I_WPG;
    for (int it = gw; it < NITEMS; it += NGW) {
        int r = it;
        if (r < I_WIN) { const float* w = F.w_in; const float* g = F.g_mix;
            tr_item([&](int k, int n) -> float { const int s = win_src_col(n); return s >= 0 ? g[k] * w[(size_t)k * INDIM + s] : 0.f; }, DM, F.WIN, scr, r / 80, r % 80, lane); continue; } r -= I_WIN;
        if (r < I_WQP) { const float* w = F.w_qup; const float* g = F.g_q;
            tr_item([&](int k, int n) -> float { return g[k] * w[(size_t)k * 768 + qup_src_col(n)] * QSCALE; }, QL, F.WQP, scr, r / 24, r % 24, lane); continue; } r -= I_WQP;
        if (r < I_WKV) { const float* uk = F.w_uk; const float* uv = F.w_uv; const float* g = F.g_kv;
            tr_item([&](int k, int n) -> float { if (k >= KVL) return 0.f; return g[k] * (n < 512 ? uk[(size_t)k * 512 + n] : uv[(size_t)k * 512 + (n - 512)]); }, 256, F.WKV, scr, r / 32, r % 32, lane); continue; } r -= I_WKV;
        if (r < I_WPP) { const float* w = F.w_pp;
            tr_item([&](int k, int n) -> float { return w[(size_t)k * DM + n]; }, PD, F.WPP, scr, r / 32, r % 32, lane); continue; } r -= I_WPP;
        if (r < I_WOUT) { const float* w = F.w_out;
            tr_item([&](int k, int n) -> float { return w[(size_t)k * DM + n]; }, DM, F.WOUT, scr, r / 32, r % 32, lane); continue; } r -= I_WOUT;
        { const float* w = F.w_pg;
            tr_item([&](int k, int n) -> float { return w[(size_t)k * DM + n]; }, DM, F.WPG, scr, r / 32, r % 32, lane); }
    }
    for (int e = (F.vcu * NTHREADS + F.tid); e < NPOS * 16; e += F.G * NTHREADS) {
        const int pi = e >> 4, i = e & 15; const double pos = (double)(pi < SEQ ? pi : PAST + (pi - SEQ));
        double inv = 1.0; for (int j = 0; j < i; ++j) inv *= 0.56234132519034908039;
        float s, c; sincos_d(pos * inv, s, c);
        F.ROPE[(size_t)pi * 32 + i] = c; F.ROPE[(size_t)pi * 32 + 16 + i] = s;
    }
    for (int e = F.vcu * NTHREADS + F.tid; e < 256 * 16; e += F.G * NTHREADS) F.W2T[e] = (bf16)f2bf(F.w_a2[(e & 15) * 256 + (e >> 4)]);
    for (int e = F.vcu * NTHREADS + F.tid; e < 512 * QL; e += F.G * NTHREADS) {
        const int q = e >> 8, k = e & 255, h = q >> 6, c = 2 * (q & 63);
        const GAS f32x4* wq = (const GAS f32x4*)(F.w_qup + (size_t)k * 768 + h * 96);
        const GAS f32x4* wu0 = (const GAS f32x4*)(F.w_uk + (size_t)(c * 8 + h) * 64); const GAS f32x4* wu1 = (const GAS f32x4*)(F.w_uk + (size_t)((c + 1) * 8 + h) * 64);
        float s0 = 0.f, s1 = 0.f;
#pragma unroll
        for (int d = 0; d < 16; ++d) { const f32x4 a = wq[d], b0 = wu0[d], b1 = wu1[d];
            s0 += (a.x * b0.x + a.y * b0.y) + (a.z * b0.z + a.w * b0.w); s1 += (a.x * b1.x + a.y * b1.y) + (a.z * b1.z + a.w * b1.w); }
        const float gs = F.g_q[k] * QSCALE;
        F.WQS[(size_t)(h * 128 + c) * QL + k] = (bf16)f2bf(s0 * gs); F.WQS[(size_t)(h * 128 + c + 1) * QL + k] = (bf16)f2bf(s1 * gs);
    }
    for (int e = F.vcu * NTHREADS + F.tid; e < 256 * QL; e += F.G * NTHREADS) {
        const int n = 1024 + (e >> 8), k = e & 255;
        F.WQS[(size_t)n * QL + k] = (bf16)f2bf(F.w_qup[(size_t)k * 768 + qup_src_col(n - 1024 + 512)] * F.g_q[k] * QSCALE);
    }
}
__device__ __forceinline__ void p0_rows(Frame& F) {
    const int gw = F.vcu * NWAVES + F.wave, NGW = F.G * NWAVES, lane = F.lane;
    for (int m0 = 4 * gw; m0 < MT; m0 += 4 * NGW) {
        f32x4 v[4][4], pv[4];
#pragma unroll
        for (int r = 0; r < 4; ++r) { const int m = m0 + r; const GAS f32x4* xr = (const GAS f32x4*)xrow_ptr(F, m) + lane;
#pragma unroll
            for (int j = 0; j < 4; ++j) v[r][j] = xr[64 * j];
            const float* prow = m < MP ? F.p_p + (size_t)m * PD : F.p_s + (size_t)(m - MP) * PD; pv[r] = ((const GAS f32x4*)prow)[lane]; }
#pragma unroll
        for (int r = 0; r < 4; ++r) { const int m = m0 + r; float s = 0.f;
#pragma unroll
            for (int j = 0; j < 4; ++j) s += (v[r][j].x * v[r][j].x + v[r][j].y * v[r][j].y) + (v[r][j].z * v[r][j].z + v[r][j].w * v[r][j].w);
            const float rstd = 1.f / sqrtf(wave_sum(s) * (1.f / DM) + EPS);
            if (lane == 0) F.RSX[m] = rstd;
            GAS unsigned long long* o8 = (GAS unsigned long long*)(F.XN + (size_t)m * DM) + lane;
#pragma unroll
            for (int j = 0; j < 4; ++j) o8[64 * j] = (unsigned long long)pk2(v[r][j].x, v[r][j].y) | ((unsigned long long)pk2(v[r][j].z, v[r][j].w) << 32);
            ((GAS unsigned long long*)(F.PB + (size_t)m * PD))[lane] = (unsigned long long)pk2(pv[r].x, pv[r].y) | ((unsigned long long)pk2(pv[r].z, pv[r].w) << 32); }
    }
}

namespace pg8 {
__device__ __forceinline__ u32x4 pack8(const f32x4 v0, const f32x4 v1) { u32x4 w; w.x = cvt_pk_bf16(v0[0], v0[1]); w.y = cvt_pk_bf16(v0[2], v0[3]); w.z = cvt_pk_bf16(v1[0], v1[1]); w.w = cvt_pk_bf16(v1[2], v1[3]); return w; }
struct EpiZ {
    static constexpr bool PERM = true;
    bf16_t* Z; float* ssq_q; float* ssq_kv; const float* rsx;
    __device__ __forceinline__ void operator()(const f32x4 (&acc)[2][2][4][2], const Unit& u, int wr, int wc, int, int) const {
        int ln_; FRESH_LANE_ID(ln_); const int fr = ln_ & 15, fq = ln_ >> 4;
        const int row0 = u.pm * BM + wr * 64 + fr, col0 = u.pn * BM + wc * 32 + 8 * fq;
#pragma unroll
        for (int ai = 0; ai < 2; ++ai)
#pragma unroll
            for (int m = 0; m < 4; ++m) { bf16_t* rowp = Z + (size_t)(row0 + ai * HALF + m * 16) * ZP + col0; const float rs = rsx[row0 + ai * HALF + m * 16];
#pragma unroll
                for (int bj = 0; bj < 2; ++bj) *(u32x4*)(rowp + bj * HALF) = pack8(acc[ai][bj][m][0] * rs, acc[ai][bj][m][1] * rs); }
        if (u.pn < 2) {
            float* dst = u.pn == 0 ? ssq_q : ssq_kv; const bool both = (u.pn == 0);
#pragma unroll
            for (int ai = 0; ai < 2; ++ai)
#pragma unroll
                for (int m = 0; m < 4; ++m) { float s = 0.f; const float rs = rsx[row0 + ai * HALF + m * 16];
#pragma unroll
                    for (int n = 0; n < 2; ++n) { const f32x4 a = acc[ai][0][m][n], b = acc[ai][1][m][n];
                        s += (a[0] * a[0] + a[1] * a[1]) + (a[2] * a[2] + a[3] * a[3]);
                        if (both) s += (b[0] * b[0] + b[1] * b[1]) + (b[2] * b[2] + b[3] * b[3]); }
                    s += __shfl_xor(s, 16); s += xor32(s, fq >= 2);
                    if (fq == 0) unsafeAtomicAdd(dst + row0 + ai * HALF + m * 16, s * rs * rs); }
        }
    }
};
struct EpiScale {
    static constexpr bool PERM = true;
    bf16_t* O0; bf16_t* O1; int split_tile; int ldc;
    const float* ssq; float inv_dim; int row_base;
    int rope_tile; const float* rope; int pos_mask, pos_base;
    __device__ __forceinline__ void operator()(const f32x4 (&acc)[2][2][4][2], const Unit& u, int wr, int wc, int, int) const {
        int ln_; FRESH_LANE_ID(ln_); const int fr = ln_ & 15, fq = ln_ >> 4;
        const int row0 = u.pm * BM + wr * 64 + fr;
        bf16_t* base = u.pn < split_tile ? O0 + u.pn * BM : O1 + (u.pn - split_tile) * BM;
        const int col0 = wc * 32 + 8 * fq;
        if (u.pn != rope_tile) {
#pragma unroll
            for (int ai = 0; ai < 2; ++ai)
#pragma unroll
                for (int m = 0; m < 4; ++m) { const int row = row0 + ai * HALF + m * 16;
                    const float rs = ssq ? rsq(ssq[row_base + row] * inv_dim + EPS) : 1.f;
                    bf16_t* rowp = base + (size_t)row * ldc + col0;
#pragma unroll
                    for (int bj = 0; bj < 2; ++bj) *(u32x4*)(rowp + bj * HALF) = pack8(acc[ai][bj][m][0] * rs, acc[ai][bj][m][1] * rs); }
        } else {
#pragma unroll
            for (int ai = 0; ai < 2; ++ai)
#pragma unroll
                for (int m = 0; m < 4; ++m) { const int row = row0 + ai * HALF + m * 16;
                    const float rs = ssq ? rsq(ssq[row_base + row] * inv_dim + EPS) : 1.f;
                    bf16_t* rowp = base + (size_t)row * ldc + col0;
                    const float* tb = rope + (size_t)(pos_base + (row & pos_mask)) * 32 + 8 * (fq & 1);
                    const f32x4 cs0 = *(const f32x4*)tb, cs1 = *(const f32x4*)(tb + 4), sn0 = *(const f32x4*)(tb + 16), sn1 = *(const f32x4*)(tb + 20);
#pragma unroll
                    for (int bj = 0; bj < 2; ++bj) { f32x4 v0 = acc[ai][bj][m][0] * rs, v1 = acc[ai][bj][m][1] * rs; f32x4 o0, o1;
#pragma unroll
                        for (int e = 0; e < 4; ++e) { o0[e] = xor32(v0[e], fq >= 2); o1[e] = xor32(v1[e], fq >= 2); }
                        if (fq < 2) { v0 = v0 * cs0 - o0 * sn0; v1 = v1 * cs1 - o1 * sn1; } else { v0 = o0 * sn0 + v0 * cs0; v1 = o1 * sn1 + v1 * cs1; }
                        *(u32x4*)(rowp + bj * HALF) = pack8(v0, v1); }
                    asm volatile("" ::: "memory"); }
        }
    }
};
}

__device__ __forceinline__ void p2_rows(Frame& F) {
    const int gw = F.vcu * NWAVES + F.wave, NGW = F.G * NWAVES, lane = F.lane, g4 = lane >> 4, l16 = lane & 15;
    const f32x4 gk0 = *(const GAS f32x4*)(F.g_kv + 8 * l16), gk1 = *(const GAS f32x4*)(F.g_kv + 8 * l16 + 4);
    for (int m0 = 4 * gw; m0 < MT; m0 += 4 * NGW) {
        const int m = m0 + g4; const bf16* zr = F.Z + (size_t)m * ZP;
        const v4u zz = *(const GAS v4u*)(zr + ZC_KV + 8 * l16);
        const float x1 = bf2f(zr[ZC_KR + l16]), x2 = bf2f(zr[ZC_KR + 16 + l16]);
        const float rstd = rsq(F.SSQ_KV[m] * (1.f / KVL) + EPS);
        const int pi = m < MP ? (m & (SEQ - 1)) : SEQ + ((m - MP) & (DECT - 1));
        const float c = F.ROPE[(size_t)pi * 32 + l16], s = F.ROPE[(size_t)pi * 32 + 16 + l16];
        float* co = (m < MP ? F.out + O_CKVP + (size_t)m * KVL : F.out + O_CKVS + (size_t)(m - MP) * KVL) + 8 * l16;
        *(GAS f32x4*)co = (f32x4){bflo(zz.x) * rstd * gk0.x, bfhi(zz.x) * rstd * gk0.y, bflo(zz.y) * rstd * gk0.z, bfhi(zz.y) * rstd * gk0.w};
        *(GAS f32x4*)(co + 4) = (f32x4){bflo(zz.z) * rstd * gk1.x, bfhi(zz.z) * rstd * gk1.y, bflo(zz.w) * rstd * gk1.z, bfhi(zz.w) * rstd * gk1.w};
        const float o1 = x1 * c - x2 * s, o2 = x1 * s + x2 * c;
        float* ko = (m < MP ? F.out + O_KRP + (size_t)m * QR : F.out + O_KRS + (size_t)(m - MP) * QR);
        ko[l16] = o1; ko[16 + l16] = o2;
        F.KR[(size_t)m * 32 + l16] = (bf16)f2bf(o1); F.KR[(size_t)m * 32 + 16 + l16] = (bf16)f2bf(o2);
    }
}

__device__ __forceinline__ float logsig16(float x) { return (fminf(x, 0.f) - __logf(1.f + __expf(-fabsf(x)))) * 0.0625f; }
__device__ __forceinline__ void unpack8(const v4u w, float* f) { f[0] = bflo(w.x); f[1] = bfhi(w.x); f[2] = bflo(w.y); f[3] = bfhi(w.y); f[4] = bflo(w.z); f[5] = bfhi(w.z); f[6] = bflo(w.w); f[7] = bfhi(w.w); }

constexpr int TRI_CB = 4160, TRI_BYTES = 4 * TRI_CB;
__device__ __forceinline__ s16x4 tr_read(LAS const unsigned char* p) { typedef short v4i16_t __attribute__((ext_vector_type(4))); return __builtin_bit_cast(s16x4, __builtin_amdgcn_ds_read_tr16_b64_v4i16((LAS v4i16_t*)p)); }
__device__ __forceinline__ bf16x8 tri_frag(LAS const unsigned char* img, int cb, int ks, int lane) {
    const int hh = lane >> 5, g1 = (lane >> 4) & 1, i = lane & 15;
    LAS const unsigned char* p = img + cb * TRI_CB + (16 * ks + 4 * hh + (i >> 2)) * 64 + g1 * 32 + (i & 3) * 8;
    const s16x4 lo = tr_read(p), hi = tr_read(p + 512);
    return (bf16x8){lo[0], lo[1], lo[2], lo[3], hi[0], hi[1], hi[2], hi[3]};
}
__device__ __forceinline__ void tri_store(LAS unsigned char* img, int row, int c8, v4u v) { *(LAS v4u*)(img + (c8 >> 2) * TRI_CB + row * 64 + (c8 & 3) * 16) = v; }

struct GlLd { bf16x8 af; v4u q, k, v[2]; };
__device__ __forceinline__ void gla_local_load(Frame& F, const int unit, const int lane, GlLd& L) {
    const int c = unit & (NCH - 1), bh = unit >> 7, h = bh & 3, b = bh >> 2, tid = F.wave * 64 + lane;
    const size_t row0 = (size_t)b * SEQ + c * 64; const int t = tid >> 3, kg = tid & 7; const bf16* zr = F.Z + (row0 + t) * ZP;
    { const int w = F.wave, r32 = lane & 31, hh = lane >> 5; L.af = *(const GAS bf16x8*)(F.Z + (row0 + 32 * (w & 1) + r32) * ZP + ZC_AG + 8 * hh); }
    L.q = *(const GAS v4u*)(zr + ZC_QG + h * 64 + kg * 8); L.k = *(const GAS v4u*)(zr + ZC_KG + h * 64 + kg * 8);
#pragma unroll
    for (int i = 0; i < 2; ++i) { const int p = tid + 512 * i, tt = p >> 4, dch = p & 15; L.v[i] = *(const GAS v4u*)(F.Z + (row0 + tt) * ZP + ZC_VG + h * 128 + dch * 8); }
}
__device__ __forceinline__ void gla_local_compute(Frame& F, const int unit, const int lane, const GlLd& L) {
    const int c = unit & (NCH - 1), bh = unit >> 7, h = bh & 3, b = bh >> 2;
    const int row0 = b * SEQ + c * 64, tid = F.wave * 64 + lane;
    LAS float* LA = (LAS float*)F.lds;
    LAS float* SEG = (LAS float*)(F.lds + 16640);
    LAS unsigned char* KHI = F.lds + 20480;
    LAS unsigned char* VI = F.lds + 20480 + 2 * TRI_CB;
    if (F.wave < 4) { const int tb = F.wave & 1, kb = F.wave >> 1, r32 = lane & 31, hh = lane >> 5; const int col = h * 64 + 32 * kb + r32;
        const bf16x8 bfr = *(const GAS bf16x8*)(F.W2T + col * 16 + 8 * hh); const float bias = F.b_a[col];
        f32x16 x = {}; x = __builtin_amdgcn_mfma_f32_32x32x16_bf16(L.af, bfr, x, 0, 0, 0);
#pragma unroll
        for (int i = 0; i < 16; ++i) LA[(32 * tb + crow(i, hh)) * 65 + 32 * kb + r32] = logsig16(x[i] + bias); }
    __syncthreads();
    { const int k = tid & 63, seg = tid >> 6; float s = 0.f;
#pragma unroll
      for (int i = 0; i < 8; ++i) s += LA[(seg * 8 + i) * 65 + k];
      SEG[seg * 64 + k] = s;
      __syncthreads();
      float run = 0.f;
      for (int s2 = 0; s2 < seg; ++s2) run += SEG[s2 * 64 + k];
#pragma unroll
      for (int i = 0; i < 8; ++i) { run += LA[(seg * 8 + i) * 65 + k]; LA[(seg * 8 + i) * 65 + k] = run; } }
    __syncthreads();
    { const int t = tid >> 3, kg = tid & 7; const size_t row = (size_t)(row0 + t);
      float q[8], kk8[8]; unpack8(L.q, q); unpack8(L.k, kk8);
      float qt[8], kt[8], kh[8];
#pragma unroll
      for (int e = 0; e < 8; ++e) { const int k = kg * 8 + e; const float bv = LA[t * 65 + k], bl = LA[63 * 65 + k];
          qt[e] = q[e] * __expf(bv) * 0.125f; kt[e] = kk8[e] * __expf(-bv); kh[e] = kk8[e] * __expf(bl - bv); }
      v4u o; o.x = pk2(qt[0], qt[1]); o.y = pk2(qt[2], qt[3]); o.z = pk2(qt[4], qt[5]); o.w = pk2(qt[6], qt[7]);
      *(GAS v4u*)(F.QT + row * 256 + h * 64 + kg * 8) = o;
      o.x = pk2(kt[0], kt[1]); o.y = pk2(kt[2], kt[3]); o.z = pk2(kt[4], kt[5]); o.w = pk2(kt[6], kt[7]);
      *(GAS v4u*)(F.KT + row * 256 + h * 64 + kg * 8) = o;
      o.x = pk2(kh[0], kh[1]); o.y = pk2(kh[2], kh[3]); o.z = pk2(kh[4], kh[5]); o.w = pk2(kh[6], kh[7]);
      tri_store(KHI, t, kg, o);
#pragma unroll
      for (int i = 0; i < 2; ++i) { const int p = tid + 512 * i, tt = p >> 4, dch = p & 15; tri_store(VI, tt, dch, L.v[i]); }
      if (tid < 64) F.DEC[(size_t)unit * 64 + tid] = __expf(LA[63 * 65 + tid]); }
    __syncthreads();
    { const int mb = F.wave & 1, nb = F.wave >> 1, r = lane & 31, hh = lane >> 5; f32x16 acc = {};
#pragma unroll
      for (int ks = 0; ks < 4; ++ks) acc = __builtin_amdgcn_mfma_f32_32x32x16_bf16(tri_frag(KHI, mb, ks, lane), tri_frag(VI, nb, ks, lane), acc, 0, 0, 0);
      GAS bf16* up = (GAS bf16*)F.U + (size_t)unit * (GDK * GDV) + 32 * nb + r;
#pragma unroll
      for (int i = 0; i < 16; ++i) up[(size_t)(32 * mb + crow(i, hh)) * GDV] = (bf16)f2bf(acc[i]); }
    __syncthreads();
}
__device__ __forceinline__ void gla_local_phase(Frame& F) {
    int lane; FRESH_LANE_ID(lane);
    GlLd nxt; int u = F.vcu;
    if (u < NGU) gla_local_load(F, u, lane, nxt);
    for (; u < NGU; u += F.G) { const GlLd cur = nxt; if (u + F.G < NGU) gla_local_load(F, u + F.G, lane, nxt); gla_local_compute(F, u, lane, cur); }
}

__device__ __forceinline__ void gla_scan(Frame& F) {
    for (int e = F.vcu * NTHREADS + F.tid; e < NB * HG * GDK * GDV; e += F.G * NTHREADS) {
        const int bh = e >> 13, k = (e >> 7) & 63, dv = e & 127; float S = 0.f;
        const GAS bf16* up = (const GAS bf16*)F.U + (size_t)bh * NCH * (GDK * GDV) + k * GDV + dv; const float* dp = F.DEC + (size_t)bh * NCH * 64 + k; bf16* sp = F.SPREV + (size_t)bh * NCH * (GDK * GDV) + k * GDV + dv;
        for (int c0 = 0; c0 < NCH; c0 += 16) { float u[16], d[16];
#pragma unroll
            for (int i = 0; i < 16; ++i) { u[i] = bf2f(up[(size_t)(c0 + i) * (GDK * GDV)]); d[i] = dp[(size_t)(c0 + i) * 64]; }
#pragma unroll
            for (int i = 0; i < 16; ++i) { sp[(size_t)(c0 + i) * (GDK * GDV)] = (bf16)f2bf(S); S = d[i] * S + u[i]; } }
        F.out[O_GSP + (size_t)e] = S;
    }
}

struct GoLd { v4u sv[2], vv[2]; v2u qp[8]; bf16x8 qn[4]; bf16x8 kf[2][4]; v4u gate[2]; };
__device__ __forceinline__ void gla_out_load(Frame& F, const int unit, const int lane, GoLd& L) {
    const int c = unit & (NCH - 1), bh = unit >> 7, h = bh & 3, b = bh >> 2, w = F.wave, tid = w * 64 + lane, r = lane & 31, hh = lane >> 5, tb = w >> 2;
    const size_t row0 = (size_t)b * SEQ + c * 64;
#pragma unroll
    for (int i = 0; i < 2; ++i) { const int p = tid + 512 * i, row = p >> 4, c8 = p & 15;
        L.sv[i] = *(const GAS v4u*)(F.SPREV + (size_t)unit * (GDK * GDV) + row * GDV + c8 * 8);
        L.vv[i] = *(const GAS v4u*)(F.Z + (row0 + row) * ZP + ZC_VG + h * 128 + c8 * 8); }
    const bf16* qrow = F.QT + (row0 + 32 * tb + r) * 256 + h * 64;
#pragma unroll
    for (int ks = 0; ks < 4; ++ks) { L.qp[2 * ks] = *(const GAS v2u*)(qrow + 16 * ks + 4 * hh); L.qp[2 * ks + 1] = *(const GAS v2u*)(qrow + 16 * ks + 8 + 4 * hh); L.qn[ks] = *(const GAS bf16x8*)(qrow + 16 * ks + 8 * hh); }
#pragma unroll
    for (int sb = 0; sb < 2; ++sb) { const bf16* krow = F.KT + (row0 + 32 * sb + r) * 256 + h * 64;
#pragma unroll
        for (int ks = 0; ks < 4; ++ks) L.kf[sb][ks] = *(const GAS bf16x8*)(krow + 16 * ks + 8 * hh); }
    { const int t = tid >> 3, part = tid & 7; const bf16* gp = F.Z + (row0 + t) * ZP + ZC_GG + h * 128 + part * 16; L.gate[0] = *(const GAS v4u*)gp; L.gate[1] = *(const GAS v4u*)(gp + 8); }
}
__device__ __forceinline__ void gla_out_compute(Frame& F, const int unit, const int lane, const GoLd& L, const float (&gon)[16]) {
    const int c = unit & (NCH - 1), bh = unit >> 7, h = bh & 3, b = bh >> 2;
    const int row0 = b * SEQ + c * 64, tid = F.wave * 64 + lane, r = lane & 31, hh = lane >> 5;
    LAS unsigned char* SI = F.lds;
    LAS unsigned char* VI = F.lds + TRI_BYTES;
    LAS float* OS = (LAS float*)(F.lds + 2 * TRI_BYTES);
#pragma unroll
    for (int i = 0; i < 2; ++i) { const int p = tid + 512 * i, row = p >> 4, c8 = p & 15; tri_store(SI, row, c8, L.sv[i]); tri_store(VI, row, c8, L.vv[i]); }
    __syncthreads();
    const int dvb = F.wave & 3, tb = F.wave >> 2;
    f32x16 o = {};
#pragma unroll
    for (int ks = 0; ks < 4; ++ks) { const bf16x8 sf = tri_frag(SI, dvb, ks, lane);
        const v4u qw = {L.qp[2 * ks].x, L.qp[2 * ks].y, L.qp[2 * ks + 1].x, L.qp[2 * ks + 1].y};
        o = __builtin_amdgcn_mfma_f32_32x32x16_bf16(__builtin_bit_cast(bf16x8, qw), sf, o, 0, 0, 0); }
#pragma unroll
    for (int sb = 0; sb < 2; ++sb) if (sb <= tb) { f32x16 at = {};
#pragma unroll
        for (int ks = 0; ks < 4; ++ks) at = __builtin_amdgcn_mfma_f32_32x32x16_bf16(L.kf[sb][ks], L.qn[ks], at, 0, 0, 0);
        if (sb == tb) {
#pragma unroll
            for (int i = 0; i < 16; ++i) if (crow(i, hh) > r) at[i] = 0.f; }
#pragma unroll
        for (int k2 = 0; k2 < 2; ++k2) { v4u pw; pw.x = pk2(at[8 * k2 + 0], at[8 * k2 + 1]); pw.y = pk2(at[8 * k2 + 2], at[8 * k2 + 3]); pw.z = pk2(at[8 * k2 + 4], at[8 * k2 + 5]); pw.w = pk2(at[8 * k2 + 6], at[8 * k2 + 7]);
            o = __builtin_amdgcn_mfma_f32_32x32x16_bf16(__builtin_bit_cast(bf16x8, pw), tri_frag(VI, dvb, 2 * sb + k2, lane), o, 0, 0, 0); } }
#pragma unroll
    for (int i = 0; i < 16; ++i) OS[(32 * tb + crow(i, hh)) * 132 + 32 * dvb + r] = o[i];
    __syncthreads();
    { const int t = tid >> 3, part = tid & 7; const LAS float* orow = OS + t * 132 + part * 16; float v[16]; float ss = 0.f;
#pragma unroll
      for (int e = 0; e < 16; ++e) { v[e] = orow[e]; ss += v[e] * v[e]; }
      ss += __shfl_xor(ss, 1); ss += __shfl_xor(ss, 2); ss += __shfl_xor(ss, 4);
      const float rstd = rsq(ss * (1.f / GDV) + EPS);
      const size_t row = (size_t)(row0 + t); float g[16]; unpack8(L.gate[0], g); unpack8(L.gate[1], g + 8);
      float res[16];
#pragma unroll
      for (int e = 0; e < 16; ++e) res[e] = v[e] * rstd * gon[e] * siluf(g[e]);
      v4u w0, w1; w0.x = pk2(res[0], res[1]); w0.y = pk2(res[2], res[3]); w0.z = pk2(res[4], res[5]); w0.w = pk2(res[6], res[7]);
      w1.x = pk2(res[8], res[9]); w1.y = pk2(res[10], res[11]); w1.z = pk2(res[12], res[13]); w1.w = pk2(res[14], res[15]);
      bf16* mp = F.MIX + row * DM + 512 + h * 128 + part * 16; *(GAS v4u*)mp = w0; *(GAS v4u*)(mp + 8) = w1; }
    __syncthreads();
}
__device__ __forceinline__ void gla_out_phase(Frame& F) {
    int lane; FRESH_LANE_ID(lane);
    float gon[16];
#pragma unroll
    for (int e = 0; e < 16; ++e) gon[e] = F.g_on[(lane & 7) * 16 + e];
    GoLd nxt; int u = F.vcu;
    if (u < NGU) gla_out_load(F, u, lane, nxt);
    for (; u < NGU; u += F.G) { const GoLd cur = nxt; if (u + F.G < NGU) gla_out_load(F, u + F.G, lane, nxt); gla_out_compute(F, u, lane, cur, gon); }
}

struct GsLd { v4u a0, a1; float ba, wa[16]; bf16 q, k, v[2], g[2]; float s0[16], gon[2]; };
__device__ __forceinline__ void gla_sample_load(Frame& F, const int unit, const int lane, GsLd& L) {
    const int h = unit & 3, b = unit >> 2, tid = F.wave * 64 + lane; const int row0 = MP + b * DECT;
    { const int t = tid >> 6, k = tid & 63; const bf16* zr = F.Z + (size_t)(row0 + t) * ZP; const int col = h * 64 + k;
      L.a0 = *(const GAS v4u*)(zr + ZC_AG); L.a1 = *(const GAS v4u*)(zr + ZC_AG + 8); L.ba = ((const GAS float*)F.b_a)[col];
#pragma unroll
      for (int r = 0; r < 16; ++r) L.wa[r] = ((const GAS float*)F.w_a2)[r * 256 + col];
      L.q = ((const GAS bf16*)zr)[ZC_QG + h * 64 + k]; L.k = ((const GAS bf16*)zr)[ZC_KG + h * 64 + k];
#pragma unroll
      for (int i = 0; i < 2; ++i) { const int dv = k + 64 * i; L.g[i] = ((const GAS bf16*)zr)[ZC_GG + h * 128 + dv]; L.gon[i] = ((const GAS float*)F.g_on)[dv]; } }
#pragma unroll
    for (int i = 0; i < 2; ++i) { const int p = tid + 512 * i, tt = p >> 7, dv = p & 127; L.v[i] = ((const GAS bf16*)F.Z)[(size_t)(row0 + tt) * ZP + ZC_VG + h * 128 + dv]; }
    { const int kq = tid >> 7, dv = tid & 127; const GAS float* s0p = (const GAS float*)F.state_gla + (((size_t)b * HG + h) * GDK + kq * 16) * GDV + dv;
#pragma unroll
      for (int kk = 0; kk < 16; ++kk) L.s0[kk] = s0p[(size_t)kk * GDV]; }
}
__device__ __forceinline__ void gla_sample_compute(Frame& F, const int unit, const int lane, const GsLd& L) {
    const int h = unit & 3, b = unit >> 2, tid = F.wave * 64 + lane; const int row0 = MP + b * DECT;
    LAS float* LA = (LAS float*)F.lds;
    LAS float* QS_ = LA + 512;
    LAS float* KS_ = QS_ + 512;
    LAS float* KH_ = KS_ + 512;
    LAS float* VS_ = KH_ + 512;
    LAS float* AI = VS_ + 1024;
    LAS float* RED = AI + 64;
    { const int t = tid >> 6, k = tid & 63;
      float a[16]; unpack8(L.a0, a); unpack8(L.a1, a + 8);
      float x = L.ba;
#pragma unroll
      for (int r = 0; r < 16; ++r) x += a[r] * L.wa[r];
      LA[t * 64 + k] = logsig16(x); }
    __syncthreads();
    if (tid < 64) { float run = 0.f;
#pragma unroll
        for (int t = 0; t < 8; ++t) { run += LA[t * 64 + tid]; LA[t * 64 + tid] = run; } }
    __syncthreads();
    { const int t = tid >> 6, k = tid & 63;
      const float bv = LA[t * 64 + k], bl = LA[7 * 64 + k], q = bf2f(L.q), kk = bf2f(L.k);
      QS_[t * 64 + k] = q * __expf(bv) * 0.125f; KS_[t * 64 + k] = kk * __expf(-bv); KH_[t * 64 + k] = kk * __expf(bl - bv);
#pragma unroll
      for (int i = 0; i < 2; ++i) { const int p = tid + 512 * i, tt = p >> 7, dv = p & 127; VS_[tt * 128 + dv] = bf2f(L.v[i]); } }
    __syncthreads();
    if (tid < 64) { const int t = tid >> 3, s = tid & 7; float a = 0.f;
        if (s <= t) {
#pragma unroll 8
            for (int k = 0; k < 64; ++k) a += QS_[t * 64 + k] * KS_[s * 64 + k]; }
        AI[t * 8 + s] = a; }
    { const int kq = tid >> 7, dv = tid & 127; float* snp = F.out + O_GSS + (((size_t)b * HG + h) * GDK + kq * 16) * GDV + dv;
      float po[8];
#pragma unroll
      for (int t = 0; t < 8; ++t) { float a = 0.f;
#pragma unroll
          for (int kk = 0; kk < 16; ++kk) a += QS_[t * 64 + kq * 16 + kk] * L.s0[kk];
          po[t] = a; }
#pragma unroll
      for (int t = 0; t < 8; ++t) RED[(kq * 8 + t) * 128 + dv] = po[t];
#pragma unroll
      for (int kk = 0; kk < 16; ++kk) { const int k = kq * 16 + kk; float sn = __expf(LA[7 * 64 + k]) * L.s0[kk];
#pragma unroll
          for (int t = 0; t < 8; ++t) sn += KH_[t * 64 + k] * VS_[t * 128 + dv];
          snp[(size_t)kk * GDV] = sn; } }
    __syncthreads();
    { const int t = tid >> 6, j = tid & 63; float ov[2]; float ss = 0.f;
#pragma unroll
      for (int i = 0; i < 2; ++i) { const int dv = j + 64 * i; float o = RED[(0 * 8 + t) * 128 + dv] + RED[(1 * 8 + t) * 128 + dv] + RED[(2 * 8 + t) * 128 + dv] + RED[(3 * 8 + t) * 128 + dv];
          for (int s = 0; s <= t; ++s) o += AI[t * 8 + s] * VS_[s * 128 + dv];
          ov[i] = o; ss += o * o; }
      const float rstd = rsq(wave_sum(ss) * (1.f / GDV) + EPS); const size_t row = (size_t)(row0 + t);
#pragma unroll
      for (int i = 0; i < 2; ++i) { const int dv = j + 64 * i;
          F.MIX[row * DM + 512 + h * 128 + dv] = (bf16)f2bf(ov[i] * rstd * L.gon[i] * siluf(bf2f(L.g[i]))); } }
    __syncthreads();
}
__device__ __forceinline__ void gla_sample_phase(Frame& F) {
    int lane; FRESH_LANE_ID(lane);
    GsLd nxt; int u = F.vcu;
    if (u < DECB * HG) gla_sample_load(F, u, lane, nxt);
    for (; u < DECB * HG; u += F.G) { const GsLd cur = nxt; if (u + F.G < DECB * HG) gla_sample_load(F, u + F.G, lane, nxt); gla_sample_compute(F, u, lane, cur); }
}

constexpr int AT_KSLOT = 12288, AT_VSLOT = 8192, AT_V0 = 4 * AT_KSLOT, AT_WSF = AT_V0 + 3 * AT_VSLOT, AT_OST = AT_WSF + NWAVES * 256, AT_END = AT_OST + NWAVES * 4096;
static_assert(AT_END <= RING_BYTES, "attention LDS");
__device__ __forceinline__ float max16(const f32x16& p) {
    float a = fmaxf(fmaxf(p[0], p[1]), fmaxf(p[2], p[3])), b = fmaxf(fmaxf(p[4], p[5]), fmaxf(p[6], p[7]));
    float c = fmaxf(fmaxf(p[8], p[9]), fmaxf(p[10], p[11])), d = fmaxf(fmaxf(p[12], p[13]), fmaxf(p[14], p[15]));
    return fmaxf(fmaxf(a, b), fmaxf(c, d));
}
__device__ __forceinline__ bf16x8 pack_p(const f32x16& p, int base) {
    v4u w; w.x = pk2(p[base + 0], p[base + 1]); w.y = pk2(p[base + 2], p[base + 3]); w.z = pk2(p[base + 4], p[base + 5]); w.w = pk2(p[base + 6], p[base + 7]); return __builtin_bit_cast(bf16x8, w);
}
#ifndef AT_STHR
#define AT_STHR 1024.0f
#endif
#define AT_SBAR() __builtin_amdgcn_sched_barrier(0)
#define AT_PIN(x) asm volatile("" : "+v"(x))
#define AT_MFMA(a, b, c) __builtin_amdgcn_mfma_f32_32x32x16_bf16(a, b, c, 0, 0, 0)
#define AT_WAIT_BAR(N) asm volatile("s_waitcnt vmcnt(" #N ") lgkmcnt(0)\n\ts_barrier" ::: "memory")
__device__ __forceinline__ void at_glds16(const char* sbase, unsigned voff, unsigned lds_base) {
    unsigned sv; asm volatile("s_mov_b32 %0, m0\n\ts_mov_b32 m0, %3\n\ts_nop 0\n\tglobal_load_lds_dwordx4 %1, %2\n\ts_mov_b32 m0, %0" : "=&s"(sv) : "v"(voff), "s"(sbase), "s"(lds_base) : "memory"); }
__device__ __forceinline__ void at_kload2(bf16x8* kf, LAS const unsigned char* kp, int d0) { kf[2 * d0] = *(const LAS bf16x8*)(kp + d0 * 2048); kf[2 * d0 + 1] = *(const LAS bf16x8*)(kp + d0 * 2048 + 512); }
#define AT_MX3(a, b, c) __builtin_fmaxf(__builtin_fmaxf((a), (b)), (c))
__device__ __forceinline__ float at_rowmax(const f32x16& p0, const f32x16& p1) {
    float a = AT_MX3(p0[0], p0[1], p1[0]), b = AT_MX3(p0[2], p0[3], p1[1]); a = AT_MX3(a, p1[2], p1[3]);
#pragma unroll
    for (int r = 4; r < 16; r += 4) { a = AT_MX3(a, p0[r], p0[r + 1]); b = AT_MX3(b, p0[r + 2], p0[r + 3]); a = AT_MX3(a, p1[r], p1[r + 1]); b = AT_MX3(b, p1[r + 2], p1[r + 3]); }
    float m = __builtin_fmaxf(a, b); auto rr = __builtin_amdgcn_permlane32_swap(__float_as_uint(m), __float_as_uint(m), false, false);
    return __builtin_fmaxf(__uint_as_float(rr[0]), __uint_as_float(rr[1])); }
__device__ __forceinline__ void at_cmask(f32x16& p0, f32x16& p1, int jb, int qrel, int hi) {
    const int d_ = qrel - 64 * jb - 4 * hi;
#pragma unroll
    for (int i = 0; i < 16; ++i) { if ((i & 3) + 8 * (i >> 2) > d_) p0[i] = -INFINITY; if ((i & 3) + 8 * (i >> 2) + 32 > d_) p1[i] = -INFINITY; } }
__device__ __forceinline__ void attn_prompt_unit(Frame& F, const int b, const int h, const int qb) {
    int ln_; FRESH_LANE_ID(ln_);
    const int lane = ln_, w = F.wave, r32 = lane & 31, hi = lane >> 5;
    const size_t R0 = (size_t)b * SEQ; const int q0 = qb * 256;
    LAS unsigned char* const lds = F.lds; const unsigned lds0 = (unsigned)(size_t)lds;
    LAS float* wsf = (LAS float*)(lds + AT_WSF) + w * 64;
    const int NT = 4 * (qb + 1);
    const char* const qbase = (const char*)(F.QP + (R0 + q0) * 768);
    const unsigned qoff = (unsigned)((32 * w + r32) * 768 + 8 * hi) * 2u;
    bf16x8 qr[6];
#pragma unroll
    for (int d0 = 0; d0 < 4; ++d0) qr[d0] = *(const GAS bf16x8*)(qbase + (qoff + (unsigned)(h * 64 + 16 * d0) * 2u));
#pragma unroll
    for (int d0 = 4; d0 < 6; ++d0) qr[d0] = *(const GAS bf16x8*)(qbase + (qoff + (unsigned)(512 + h * 32 + 16 * (d0 - 4)) * 2u));
    const char* const kbase = (const char*)(F.KN + R0 * 512 + h * 64);
    const char* const rbase = (const char*)(F.KR + R0 * 32);
    const char* const vbase = (const char*)(F.VV + R0 * 512 + h * 64);
    const unsigned koff = (unsigned)(lane * 512 + w * 8) * 2u, roff = (unsigned)(lane * 32 + (w & 3) * 8) * 2u;
    const unsigned voff = (unsigned)((16 * (w & 3) + (lane >> 2)) * 512 + (w >> 2) * 32 + (lane & 3) * 8) * 2u;
    const unsigned kdst = lds0 + w * 1024, rdst = lds0 + (8 + (w & 3)) * 1024, vdst = lds0 + AT_V0 + w * 1024;
#define AT_DMA_K(t, slot) do { at_glds16(kbase + (size_t)(t) * 65536u, koff, (unsigned)__builtin_amdgcn_readfirstlane(kdst + (slot) * AT_KSLOT)); \
                               at_glds16(rbase + (size_t)(t) * 4096u, roff, (unsigned)__builtin_amdgcn_readfirstlane(rdst + (slot) * AT_KSLOT)); } while (0)
#define AT_DMA_V(t, slot) at_glds16(vbase + (size_t)(t) * 65536u, voff, (unsigned)__builtin_amdgcn_readfirstlane(vdst + (slot) * AT_VSLOT))
    LAS const unsigned char* const vp0 = lds + AT_V0 + ((lane >> 4) & 1) * 32 + (lane & 3) * 8 + (4 * hi + ((lane & 15) >> 2)) * 64;
    LAS const unsigned char* const kp0 = lds + hi * 1024 + r32 * 16;
    AT_DMA_K(0, 0); AT_DMA_V(0, 0); AT_DMA_K(1, 1); AT_DMA_K(2, 2);
    float nm, l_reg = 0.f, slast = 0.f; f32x16 o[2]; o[0] = f32x16{}; o[1] = f32x16{};
    f32x16 negm;
    const int qrel = w * 32 + r32; bool resc = false;
    f32x16 pA0, pA1, pB0, pB1; bf16x8 kf[12]; s16x4 vlo[8], vhi[8]; v4u pw0, pw1, pw2, pw3;
    int vs_prev = 0, vs_cur = 0, vs_next = 1;
#define AT_ROT() do { vs_prev = vs_cur; vs_cur = vs_next; vs_next = (vs_next == 2) ? 0 : vs_next + 1; } while (0)
#define AT_EX(v) __builtin_amdgcn_exp2f(v)
#define AT_RESC() do { if (resc) { _Pragma("unroll") for (int d_ = 0; d_ < 2; ++d_) _Pragma("unroll") for (int r = 0; r < 16; ++r) o[d_][r] *= wsf[crow(r, hi)]; } } while (0)
    AT_WAIT_BAR(5);
    { const f32x16 z = f32x16{};
      at_kload2(kf, kp0, 0); pA0 = AT_MFMA(kf[0], qr[0], z); pA1 = AT_MFMA(kf[1], qr[0], z);
#pragma unroll
      for (int d0 = 1; d0 < 6; ++d0) { at_kload2(kf, kp0, d0); pA0 = AT_MFMA(kf[2 * d0], qr[d0], pA0); pA1 = AT_MFMA(kf[2 * d0 + 1], qr[d0], pA1); } }
    if (NT == 4) at_cmask(pA0, pA1, 0, qrel, hi);
    { const float rm = at_rowmax(pA0, pA1); nm = -rm;
#pragma unroll
      for (int r = 0; r < 16; ++r) { pA0[r] = AT_EX(pA0[r] + nm); pA1[r] = AT_EX(pA1[r] + nm); negm[r] = nm; } }
    AT_PIN(negm);
    AT_WAIT_BAR(0);
    AT_DMA_K(3, 3); AT_DMA_V(1, 1); AT_ROT();
    at_kload2(kf, kp0 + AT_KSLOT, 0); at_kload2(kf, kp0 + AT_KSLOT, 1);
#define AT_PKW(P, i) pk2(P[i], P[i + 1])
#define AT_PAF(k) __builtin_bit_cast(bf16x8, pw##k)
#define AT_VFR(i) (bf16x8){vlo[i][0], vlo[i][1], vlo[i][2], vlo[i][3], vhi[i][0], vhi[i][1], vhi[i][2], vhi[i][3]}
#define AT_VRD(i) do { vlo[i] = tr_read(vp_ + (((i) >> 2) * 4096 + ((i) & 3) * 1024)); vhi[i] = tr_read(vp_ + (((i) >> 2) * 4096 + ((i) & 3) * 1024 + 512)); } while (0)
#define AT_KJ(d0) at_kload2(kf, kp_, d0)
#define AT_KRD(G, d0) do { if (G) { at_kload2(kf, kn_, d0); } } while (0)
#define AT_GAPM(MF, RD) do { MF; RD; AT_SBAR(); } while (0)
#define AT_GAPB(MF, RD, X, i) do { MF; RD; X[i] = AT_EX(X[i]); X[i + 1] = AT_EX(X[i + 1]); X[i + 2] = AT_EX(X[i + 2]); X[i + 3] = AT_EX(X[i + 3]); AT_PIN(X); AT_SBAR(); } while (0)
#define AT_STEP(C0, C1, P0, P1, t, MASK, GK, GV, GL) do { AT_SBAR(); \
    LAS const unsigned char* const vp_ = vp0 + vs_prev * AT_VSLOT; LAS const unsigned char* const kp_ = kp0 + ((t) & 3) * AT_KSLOT; LAS const unsigned char* const kn_ = kp0 + (((t) + 1) & 3) * AT_KSLOT; \
    float sacc = P0[0] + P0[1]; \
    C0 = AT_MFMA(kf[0], qr[0], negm); AT_KJ(2); float smrg = slast + xor32(slast, hi != 0); sacc += P0[2]; sacc += P0[3]; pw0[0] = pk2(P0[0], P0[1]); AT_PIN(pw0); AT_PIN(smrg); AT_PIN(sacc); AT_SBAR(); \
    C1 = AT_MFMA(kf[1], qr[0], negm); (void)0; sacc += P0[4]; sacc += P0[5]; sacc += P0[6]; pw0[1] = pk2(P0[2], P0[3]); AT_PIN(pw0); AT_PIN(sacc); AT_SBAR(); \
    C0 = AT_MFMA(kf[2], qr[1], C0); AT_KJ(3); sacc += P0[7]; sacc += P0[8]; sacc += P0[9]; pw0[2] = pk2(P0[4], P0[5]); AT_PIN(pw0); AT_PIN(sacc); AT_SBAR(); \
    C1 = AT_MFMA(kf[3], qr[1], C1); (void)0; sacc += P0[10]; sacc += P0[11]; sacc += P0[12]; pw0[3] = pk2(P0[6], P0[7]); AT_PIN(pw0); AT_PIN(sacc); AT_SBAR(); \
    C0 = AT_MFMA(kf[4], qr[2], C0); AT_KJ(4); sacc += P0[13]; sacc += P0[14]; sacc += P0[15]; pw1[0] = pk2(P0[8], P0[9]); AT_PIN(pw1); AT_PIN(sacc); AT_SBAR(); \
    C1 = AT_MFMA(kf[5], qr[2], C1); (void)0; sacc += P1[0]; sacc += P1[1]; sacc += P1[2]; pw1[1] = pk2(P0[10], P0[11]); AT_PIN(pw1); AT_PIN(sacc); AT_SBAR(); \
    C0 = AT_MFMA(kf[6], qr[3], C0); AT_KJ(5); sacc += P1[3]; sacc += P1[4]; sacc += P1[5]; pw1[2] = pk2(P0[12], P0[13]); AT_PIN(pw1); AT_PIN(sacc); AT_SBAR(); \
    C1 = AT_MFMA(kf[7], qr[3], C1); (void)0; sacc += P1[6]; sacc += P1[7]; sacc += P1[8]; pw1[3] = pk2(P0[14], P0[15]); AT_PIN(pw1); AT_PIN(sacc); AT_SBAR(); \
    C0 = AT_MFMA(kf[8], qr[4], C0); AT_VRD(0); sacc += P1[9]; sacc += P1[10]; pw2[0] = pk2(P1[0], P1[1]); pw2[1] = pk2(P1[2], P1[3]); AT_PIN(pw2); AT_PIN(sacc); AT_SBAR(); \
    C1 = AT_MFMA(kf[9], qr[4], C1); AT_VRD(4); sacc += P1[11]; sacc += P1[12]; pw2[2] = pk2(P1[4], P1[5]); pw2[3] = pk2(P1[6], P1[7]); AT_PIN(pw2); AT_PIN(sacc); AT_SBAR(); \
    C0 = AT_MFMA(kf[10], qr[5], C0); AT_VRD(1); sacc += P1[13]; sacc += P1[14]; pw3[0] = pk2(P1[8], P1[9]); pw3[1] = pk2(P1[10], P1[11]); AT_PIN(pw3); AT_PIN(sacc); AT_SBAR(); \
    C1 = AT_MFMA(kf[11], qr[5], C1); AT_VRD(5); sacc += P1[15]; pw3[2] = pk2(P1[12], P1[13]); pw3[3] = pk2(P1[14], P1[15]); AT_PIN(pw3); AT_PIN(sacc); AT_SBAR(); \
    l_reg += sacc; \
    if (GK) AT_DMA_K((t) + 3, ((t) + 3) & 3); if (GV) AT_DMA_V((t) + 1, vs_next); \
    if (MASK) at_cmask(C0, C1, (t) - (NT - 4), qrel, hi); \
    resc = false; slast = sacc;                                                                                            \
    if (__builtin_expect(__any(smrg > AT_STHR), 0)) { const float dl = __builtin_fmaxf(__builtin_amdgcn_logf(smrg), 0.f); nm -= dl;     \
        const float f = __builtin_amdgcn_exp2f(-dl); l_reg *= f; slast *= f; if (hi == 0) wsf[r32] = f; resc = true; \
        _Pragma("unroll") for (int r = 0; r < 16; ++r) { C0[r] -= dl; C1[r] -= dl; negm[r] = nm; } } \
    AT_PIN(negm); AT_SBAR(); \
    AT_GAPB(o[0] = AT_MFMA(AT_PAF(0), AT_VFR(0), o[0]), AT_VRD(2), C0, 0); \
    AT_GAPB(o[1] = AT_MFMA(AT_PAF(0), AT_VFR(4), o[1]), AT_VRD(6), C0, 4); \
    AT_GAPB(o[0] = AT_MFMA(AT_PAF(1), AT_VFR(1), o[0]), AT_VRD(3), C0, 8); \
    AT_GAPB(o[1] = AT_MFMA(AT_PAF(1), AT_VFR(5), o[1]), AT_VRD(7), C0, 12); \
    AT_GAPB(o[0] = AT_MFMA(AT_PAF(2), AT_VFR(2), o[0]), AT_KRD(GL, 0), C1, 0); \
    AT_GAPB(o[1] = AT_MFMA(AT_PAF(2), AT_VFR(6), o[1]), AT_KRD(GL, 1), C1, 4); \
    AT_GAPB(o[0] = AT_MFMA(AT_PAF(3), AT_VFR(3), o[0]), (void)0, C1, 8); \
    AT_GAPB(o[1] = AT_MFMA(AT_PAF(3), AT_VFR(7), o[1]), (void)0, C1, 12); \
    } while (0)
    int t = 1;
    for (; t + 5 < NT; t += 2) {
        AT_STEP(pB0, pB1, pA0, pA1, t, false, true, true, true);     AT_WAIT_BAR(3); AT_RESC(); AT_ROT();
        AT_STEP(pA0, pA1, pB0, pB1, t + 1, false, true, true, true); AT_WAIT_BAR(3); AT_RESC(); AT_ROT();
    }
#define AT_ENDW(tt) do { if ((tt) + 3 < NT) { AT_WAIT_BAR(3); } else if ((tt) + 2 < NT) { AT_WAIT_BAR(1); } else { AT_WAIT_BAR(0); } } while (0)
    for (; t + 1 < NT; t += 2) {
        AT_STEP(pB0, pB1, pA0, pA1, t, true, (t + 3 < NT), (t + 1 < NT), (t + 1 < NT));         AT_ENDW(t);     AT_RESC(); AT_ROT();
        AT_STEP(pA0, pA1, pB0, pB1, t + 1, true, (t + 4 < NT), (t + 2 < NT), (t + 2 < NT));     AT_ENDW(t + 1); AT_RESC(); AT_ROT();
    }
    AT_STEP(pB0, pB1, pA0, pA1, NT - 1, true, false, false, false); AT_RESC();
    { float sacc = pB0[0] + pB0[1];
#pragma unroll
      for (int r = 2; r < 16; ++r) sacc += pB0[r];
#pragma unroll
      for (int r = 0; r < 16; ++r) sacc += pB1[r];
      l_reg += sacc;
      pw0 = (v4u){AT_PKW(pB0, 0), AT_PKW(pB0, 2), AT_PKW(pB0, 4), AT_PKW(pB0, 6)}; pw1 = (v4u){AT_PKW(pB0, 8), AT_PKW(pB0, 10), AT_PKW(pB0, 12), AT_PKW(pB0, 14)};
      pw2 = (v4u){AT_PKW(pB1, 0), AT_PKW(pB1, 2), AT_PKW(pB1, 4), AT_PKW(pB1, 6)}; pw3 = (v4u){AT_PKW(pB1, 8), AT_PKW(pB1, 10), AT_PKW(pB1, 12), AT_PKW(pB1, 14)};
      LAS const unsigned char* const vp_ = vp0 + vs_cur * AT_VSLOT; _Pragma("unroll") for (int i = 0; i < 8; ++i) AT_VRD(i);
      o[0] = AT_MFMA(AT_PAF(0), AT_VFR(0), o[0]); o[1] = AT_MFMA(AT_PAF(0), AT_VFR(4), o[1]); o[0] = AT_MFMA(AT_PAF(1), AT_VFR(1), o[0]); o[1] = AT_MFMA(AT_PAF(1), AT_VFR(5), o[1]);
      o[0] = AT_MFMA(AT_PAF(2), AT_VFR(2), o[0]); o[1] = AT_MFMA(AT_PAF(2), AT_VFR(6), o[1]); o[0] = AT_MFMA(AT_PAF(3), AT_VFR(3), o[0]); o[1] = AT_MFMA(AT_PAF(3), AT_VFR(7), o[1]); }
#undef AT_KJ
#undef AT_DMA_K
#undef AT_DMA_V
#undef AT_ROT
#undef AT_EX
#undef AT_RESC
#undef AT_PKW
#undef AT_PAF
#undef AT_VFR
#undef AT_VRD
#undef AT_KRD
#undef AT_ENDW
#undef AT_GAPM
#undef AT_GAPB
#undef AT_STEP
    float l = l_reg; l += xor32(l, hi != 0);
    if (hi == 0) wsf[32 + r32] = l;
    LAS bf16* stg = (LAS bf16*)(lds + AT_OST) + w * 2048;
#pragma unroll
    for (int i = 0; i < 16; ++i) { const int orow = crow(i, hi); const float rl = __builtin_amdgcn_rcpf(wsf[32 + orow]);
        stg[orow * 64 + r32] = (bf16)f2bf(o[0][i] * rl); stg[orow * 64 + 32 + r32] = (bf16)f2bf(o[1][i] * rl); }
#pragma unroll
    for (int i = 0; i < 4; ++i) { const int row = i * 8 + (lane >> 3), c8 = lane & 7; const unsigned lrow = (unsigned)(32 * w + row);
        const char* const gbase = (const char*)(F.Z + (R0 + q0) * ZP + ZC_GM + h * 64); char* const mbase = (char*)(F.MIX + (R0 + q0) * DM + h * 64);
        float ov[8], g[8]; unpack8(*(const LAS v4u*)(stg + row * 64 + c8 * 8), ov); unpack8(*(const GAS v4u*)(gbase + (lrow * (unsigned)ZP + c8 * 8) * 2u), g);
        v4u ovv; ovv.x = pk2(ov[0] * siluf(g[0]), ov[1] * siluf(g[1])); ovv.y = pk2(ov[2] * siluf(g[2]), ov[3] * siluf(g[3])); ovv.z = pk2(ov[4] * siluf(g[4]), ov[5] * siluf(g[5])); ovv.w = pk2(ov[6] * siluf(g[6]), ov[7] * siluf(g[7]));
        *(GAS v4u*)(mbase + (lrow * (unsigned)DM + c8 * 8) * 2u) = ovv; }
    __syncthreads();
}

constexpr int DC_RCH = 2064, DC_RI = 32768, DC_BUF = DC_RI + 4 * DC_RCH + 192, DC_WSF = 2 * DC_BUF, DC_END = DC_WSF + NWAVES * 256;
static_assert(DC_BUF % 256 == 0 && DC_END <= RING_BYTES, "decode LDS");
__device__ __forceinline__ void decode_unit(Frame& F, const int b, const int sp) {
    int ln_; FRESH_LANE_ID(ln_);
    const int lane = ln_, w = F.wave, tid = w * 64 + lane, r32 = lane & 31, hi = lane >> 5, rh = w & 1, kg = w >> 1;
    LAS unsigned char* const lds = F.lds;
    LAS float* wsf = (LAS float*)(lds + DC_WSF) + w * 64;
    const int qi = 32 * rh + r32, tq = qi >> 3, hq = qi & 7;
    const bf16* qrow = F.QS + (size_t)(b * DECT + tq) * 1280;
    bf16x8 qf[10];
#pragma unroll
    for (int d0 = 0; d0 < 8; ++d0) qf[d0] = *(const GAS bf16x8*)(qrow + hq * 128 + 16 * d0 + 8 * hi);
#pragma unroll
    for (int d0 = 8; d0 < 10; ++d0) qf[d0] = *(const GAS bf16x8*)(qrow + 1024 + hq * 32 + 16 * (d0 - 8) + 8 * hi);
    const int* pt = F.page_table + b * NPAGES + sp * (NPAGES / DSPLIT);
    f32x4 cr[8], kr[2];
#define DC_LOAD(j) do { const size_t pg_ = (size_t)pt[j]; const GAS f32x4* c_ = (const GAS f32x4*)(F.cache_ckv + pg_ * (PAGE * KVL)) + tid; const GAS f32x4* k_ = (const GAS f32x4*)(F.cache_kr + pg_ * (PAGE * QR)) + tid; \
        _Pragma("unroll") for (int i_ = 0; i_ < 8; ++i_) cr[i_] = __builtin_nontemporal_load(c_ + 512 * i_); kr[0] = __builtin_nontemporal_load(k_); kr[1] = __builtin_nontemporal_load(k_ + 512); } while (0)
    const int skb = tid >> 5, sc4 = tid & 31, sch = sc4 >> 1;
    const int st_c = 2048 * (skb >> 3) + 512 * (sch >> 2) + 64 * (skb & 7) + 16 * ((sch & 3) ^ ((skb >> 2) & 3)) + 8 * (sc4 & 1);
    const int st_r = DC_RI + ((tid & 7) >> 1) * DC_RCH + (tid >> 3) * 16 + (tid & 1) * 8;
    const int kr_b = 8192 * kg + 2048 * (r32 >> 3) + 64 * (r32 & 7);
    const int kr_e = kr_b + 16 * (hi ^ ((r32 >> 2) & 3)), kr_o = kr_b + 16 * ((2 + hi) ^ ((r32 >> 2) & 3));
    const int kr_r = DC_RI + hi * DC_RCH + (32 * kg + r32) * 16;
    const int vq = (lane & 15) >> 2, vp = lane & 3, vC = 2 * ((lane >> 4) & 1) + (vp >> 1);
    const int vr_b = 8192 * kg + 64 * (4 * hi + vq) + 8 * (vp & 1);
    const int vr_lo = vr_b + 16 * (vC ^ hi), vr_hi = vr_b + 2048 + 16 * (vC ^ (2 + hi));
#define DC_STORE(buf) do { LAS unsigned char* ib_ = lds + (buf) * DC_BUF; \
        _Pragma("unroll") for (int i = 0; i < 8; ++i) { const v2u wv = {pk2(cr[i].x, cr[i].y), pk2(cr[i].z, cr[i].w)}; *(LAS v2u*)(ib_ + st_c + 4096 * i) = wv; } \
        _Pragma("unroll") for (int i = 0; i < 2; ++i) { const v2u wv = {pk2(kr[i].x, kr[i].y), pk2(kr[i].z, kr[i].w)}; *(LAS v2u*)(ib_ + st_r + 1024 * i) = wv; } } while (0)
#define DC_COMPUTE(buf) do { LAS const unsigned char* ib_ = lds + (buf) * DC_BUF; \
        bf16x8 kf[10]; \
        _Pragma("unroll") for (int d0 = 0; d0 < 8; ++d0) kf[d0] = *(const LAS bf16x8*)(ib_ + ((d0 & 1) ? kr_o : kr_e) + 512 * (d0 >> 1)); \
        kf[8] = *(const LAS bf16x8*)(ib_ + kr_r); kf[9] = *(const LAS bf16x8*)(ib_ + kr_r + 2 * DC_RCH); \
        __builtin_amdgcn_sched_barrier(0); \
        f32x16 p = {}; \
        _Pragma("unroll") for (int d0 = 0; d0 < 10; ++d0) p = __builtin_amdgcn_mfma_f32_32x32x16_bf16(kf[d0], qf[d0], p, 0, 0, 0); \
        float rm = max16(p); rm = fmaxf(rm, xor32(rm, hi != 0)); \
        const float mn = fmaxf(m, rm); \
        if (__any(mn > m)) { const float al = fast_exp2(m - mn); l *= al; if (hi == 0) wsf[r32] = al; \
            _Pragma("unroll") for (int i = 0; i < 16; ++i) { const float f = wsf[crow(i, hi)]; o[0][i] *= f; o[1][i] *= f; o[2][i] *= f; o[3][i] *= f; } } \
        m = mn; \
        float ls = 0.f; \
        _Pragma("unroll") for (int i = 0; i < 16; ++i) { p[i] = fast_exp2(p[i] - m); ls += p[i]; } \
        l += ls; \
        const bf16x8 pa0 = pack_p(p, 0), pa1 = pack_p(p, 8); \
        _Pragma("unroll") for (int cb = 0; cb < 4; ++cb) \
            _Pragma("unroll") for (int ks2 = 0; ks2 < 2; ++ks2) { const s16x4 lo = tr_read(ib_ + vr_lo + 4096 * ks2 + 512 * cb), hi4 = tr_read(ib_ + vr_hi + 4096 * ks2 + 512 * cb); \
                o[cb] = __builtin_amdgcn_mfma_f32_32x32x16_bf16(ks2 == 0 ? pa0 : pa1, (bf16x8){lo[0], lo[1], lo[2], lo[3], hi4[0], hi4[1], hi4[2], hi4[3]}, o[cb], 0, 0, 0); } } while (0)
#define DC_LBAR() asm volatile("s_waitcnt lgkmcnt(0)\n\ts_barrier" ::: "memory")
    f32x16 o[4]; o[0] = f32x16{}; o[1] = f32x16{}; o[2] = f32x16{}; o[3] = f32x16{};
    float m = -1e30f, l = 0.f;
    constexpr int NPG = NPAGES / DSPLIT;
    DC_LOAD(0); DC_STORE(0); DC_LOAD(1);
    DC_LBAR();
    for (int j = 0; j < NPG; ++j) {
        const int cur = j & 1;
        if (w >= 4 && j + 1 < NPG) { DC_STORE(cur ^ 1); if (j + 2 < NPG) DC_LOAD(j + 2); }
        DC_COMPUTE(cur);
        if (w < 4 && j + 1 < NPG) { DC_STORE(cur ^ 1); if (j + 2 < NPG) DC_LOAD(j + 2); }
        DC_LBAR();
    }
#undef DC_LOAD
#undef DC_STORE
#undef DC_COMPUTE
#undef DC_LBAR
    l += xor32(l, hi != 0);
    const int part = sp * 4 + kg;
    float* pp = F.PART + ((size_t)(b * DPART + part) * 64 + 32 * rh) * 128 + r32;
#pragma unroll
    for (int cb = 0; cb < 4; ++cb)
#pragma unroll
        for (int i = 0; i < 16; ++i) pp[(size_t)crow(i, hi) * 128 + 32 * cb] = o[cb][i];
    if (hi == 0) { float* ml = F.ML + ((size_t)(b * DPART + part) * 64 + 32 * rh + r32) * 2; ml[0] = m; ml[1] = l; }
}

__device__ __forceinline__ void decode_combine_unit(Frame& F, const int b) {
    int ln_; FRESH_LANE_ID(ln_);
    const int tid = F.wave * 64 + ln_, i = tid >> 3, part = tid & 7, t = i >> 3, h = i & 7;
    LAS float* SC = (LAS float*)F.lds;
    LAS float* OL = SC + 512;
    const bf16* qrow = F.QS + (size_t)(b * DECT + t) * 1280;
    { float s = -INFINITY;
      if (part <= t) { const float* ck = F.out + O_CKVS + (size_t)(b * DECT + part) * KVL; const float* kr = F.out + O_KRS + (size_t)(b * DECT + part) * QR; float a = 0.f;
          for (int c = 0; c < 128; c += 8) { float q8[8]; unpack8(*(const GAS v4u*)(qrow + h * 128 + c), q8);
#pragma unroll
              for (int e = 0; e < 8; ++e) a += q8[e] * ck[c + e]; }
          for (int c = 0; c < 32; c += 8) { float q8[8]; unpack8(*(const GAS v4u*)(qrow + 1024 + h * 32 + c), q8);
#pragma unroll
              for (int e = 0; e < 8; ++e) a += q8[e] * kr[c + e]; }
          s = a; }
      SC[i * 8 + part] = s; }
    __syncthreads();
    float M = -1e30f; float mp[DPART], lp[DPART], sj[8];
#pragma unroll
    for (int p = 0; p < DPART; ++p) { const float* ml = F.ML + ((size_t)(b * DPART + p) * 64 + i) * 2; mp[p] = ml[0]; lp[p] = ml[1]; M = fmaxf(M, mp[p]); }
#pragma unroll
    for (int j = 0; j < 8; ++j) { sj[j] = SC[i * 8 + j]; M = fmaxf(M, sj[j]); }
    float L = 0.f;
#pragma unroll
    for (int p = 0; p < DPART; ++p) { mp[p] = fast_exp2(mp[p] - M); L += mp[p] * lp[p]; }
#pragma unroll
    for (int j = 0; j < 8; ++j) { sj[j] = fast_exp2(sj[j] - M); L += sj[j]; }
    { float acc[16];
#pragma unroll
      for (int e = 0; e < 16; ++e) acc[e] = 0.f;
#pragma unroll
      for (int p = 0; p < DPART; ++p) { const GAS f32x4* src = (const GAS f32x4*)(F.PART + ((size_t)(b * DPART + p) * 64 + i) * 128 + part * 16);
#pragma unroll
          for (int v = 0; v < 4; ++v) { const f32x4 x = src[v]; acc[4 * v] += mp[p] * x.x; acc[4 * v + 1] += mp[p] * x.y; acc[4 * v + 2] += mp[p] * x.z; acc[4 * v + 3] += mp[p] * x.w; } }
#pragma unroll
      for (int j = 0; j < 8; ++j) { const GAS f32x4* src = (const GAS f32x4*)(F.out + O_CKVS + (size_t)(b * DECT + j) * KVL + part * 16);
#pragma unroll
          for (int v = 0; v < 4; ++v) { const f32x4 x = src[v]; acc[4 * v] += sj[j] * x.x; acc[4 * v + 1] += sj[j] * x.y; acc[4 * v + 2] += sj[j] * x.z; acc[4 * v + 3] += sj[j] * x.w; } }
      const float rl = __builtin_amdgcn_rcpf(L);
#pragma unroll
      for (int e = 0; e < 16; ++e) OL[i * 128 + part * 16 + e] = acc[e] * rl; }
    __syncthreads();
    { float od[8];
#pragma unroll
      for (int e = 0; e < 8; ++e) od[e] = 0.f;
      const float* wv = F.w_uv + h * 64 + part * 8;
#pragma unroll 16
      for (int c = 0; c < 128; ++c) { const float x = OL[i * 128 + c]; const f32x4 w0 = *(const GAS f32x4*)(wv + (size_t)c * 512), w1 = *(const GAS f32x4*)(wv + (size_t)c * 512 + 4);
          od[0] += x * w0.x; od[1] += x * w0.y; od[2] += x * w0.z; od[3] += x * w0.w; od[4] += x * w1.x; od[5] += x * w1.y; od[6] += x * w1.z; od[7] += x * w1.w; }
      const size_t row = (size_t)(MP + b * DECT + t); float g[8]; unpack8(*(const GAS v4u*)(F.Z + row * ZP + ZC_GM + h * 64 + part * 8), g);
      v4u o; o.x = pk2(od[0] * siluf(g[0]), od[1] * siluf(g[1])); o.y = pk2(od[2] * siluf(g[2]), od[3] * siluf(g[3])); o.z = pk2(od[4] * siluf(g[4]), od[5] * siluf(g[5])); o.w = pk2(od[6] * siluf(g[6]), od[7] * siluf(g[7]));
      *(GAS v4u*)(F.MIX + row * DM + h * 64 + part * 8) = o; }
    __syncthreads();
}


namespace pg8 {
struct EpiOut {
    static constexpr bool PERM = true;
    const bf16_t* XB; bf16_t* H1B;
    __device__ __forceinline__ void operator()(const f32x4 (&acc)[2][2][4][2], const Unit& u, int wr, int wc, int, int) const {
        int ln_; FRESH_LANE_ID(ln_); const int fr = ln_ & 15, fq = ln_ >> 4;
        const char* xb = (const char*)(XB + (size_t)u.pm * BM * DM + u.pn * BM);
        char* hb = (char*)(H1B + (size_t)u.pm * BM * DM + u.pn * BM);
        const unsigned lo = (unsigned)((wr * 64 + fr) * DM + wc * 32 + 8 * fq);
#pragma unroll
        for (int ai = 0; ai < 2; ++ai) {
            u32x4 xv[4][2];
#pragma unroll
            for (int m = 0; m < 4; ++m)
#pragma unroll
                for (int bj = 0; bj < 2; ++bj) xv[m][bj] = *(const u32x4*)(xb + (lo + (unsigned)((ai * HALF + m * 16) * DM + bj * HALF)) * 2u);
#pragma unroll
            for (int m = 0; m < 4; ++m)
#pragma unroll
                for (int bj = 0; bj < 2; ++bj) { const u32x4 w = xv[m][bj];
                    const f32x4 x0 = {bflo(w.x), bfhi(w.x), bflo(w.y), bfhi(w.y)}, x1 = {bflo(w.z), bfhi(w.z), bflo(w.w), bfhi(w.w)};
                    *(u32x4*)(hb + (lo + (unsigned)((ai * HALF + m * 16) * DM + bj * HALF)) * 2u) = pack8(acc[ai][bj][m][0] + x0, acc[ai][bj][m][1] + x1); }
            asm volatile("" ::: "memory"); }
    }
};
__device__ __forceinline__ void norm_wait(unsigned* cnt, unsigned want, unsigned* tmo) {
    asm volatile("s_waitcnt vmcnt(0)" ::: "memory");
    unsigned ln; FRESH_LANE_ID(ln);
    if (ln == 0) __hip_atomic_fetch_add(cnt, 1u, __ATOMIC_RELAXED, __HIP_MEMORY_SCOPE_AGENT);
    unsigned spins = 0;
    while ((unsigned)__builtin_amdgcn_readfirstlane(__hip_atomic_load(cnt, __ATOMIC_RELAXED, __HIP_MEMORY_SCOPE_AGENT)) < want) {
        __builtin_amdgcn_s_sleep(2);
        if (++spins > (1u << 20)) { if (ln == 0) __hip_atomic_store(tmo, 1u, __ATOMIC_RELAXED, __HIP_MEMORY_SCOPE_AGENT); break; } }
}
struct EpiPle {
    static constexpr bool PERM = true;
    const bf16_t* H1B; const bf16_t* PPb; float* ssq; float* Yout; const float* g_fin; unsigned* ctl;
    __device__ __forceinline__ void operator()(f32x4 (&acc)[2][2][4][2], const Unit& u, int wr, int wc, int, int) const {
        int ln_; FRESH_LANE_ID(ln_); const int fr = ln_ & 15, fq = ln_ >> 4;
        const int col0 = u.pn * BM + wc * 32 + 8 * fq;
#pragma unroll
        for (int ai = 0; ai < 2; ++ai)
#pragma unroll
            for (int m = 0; m < 4; ++m) { const int row = u.pm * BM + ai * HALF + wr * 64 + m * 16 + fr; const size_t off = (size_t)row * DM + col0; float s = 0.f;
#pragma unroll
                for (int bj = 0; bj < 2; ++bj) { const u32x4 hw = *(const u32x4*)(H1B + off + bj * HALF), pw = *(const u32x4*)(PPb + off + bj * HALF);
#pragma unroll
                    for (int n = 0; n < 2; ++n) { const unsigned h0 = n == 0 ? hw.x : hw.z, h1w = n == 0 ? hw.y : hw.w, p0 = n == 0 ? pw.x : pw.z, p1 = n == 0 ? pw.y : pw.w;
                        const f32x4 a = acc[ai][bj][m][n]; f32x4 h2;
                        h2[0] = bflo(h0) + __builtin_amdgcn_rcpf(1.f + __expf(-a[0])) * bflo(p0); h2[1] = bfhi(h0) + __builtin_amdgcn_rcpf(1.f + __expf(-a[1])) * bfhi(p0);
                        h2[2] = bflo(h1w) + __builtin_amdgcn_rcpf(1.f + __expf(-a[2])) * bflo(p1); h2[3] = bfhi(h1w) + __builtin_amdgcn_rcpf(1.f + __expf(-a[3])) * bfhi(p1);
                        acc[ai][bj][m][n] = h2; s += (h2[0] * h2[0] + h2[1] * h2[1]) + (h2[2] * h2[2] + h2[3] * h2[3]); } }
                s += __shfl_xor(s, 16); s += xor32(s, fq >= 2);
                if (fq == 0) unsafeAtomicAdd(ssq + row, s);
                if (m & 1) asm volatile("" ::: "memory"); }
        norm_wait(ctl + CW_PCNT + 64 * u.pm, 32u, ctl + CW_TMO);
        f32x4 gv[2][2];
#pragma unroll
        for (int bj = 0; bj < 2; ++bj)
#pragma unroll
            for (int n = 0; n < 2; ++n) gv[bj][n] = *(const f32x4*)(g_fin + col0 + bj * HALF + n * 4);
#pragma unroll
        for (int ai = 0; ai < 2; ++ai)
#pragma unroll
            for (int m = 0; m < 4; ++m) { const int row = u.pm * BM + ai * HALF + wr * 64 + m * 16 + fr; const size_t off = (size_t)row * DM + col0;
                const float rstd = rsq(__hip_atomic_load(ssq + row, __ATOMIC_RELAXED, __HIP_MEMORY_SCOPE_AGENT) * (1.f / DM) + EPS);
#pragma unroll
                for (int bj = 0; bj < 2; ++bj)
#pragma unroll
                    for (int n = 0; n < 2; ++n) *(f32x4*)(Yout + off + bj * HALF + n * 4) = acc[ai][bj][m][n] * rstd * gv[bj][n]; }
    }
};
}
__device__ __forceinline__ void p6_final(Frame& F) {
    const int gw = F.vcu * NWAVES + F.wave, NGW = F.G * NWAVES, lane = F.lane;
    for (int m = gw; m < MT; m += NGW) {
        GAS f32x4* yr = (GAS f32x4*)(F.out + O_Y + (size_t)m * DM) + lane; const float rstd = rsq(F.SSQ_Y[m] * (1.f / DM) + EPS);
#pragma unroll
        for (int j = 0; j < 4; ++j) { const f32x4 g = ((const GAS f32x4*)F.g_fin)[lane + 64 * j]; yr[64 * j] = yr[64 * j] * rstd * g; }
    }
}

template <int MODE  >
__device__ __forceinline__ void small_gemm_tile(Frame& F, const int tile) {
    const int lane = F.lane, w = F.wave, rb = w >> 1, cg = w & 1, l15 = lane & 15, kq = lane >> 4;
    const int tm = tile >> 4, tn = tile & 15;
    f32x4 acc0, acc1;
    { const bf16* A = (MODE == 4 ? F.MIX : F.H1B) + (size_t)(MP + tm * 64 + l15) * DM + 128 * w + 8 * kq;
      const bf16* B = (MODE == 4 ? F.WOUT : F.WPG) + (size_t)(tn * 64 + l15) * DM + 128 * w + 8 * kq;
      bf16x8 a[4][4], b[4][4];
#pragma unroll
      for (int i = 0; i < 4; ++i)
#pragma unroll
          for (int ks = 0; ks < 4; ++ks) { a[i][ks] = *(const GAS bf16x8*)(A + (size_t)(16 * i) * DM + 32 * ks); b[i][ks] = *(const GAS bf16x8*)(B + (size_t)(16 * i) * DM + 32 * ks); }
      LAS f32x4* P = (LAS f32x4*)F.lds + w * 1024 + lane;
#pragma unroll
      for (int i = 0; i < 4; ++i)
#pragma unroll
          for (int j = 0; j < 4; ++j) { f32x4 t = {0.f, 0.f, 0.f, 0.f};
#pragma unroll
              for (int ks = 0; ks < 4; ++ks) t = __builtin_amdgcn_mfma_f32_16x16x32_bf16(a[i][ks], b[j][ks], t, 0, 0, 0);
              P[(i * 4 + j) * 64] = t; }
      __syncthreads();
      LAS const f32x4* Q = (LAS const f32x4*)F.lds + (2 * w) * 64 + lane;
      acc0 = (f32x4){0.f, 0.f, 0.f, 0.f}; acc1 = acc0;
#pragma unroll
      for (int w2 = 0; w2 < 8; ++w2) { acc0 += Q[w2 * 1024]; acc1 += Q[w2 * 1024 + 64]; }
      __syncthreads(); }
    if (MODE == 4) {
#pragma unroll
        for (int r = 0; r < 4; ++r) { const int rs = tm * 64 + rb * 16 + 4 * kq + r; const size_t row = (size_t)(MP + rs);
#pragma unroll
            for (int c = 0; c < 2; ++c) { const int col = tn * 64 + cg * 32 + 16 * c + l15; const float av = c == 0 ? acc0[r] : acc1[r];
                F.H1B[row * DM + col] = (bf16)f2bf(av + bf2f(F.XN[row * DM + col])); } }
    } else {
        float hv[4][2];
#pragma unroll
        for (int r = 0; r < 4; ++r) { const int rs = tm * 64 + rb * 16 + 4 * kq + r; const size_t row = (size_t)(MP + rs); float ss = 0.f;
#pragma unroll
            for (int c = 0; c < 2; ++c) { const int col = tn * 64 + cg * 32 + 16 * c + l15; const float av = c == 0 ? acc0[r] : acc1[r];
                hv[r][c] = bf2f(F.H1B[row * DM + col]) + __builtin_amdgcn_rcpf(1.f + __expf(-av)) * bf2f(F.PP[row * DM + col]); ss += hv[r][c] * hv[r][c]; }
            ss += __shfl_xor(ss, 1); ss += __shfl_xor(ss, 2); ss += __shfl_xor(ss, 4); ss += __shfl_xor(ss, 8); if (l15 == 0) unsafeAtomicAdd(F.SSQ_Y + row, ss); }
        pg8::norm_wait((unsigned*)F.ctl + CW_SCNT + 64 * tm, 128u, (unsigned*)F.ctl + CW_TMO);
#pragma unroll
        for (int r = 0; r < 4; ++r) { const int rs = tm * 64 + rb * 16 + 4 * kq + r; const size_t row = (size_t)(MP + rs);
            const float rstd = rsq(__hip_atomic_load(F.SSQ_Y + row, __ATOMIC_RELAXED, __HIP_MEMORY_SCOPE_AGENT) * (1.f / DM) + EPS);
#pragma unroll
            for (int c = 0; c < 2; ++c) { const int col = tn * 64 + cg * 32 + 16 * c + l15; F.out[O_Y + row * DM + col] = hv[r][c] * rstd * F.g_fin[col]; } }
    }
}


__global__ void __launch_bounds__(NTHREADS, 2) hymba_fwd(Args args) {
    extern __shared__ __attribute__((aligned(16))) unsigned char lds_raw[];
    LAS unsigned char* const lds = (LAS unsigned char*)lds_raw;
    const int wave_s = __builtin_amdgcn_readfirstlane(threadIdx.x >> 6);
    for (int u = threadIdx.x; u < (LDS_BYTES - LDSCTL_OFF) / 4; u += NTHREADS) ((LAS unsigned*)(lds + LDSCTL_OFF))[u] = 0u;
    __syncthreads();
    XcdBarrier bar = xcd_barrier_post((unsigned*)((gu32*)(args.ws + WS_CTL) + CW_BAR), (volatile LAS unsigned*)(lds + MISC_OFF) + 8);
#define GRID_BAR() xcd_barrier(bar)
#define PHASE_BEGIN { Frame F; make_frame(F, lds, wave_s); const int bx = (int)blockIdx.x; (void)bx;
#define PHASE_END }

    { PHASE_BEGIN p0_prologue(F); PHASE_END PHASE_BEGIN p0_rows(F); PHASE_END }
    GRID_BAR();

    PHASE_BEGIN
        pg8::Gemm g{F.XN, F.WIN, MT, ZP, DM, DM, DM}; pg8::StaticOrder S; S.init(MT, ZP, F.G, bx);
        pg8::EpiZ E{F.Z, F.SSQ_Q, F.SSQ_KV, F.RSX};
        pg8::gemm_phase<pg8::EpiZ, pg8::StaticOrder, true>(F.lds, g, S, E, wave_s);
    PHASE_END
    PHASE_BEGIN const bool tail = (F.G == 256); const int nfree = 216, first = 40;
      pg8::Gemm g{F.PB, F.WPP, MT, 1024, 256, 256, 256}; pg8::StaticOrder S; S.init(MT, 1024, tail ? nfree : F.G, tail ? (bx >= first ? bx - first : (1 << 24)) : bx);
      pg8::EpiScale E{F.PP, F.PP, 99, 1024, nullptr, 0.f, 0, -1, F.ROPE, 0, 0};
      pg8::gemm_phase<pg8::EpiScale, pg8::StaticOrder, true>(F.lds, g, S, E, wave_s); PHASE_END
    GRID_BAR();

    {
    PHASE_BEGIN pg8::Gemm g{F.Z, F.WQP, MP, 768, 256, ZP, 256}; pg8::StaticOrder S; S.init(MP, 768, F.G, bx);
      pg8::EpiScale E{F.QP, F.QP, 99, 768, F.SSQ_Q, 1.f / 256.f, 0, 2, F.ROPE, SEQ - 1, 0};
      pg8::gemm_phase<pg8::EpiScale, pg8::StaticOrder, true>(F.lds, g, S, E, wave_s); PHASE_END
    PHASE_BEGIN pg8::Gemm g{F.Z + (size_t)MP * ZP, F.WQS, MS, 1280, 256, ZP, 256}; pg8::StaticOrder S; S.init(MS, 1280, F.G, (bx + 256 - (384 % 256)) % F.G);
      pg8::EpiScale E{F.QS, F.QS, 99, 1280, F.SSQ_Q, 1.f / 256.f, MP, 4, F.ROPE, DECT - 1, SEQ};
      pg8::gemm_phase<pg8::EpiScale, pg8::StaticOrder, true>(F.lds, g, S, E, wave_s); PHASE_END
    PHASE_BEGIN pg8::Gemm g{F.Z + ZC_KV, F.WKV, MP, 1024, 256, ZP, 256}; pg8::StaticOrder S; S.init(MP, 1024, F.G, (bx + 512 - (404 % 256)) % F.G);
      pg8::EpiScale E{F.KN, F.VV, 2, 512, F.SSQ_KV, 1.f / 128.f, 0, -1, F.ROPE, 0, 0};
      pg8::gemm_phase<pg8::EpiScale, pg8::StaticOrder, true>(F.lds, g, S, E, wave_s); PHASE_END
    }
    PHASE_BEGIN p2_rows(F); PHASE_END
    PHASE_BEGIN gla_local_phase(F); PHASE_END
    PHASE_BEGIN gla_sample_phase(F); PHASE_END
    GRID_BAR();

    PHASE_BEGIN gla_scan(F); PHASE_END
    GRID_BAR();

    PHASE_BEGIN
        const int xl = bx & 7, rk = bx >> 3, nrk = (F.G - xl + 7) >> 3, rd = nrk < 16 ? nrk : 16;
        if (rk < rd) for (int jb = rk; jb < 16; jb += rd) { const int b = xl * 16 + jb;
            decode_unit(F, b, 0); decode_unit(F, b, 1);
            __syncthreads();
            decode_combine_unit(F, b); }
        volatile LAS int* qs = (volatile LAS int*)(F.lds + LDSCTL_OFF + 128);
        unsigned* const qhead = (unsigned*)F.ctl + CW_ATQ + 64 * xl;
#define Q_PULL(dst) do { if (F.tid == 0) qs[0] = (int)__hip_atomic_fetch_add(qhead, 1u, __ATOMIC_RELAXED, __HIP_MEMORY_SCOPE_AGENT); __syncthreads(); dst = __builtin_amdgcn_readfirstlane(qs[0]); __syncthreads(); } while (0)
        int i; Q_PULL(i);
        while (i < 128) { const int qb = 31 - ((i & 63) >> 1), bh = 4 * xl + 2 * (i >> 6) + (i & 1);
            attn_prompt_unit(F, bh >> 3, bh & 7, qb); Q_PULL(i); }
        { int lane; FRESH_LANE_ID(lane); float gon[16];
#pragma unroll
          for (int e = 0; e < 16; ++e) gon[e] = F.g_on[(lane & 7) * 16 + e];
          GoLd nxt; if (i < 384) gla_out_load(F, xl * 256 + (i - 128), lane, nxt);
          while (i < 384) { int j; Q_PULL(j); const GoLd cur = nxt; if (j < 384) gla_out_load(F, xl * 256 + (j - 128), lane, nxt); gla_out_compute(F, xl * 256 + (i - 128), lane, cur, gon); i = j; } }
#undef Q_PULL
    PHASE_END
    GRID_BAR();

    { PHASE_BEGIN pg8::Gemm g{F.MIX, F.WOUT, MP, DM, DM, DM, DM}; pg8::StaticOrder S; S.init(MP, DM, F.G, bx);
      pg8::EpiOut E{F.XN, F.H1B};
      pg8::gemm_phase<pg8::EpiOut, pg8::StaticOrder, true>(F.lds, g, S, E, wave_s); PHASE_END
    PHASE_BEGIN for (int t = F.vcu; t < 256; t += F.G) small_gemm_tile<4>(F, t); PHASE_END }
    GRID_BAR();

    PHASE_BEGIN pg8::Gemm g{F.H1B, F.WPG, MP, DM, DM, DM, DM}; pg8::StaticOrder S; S.init(MP, DM, F.G, bx);
      pg8::EpiPle E{F.H1B, F.PP, F.SSQ_Y, F.out + O_Y, F.g_fin, (unsigned*)F.ctl};
      pg8::gemm_phase<pg8::EpiPle, pg8::StaticOrder, true>(F.lds, g, S, E, wave_s); PHASE_END
    PHASE_BEGIN for (int t = F.vcu; t < 256; t += F.G) small_gemm_tile<5>(F, t); PHASE_END
}

extern "C" void kernel_launch(void* const* d_in, const int* in_sizes, int n_in, void* d_out, int out_size, void* d_ws, size_t ws_size, hipStream_t stream) {
    static int grid = 0;
    if (grid == 0) {
        if (n_in != 22 || (size_t)out_size != O_END || ws_size < WS_END) { fprintf(stderr, "kernel_launch: unexpected shapes: n_in %d out %d ws %zu (need %zu)\n", n_in, out_size, ws_size, (size_t)WS_END); grid = -1; return; }
        int dev = 0, cus = 0, per_cu = 0;
        if (hipGetDevice(&dev) != hipSuccess || hipDeviceGetAttribute(&cus, hipDeviceAttributeMultiprocessorCount, dev) != hipSuccess) { grid = -1; return; }
        if (hipFuncSetAttribute((const void*)hymba_fwd, hipFuncAttributeMaxDynamicSharedMemorySize, LDS_BYTES) != hipSuccess) { fprintf(stderr, "kernel_launch: hipFuncSetAttribute failed\n"); grid = -1; return; }
        if (hipOccupancyMaxActiveBlocksPerMultiprocessor(&per_cu, (const void*)hymba_fwd, NTHREADS, LDS_BYTES) != hipSuccess || per_cu < 1)
            fprintf(stderr, "kernel_launch: note: occupancy query reports %d workgroups per CU\n", per_cu);
        (void)hipGetLastError();
        grid = cus;
    }
    if (grid < 0) return;
    if (hipMemsetAsync((char*)d_ws + WS_CTL, 0, CTL_ZERO_BYTES, stream) != hipSuccess) { fprintf(stderr, "kernel_launch: memset failed\n"); return; }
    Args a{};
    for (int i = 0; i < 22; ++i) a.in[i] = (const float*)d_in[i];
    a.out = (float*)d_out; a.ws = (unsigned char*)d_ws;
    hipLaunchKernelGGL(hymba_fwd, dim3(grid), dim3(NTHREADS), LDS_BYTES, stream, a);
    const hipError_t le = hipPeekAtLastError();
    if (le != hipSuccess) fprintf(stderr, "kernel_launch: launch failed: %s\n", hipGetErrorName(le));
}
```
